# Optimizing an MI355X kernel written in HIP

```python
import math
import jax, jax.numpy as jnp
from jax import lax
import numpy as np


D_MODEL = 1024
BATCH = 8
SEQ = 8192
DEPTH = 2

A_HEAD_DIM = 64
A_WIDTH = D_MODEL // 2
A_HEADS = A_WIDTH // A_HEAD_DIM
A_DECAY_LORA = 32
A_ICLR_LORA = 32
A_COLS = 4 * A_WIDTH + A_DECAY_LORA + A_ICLR_LORA
A_GN_EPS = 64e-5

B_HEAD_DIM = 64
B_WIDTH = D_MODEL // 2
B_HEADS = B_WIDTH // B_HEAD_DIM
B_KV_HEADS = 2
B_GROUP = B_HEADS // B_KV_HEADS
B_KV_WIDTH = B_KV_HEADS * B_HEAD_DIM
B_COLS = 2 * B_WIDTH + 2 * B_KV_WIDTH
WINDOW = 128
BLOCK = 128

REL_BUCKETS = 32
REL_MAX_DIST = 128

C_KEY_DIM = 128
C_VAL_DIM = 128
C_HEADS = D_MODEL // C_KEY_DIM
C_WIDTH = C_HEADS * C_VAL_DIM
C_COLS = 4 * C_WIDTH
CHUNK = 64

NORM_EPS = 1e-6
NEG_INF = -1e30

kernel_name = 'hybrid_rwkv7_swa_hgrn2_trunk'


def _split(x, sizes):
    idx = [int(i) for i in np.cumsum(sizes)[:-1]]
    return jnp.split(x, idx, axis=-1)


def rms_norm(x, w):
    xf = x.astype(jnp.float32)
    y = xf * lax.rsqrt(jnp.mean(xf * xf, axis=-1, keepdims=True) + NORM_EPS)
    return y * w.astype(jnp.float32)


def token_shift(feats, mu):
    prev = jnp.pad(feats, ((0, 0), (1, 0), (0, 0)))[:, :-1]
    return feats + mu * (prev - feats)


def t5_bucket(dist):
    max_exact = REL_BUCKETS // 2
    d = jnp.maximum(dist, 0)
    large = max_exact + (jnp.log(jnp.maximum(d, 1).astype(jnp.float32) / max_exact)
                         / math.log(REL_MAX_DIST / max_exact)
                         * (REL_BUCKETS - max_exact)).astype(jnp.int32)
    large = jnp.minimum(large, REL_BUCKETS - 1)
    return jnp.where(d < max_exact, d, large)


def rwkv7_scan(r, decay, k, v, kk, a):
    bsz, _, heads, n = r.shape
    xs = tuple(jnp.moveaxis(z, 1, 0) for z in (r, decay, k, v, kk, a))

    def step(state, inp):
        r_t, w_t, k_t, v_t, kk_t, a_t = inp
        sa = jnp.einsum('bhvk,bhk->bhv', state, -kk_t)
        state = (state * w_t[:, :, None, :]
                 + sa[..., None] * (kk_t * a_t)[:, :, None, :]
                 + v_t[..., None] * k_t[:, :, None, :])
        return state, jnp.einsum('bhvk,bhk->bhv', state, r_t)

    s0 = jnp.zeros((bsz, heads, n, n), jnp.float32)
    _, ys = lax.scan(step, s0, xs)
    return jnp.moveaxis(ys, 0, 1)


def rwkv7_branch(feats, a_w0, a_w2, a_a0, a_a2, a_k_k, a_k_a, a_r_k, a_ln_w, a_ln_b):
    bsz, t = feats.shape[:2]
    r, k, v, w_lr, a_lr = _split(feats, [A_WIDTH, A_WIDTH, A_WIDTH, A_DECAY_LORA, A_ICLR_LORA])
    w = -jax.nn.softplus(-(a_w0 + jnp.tanh(w_lr) @ a_w2)) - 0.5
    decay = jnp.exp(-jnp.exp(w))
    a = jax.nn.sigmoid(a_a0 + a_lr @ a_a2)
    kk = k * a_k_k
    k = k * (1.0 + (a - 1.0) * a_k_a)

    def hs(z):
        return z.reshape(bsz, t, A_HEADS, A_HEAD_DIM)

    kk = hs(kk)
    kk = kk / jnp.maximum(jnp.sqrt(jnp.sum(kk * kk, axis=-1, keepdims=True)), 1e-12)
    r, k, v, decay, a = hs(r), hs(k), hs(v), hs(decay), hs(a)
    y = rwkv7_scan(r, decay, k, v, kk, a)
    mean = jnp.mean(y, axis=-1, keepdims=True)
    var = jnp.mean(jnp.square(y - mean), axis=-1, keepdims=True)
    y = ((y - mean) * lax.rsqrt(var + A_GN_EPS) * a_ln_w.reshape(A_HEADS, A_HEAD_DIM)
         + a_ln_b.reshape(A_HEADS, A_HEAD_DIM))
    y = y + jnp.sum(r * k * a_r_k, axis=-1, keepdims=True) * v
    return y.reshape(bsz, t, A_WIDTH)


def swa_sink_attention(q, k, v, sinks, rel_bias_table):
    bsz, t = q.shape[:2]
    nb = t // BLOCK
    q = q.reshape(bsz, nb, BLOCK, B_KV_HEADS, B_GROUP, B_HEAD_DIM)
    pad = ((0, 0), (BLOCK, 0), (0, 0), (0, 0))
    kp = jnp.pad(k.reshape(bsz, t, B_KV_HEADS, B_HEAD_DIM), pad).reshape(bsz, nb + 1, BLOCK, B_KV_HEADS, B_HEAD_DIM)
    vp = jnp.pad(v.reshape(bsz, t, B_KV_HEADS, B_HEAD_DIM), pad).reshape(bsz, nb + 1, BLOCK, B_KV_HEADS, B_HEAD_DIM)
    kb = jnp.concatenate([kp[:, :-1], kp[:, 1:]], axis=2)
    vb = jnp.concatenate([vp[:, :-1], vp[:, 1:]], axis=2)
    scores = jnp.einsum('bnqhgd,bnkhd->bnhgqk', q, kb) * (B_HEAD_DIM ** -0.5)

    qi = jnp.arange(BLOCK)[:, None]
    kj = jnp.arange(2 * BLOCK)[None, :]
    dist = qi + BLOCK - kj
    bias = rel_bias_table[t5_bucket(dist)]
    bias = jnp.transpose(bias, (2, 0, 1)).reshape(B_KV_HEADS, B_GROUP, BLOCK, 2 * BLOCK)
    in_window = (dist >= 0) & (dist < WINDOW)
    key_pos = jnp.arange(nb)[:, None, None] * BLOCK - BLOCK + kj[None]
    valid = in_window[None] & (key_pos >= 0)
    scores = jnp.where(valid[None, :, None, None], scores + bias, NEG_INF)

    sink = sinks.reshape(B_KV_HEADS, B_GROUP)[None, None, :, :, None, None]
    m = jnp.maximum(jnp.max(scores, axis=-1, keepdims=True), sink)
    p = jnp.exp(scores - m)
    denom = jnp.sum(p, axis=-1, keepdims=True) + jnp.exp(sink - m)
    out = jnp.einsum('bnhgqk,bnkhd->bnqhgd', p / denom, vb)
    return out.reshape(bsz, t, B_WIDTH)


def rwkv_swa_layer(h, w_in, w_out, a_mu, a_w0, a_w2, a_a0, a_a2, a_k_k, a_k_a, a_r_k,
                   a_ln_w, a_ln_b, b_sinks, rel_bias_table):
    proj = h @ w_in
    a_feats = token_shift(proj[..., :A_COLS], a_mu)
    a_core, a_gate = a_feats[..., :-A_WIDTH], a_feats[..., -A_WIDTH:]
    q_b, k_b, v_b, b_gate = _split(proj[..., A_COLS:], [B_WIDTH, B_KV_WIDTH, B_KV_WIDTH, B_WIDTH])
    y_a = rwkv7_branch(a_core, a_w0, a_w2, a_a0, a_a2, a_k_k, a_k_a, a_r_k, a_ln_w, a_ln_b)
    y_b = swa_sink_attention(q_b, k_b, v_b, b_sinks, rel_bias_table)
    y = jnp.concatenate([y_a * jax.nn.silu(a_gate), y_b * jax.nn.silu(b_gate)], axis=-1)
    return y @ w_out


def hgrn2_chunkwise(q, k, v, log_f):
    bsz, t, heads, dk = q.shape
    dv = v.shape[-1]
    nc = t // CHUNK

    def chunked(z):
        return jnp.moveaxis(z.reshape(bsz, nc, CHUNK, heads, z.shape[-1]), 1, 0)

    causal = jnp.tril(jnp.ones((CHUNK, CHUNK), dtype=bool))

    def step(state, inp):
        q_c, k_c, v_c, g_c = inp
        g_cum = jnp.cumsum(g_c, axis=1)
        g_last = g_cum[:, -1]
        q_dec = q_c * jnp.exp(g_cum)
        k_inv = k_c * jnp.exp(-g_cum)
        scores = jnp.where(causal, jnp.einsum('bihk,bjhk->bhij', q_dec, k_inv), 0.0)
        o = (jnp.einsum('bhij,bjhv->bihv', scores, v_c)
             + jnp.einsum('bihk,bhkv->bihv', q_dec, state))
        k_tail = k_c * jnp.exp(g_last[:, None] - g_cum)
        state = state * jnp.exp(g_last)[..., None] + jnp.einsum('bjhk,bjhv->bhkv', k_tail, v_c)
        return state, o

    s0 = jnp.zeros((bsz, heads, dk, dv), jnp.float32)
    _, o = lax.scan(step, s0, (chunked(q), chunked(k), chunked(v), chunked(log_f)))
    return jnp.moveaxis(o, 0, 1).reshape(bsz, t, heads, dv)


def hgrn2_layer(h, layer, w_in, w_out, lower_bounds, c_norm_w):
    bsz, t = h.shape[:2]
    proj = h @ w_in
    q, f, i, g = _split(proj, [C_HEADS * C_KEY_DIM, C_HEADS * C_KEY_DIM, C_WIDTH, C_WIDTH])
    lb_soft = jax.nn.softmax(lower_bounds.astype(jnp.float32), axis=0)
    lb = (jnp.cumsum(lb_soft, axis=0) - lb_soft[0])[layer]
    forget = lb + (1.0 - lb) * jax.nn.sigmoid(f)

    def hk(z):
        return z.reshape(bsz, t, C_HEADS, C_KEY_DIM)

    def hv(z):
        return z.reshape(bsz, t, C_HEADS, C_VAL_DIM)

    o = hgrn2_chunkwise(hk(jax.nn.silu(q)), hk(1.0 - forget), hv(i), hk(jnp.log(forget)))
    o = o * lax.rsqrt(jnp.mean(o * o, axis=-1, keepdims=True) + NORM_EPS) * c_norm_w
    o = o * jax.nn.silu(hv(g))
    return o.reshape(bsz, t, C_WIDTH) @ w_out


def setup_inputs(seed: int = 0) -> dict:
    key = jax.random.key(seed)
    ks = jax.random.split(key, 23)

    def nrm(k, shape, scale):
        return jax.random.normal(k, shape, jnp.float32) * scale

    def gain(k, n):
        return 1.0 + nrm(k, (n,), 0.05)

    return {
        'x': nrm(ks[0], (BATCH, SEQ, D_MODEL), 1.0),
        'rel_bias_table': nrm(ks[1], (REL_BUCKETS, B_HEADS), 0.5),
        'lower_bounds': nrm(ks[2], (DEPTH, C_HEADS * C_KEY_DIM), 0.1),
        'l0_pre_norm': gain(ks[3], D_MODEL),
        'l0_post_norm': gain(ks[4], D_MODEL),
        'l0_w_in': nrm(ks[5], (D_MODEL, A_COLS + B_COLS), D_MODEL ** -0.5),
        'l0_w_out': nrm(ks[6], (A_WIDTH + B_WIDTH, D_MODEL), (A_WIDTH + B_WIDTH) ** -0.5),
        'a_mu': jax.random.uniform(ks[7], (A_COLS,), jnp.float32),
        'a_w0': jax.random.uniform(ks[8], (A_WIDTH,), jnp.float32, minval=-6.0, maxval=1.0),
        'a_w2': nrm(ks[9], (A_DECAY_LORA, A_WIDTH), 0.1),
        'a_a0': nrm(ks[10], (A_WIDTH,), 0.5),
        'a_a2': nrm(ks[11], (A_ICLR_LORA, A_WIDTH), A_ICLR_LORA ** -0.5),
        'a_k_k': 0.85 + nrm(ks[12], (A_WIDTH,), 0.05),
        'a_k_a': gain(ks[13], A_WIDTH),
        'a_r_k': nrm(ks[14], (A_HEADS, A_HEAD_DIM), 0.1),
        'a_ln_w': gain(ks[15], A_WIDTH),
        'a_ln_b': nrm(ks[16], (A_WIDTH,), 0.01),
        'b_sinks': nrm(ks[17], (B_HEADS,), 1.0),
        'l1_pre_norm': gain(ks[18], D_MODEL),
        'l1_post_norm': gain(ks[19], D_MODEL),
        'l1_w_in': nrm(ks[20], (D_MODEL, C_COLS), D_MODEL ** -0.5),
        'l1_w_out': nrm(ks[21], (C_WIDTH, D_MODEL), C_WIDTH ** -0.5),
        'c_norm_w': gain(ks[22], C_VAL_DIM),
    }


def reference(x, rel_bias_table, lower_bounds, l0_pre_norm, l0_post_norm, l0_w_in, l0_w_out,
              a_mu, a_w0, a_w2, a_a0, a_a2, a_k_k, a_k_a, a_r_k, a_ln_w, a_ln_b, b_sinks,
              l1_pre_norm, l1_post_norm, l1_w_in, l1_w_out, c_norm_w):
    for layer in range(DEPTH):
        if layer % 2 == 0:
            h = rms_norm(x, l0_pre_norm)
            y = rwkv_swa_layer(h, l0_w_in, l0_w_out, a_mu, a_w0, a_w2, a_a0, a_a2, a_k_k, a_k_a,
                               a_r_k, a_ln_w, a_ln_b, b_sinks, rel_bias_table)
            x = x + rms_norm(y, l0_post_norm).astype(x.dtype)
        else:
            h = rms_norm(x, l1_pre_norm)
            y = hgrn2_layer(h, layer, l1_w_in, l1_w_out, lower_bounds, c_norm_w)
            x = x + rms_norm(y, l1_post_norm).astype(x.dtype)
    return x
```

```cpp
#include <hip/hip_runtime.h>
#include <cstdio>
#include <cstdint>
namespace pg8 {
#define PG8_LAS __attribute__((address_space(3)))
typedef unsigned short bf16_t;
typedef short bf16x8 __attribute__((ext_vector_type(8)));
typedef float f32x4 __attribute__((ext_vector_type(4)));
typedef unsigned u32x4 __attribute__((ext_vector_type(4)));
constexpr int BM = 256, BK = 64, HALF = 128, HTB = HALF * BK * 2  , STAGE_BYTES = 8 * HTB, NXCD = 8, WGM = 8;

__host__ __device__ __forceinline__ int lds_byte(int r, int c) { const int st = (r >> 4) * 2 + (c >> 5), rr = r & 15, cc = c & 31, ob = rr * 64 + cc * 2; return st * 1024 + (ob ^ (((ob >> 9) & 1) << 5)); }
__host__ __device__ __forceinline__ void stage_rc(int b, int& R, int& C) { const int st = b / 1024, sb = b % 1024, swz = sb ^ (((sb >> 9) & 1) << 5); R = (st >> 1) * 16 + swz / 64; C = (st & 1) * 32 + (swz % 64) / 2; }
__host__ __device__ __forceinline__ int perm32(int rho) { const int n = rho >> 4, i = rho & 15; return 8 * (i >> 2) + 4 * n + (i & 3); }

struct Unit { int pm, pn; };
struct Gemm { const bf16_t* A; const bf16_t* Bt; int M, N, K; };

struct StaticOrder {
    int nM, nN, nwg, G, c;
    __host__ __device__ void init(int M, int N, int G_, int c_) { nM = M / BM; nN = N / BM; nwg = nM * nN; G = G_; c = c_; }
    __host__ __device__ bool next(int i, Unit& u) const {
        const long L = (long)i * G + c; if (L >= nwg) return false;
        int wgid = (int)L; { const int q = nwg / NXCD, r = nwg % NXCD, xcd = wgid % NXCD, off = wgid / NXCD; wgid = (xcd < r ? xcd * (q + 1) : r * (q + 1) + (xcd - r) * q) + off; }
        const int nig = WGM * nN, gid = wgid / nig, fm = gid * WGM, gsz = (nM - fm) < WGM ? (nM - fm) : WGM;
        u.pm = fm + ((wgid % nig) % gsz); u.pn = (wgid % nig) / gsz; return true;
    }
    __device__ __forceinline__ void a_ready(const Unit&) const {}
    __device__ __forceinline__ void done(const Unit&) const {}
};

__device__ __forceinline__ unsigned cvt_pk_bf16(float lo, float hi) { unsigned r; asm volatile("v_cvt_pk_bf16_f32 %0, %1, %2" : "=v"(r) : "v"(lo), "v"(hi)); return r; }
struct EpiBf16 {
    static constexpr bool PERM = true, AFTER_DRAIN = false;
    bf16_t* O; int ldc;
    __device__ __forceinline__ void operator()(const f32x4 (&acc)[2][2][4][2], const Unit& u, int wr, int wc, int fr, int fq) const {
        const int row0 = u.pm * BM + wr * 64 + fr; const int col0 = u.pn * BM + wc * 32 + 8 * fq;
#pragma unroll
        for (int ai = 0; ai < 2; ++ai)
#pragma unroll
            for (int m = 0; m < 4; ++m) { bf16_t* rowp = O + (size_t)(row0 + ai * HALF + m * 16) * ldc + col0;
#pragma unroll
                for (int bj = 0; bj < 2; ++bj) { const f32x4 v0 = acc[ai][bj][m][0], v1 = acc[ai][bj][m][1];
                    u32x4 w; w.x = cvt_pk_bf16(v0[0], v0[1]); w.y = cvt_pk_bf16(v0[2], v0[3]); w.z = cvt_pk_bf16(v1[0], v1[1]); w.w = cvt_pk_bf16(v1[2], v1[3]);
                    *(u32x4*)(rowp + bj * HALF) = w; } }
    }
};

template <class Epi, class Sched, bool ALIGN_EPI = false, bool SP2 = false>
__device__ __forceinline__ void gemm_phase(PG8_LAS unsigned char* lds, const Gemm g, const Sched& S, const Epi& E) {
    const int tid = threadIdx.x, wid = __builtin_amdgcn_readfirstlane(tid >> 6), lane = tid & 63, wr = wid >> 2, wc = wid & 3, fr = lane & 15, fq = lane >> 4;
    const int K = g.K, nt = K / BK;
    unsigned voffA[2], voffB[2];
#pragma unroll
    for (int i = 0; i < 2; ++i) { int R, C; stage_rc(tid * 16 + i * 8192, R, C); const int Rb = Epi::PERM ? ((R & ~31) + perm32(R & 31)) : R;
        voffA[i] = (unsigned)(R * K + C) * 2u; voffB[i] = (unsigned)(Rb * K + C) * 2u; }
    const size_t kstep = (size_t)(BK * 2);
    const size_t hstep = (size_t)HALF * K * 2;
    const size_t tstep = 2 * hstep;
    const unsigned ldsw = (unsigned)wid * 1024u;
    const int aoff = lds_byte(wr * 64 + fr, fq * 8), boff = lds_byte(wc * 32 + fr, fq * 8);
#define PG8_SA(b, h) (((b) * 2 + (h)) * HTB)
#define PG8_SB(b, h) ((4 + (b) * 2 + (h)) * HTB)
#define PG8_STAGE(bufoff, gbase, voff) do { _Pragma("unroll") for (int _i = 0; _i < 2; ++_i) \
        __builtin_amdgcn_global_load_lds((const unsigned*)((const char*)(gbase) + (voff)[_i]), (PG8_LAS unsigned*)(lds + (bufoff) + ldsw + _i * 8192), 16, 0, 0); } while (0)
#define PG8_LDA(dst, b, h) do { _Pragma("unroll") for (int m = 0; m < 4; ++m) _Pragma("unroll") for (int k = 0; k < 2; ++k) dst[m][k] = *(const PG8_LAS bf16x8*)(lds + PG8_SA(b, h) + aoff + m * 2048 + k * 1024); } while (0)
#define PG8_LDB(dst, b, h) do { _Pragma("unroll") for (int n = 0; n < 2; ++n) _Pragma("unroll") for (int k = 0; k < 2; ++k) dst[n][k] = *(const PG8_LAS bf16x8*)(lds + PG8_SB(b, h) + boff + n * 2048 + k * 1024); } while (0)
#define PG8_MMA(ai, bj, At, Bt) do { __builtin_amdgcn_s_setprio(1); _Pragma("unroll") for (int m = 0; m < 4; ++m) _Pragma("unroll") for (int n = 0; n < 2; ++n) _Pragma("unroll") for (int k = 0; k < 2; ++k) \
        acc[ai][bj][m][n] = __builtin_amdgcn_mfma_f32_16x16x32_bf16(Bt[n][k], At[m][k], acc[ai][bj][m][n], 0, 0, 0); __builtin_amdgcn_s_setprio(0); } while (0)
#define PG8_WAIT_V(n) asm volatile("s_waitcnt vmcnt(" #n ")" ::: "memory")
#define PG8_WAIT_L(n) asm volatile("s_waitcnt lgkmcnt(" #n ")" ::: "memory")
#define PG8_BAR __builtin_amdgcn_s_barrier()
#define PG8_SCHED __builtin_amdgcn_sched_barrier(0)
    Unit cur, nxt; int ui = 0;
    if (!S.next(0, cur)) return;
    f32x4 acc[2][2][4][2];
#pragma unroll
    for (int a = 0; a < 2; ++a)
#pragma unroll
        for (int b = 0; b < 2; ++b)
#pragma unroll
            for (int m = 0; m < 4; ++m)
#pragma unroll
                for (int n = 0; n < 2; ++n) acc[a][b][m][n] = (f32x4){0.f, 0.f, 0.f, 0.f};
    bf16x8 At[4][2], B0[2][2], B1[2][2];
    const char* cA = (const char*)g.A + (size_t)cur.pm * tstep; const char* cB = (const char*)g.Bt + (size_t)cur.pn * tstep;
    S.a_ready(cur);
    if constexpr (SP2) {
        PG8_STAGE(PG8_SB(0, 0), cB, voffB); PG8_STAGE(PG8_SB(0, 1), cB + hstep, voffB); PG8_STAGE(PG8_SA(0, 0), cA, voffA); PG8_STAGE(PG8_SA(0, 1), cA + hstep, voffA);
        if (wr == 1) PG8_BAR;
        PG8_WAIT_V(2); PG8_BAR;
        PG8_STAGE(PG8_SB(1, 0), cB + kstep, voffB); PG8_STAGE(PG8_SA(1, 0), cA + kstep, voffA); PG8_STAGE(PG8_SB(1, 1), cB + hstep + kstep, voffB);
        PG8_WAIT_V(6); PG8_BAR;
    } else {
        PG8_STAGE(PG8_SB(0, 0), cB, voffB); PG8_STAGE(PG8_SA(0, 0), cA, voffA); PG8_STAGE(PG8_SB(0, 1), cB + hstep, voffB); PG8_STAGE(PG8_SA(0, 1), cA + hstep, voffA);
        if (wr == 1) PG8_BAR;
        PG8_WAIT_V(4); PG8_BAR;
        PG8_STAGE(PG8_SB(1, 0), cB + kstep, voffB); PG8_STAGE(PG8_SA(1, 0), cA + kstep, voffA); PG8_STAGE(PG8_SB(1, 1), cB + hstep + kstep, voffB);
        PG8_WAIT_V(6); PG8_BAR;
    }
    for (;;) {
        const bool has_next = S.next(ui + 1, nxt);
        const char* nA = has_next ? (const char*)g.A + (size_t)nxt.pm * tstep : cA; const char* nB = has_next ? (const char*)g.Bt + (size_t)nxt.pn * tstep : cB;
        for (int t = 0; t < nt; t += 2) {
            const bool last = (t == nt - 2);
            const char* a1 = cA + (size_t)(t + 1) * kstep;
            const char* a2 = last ? nA : cA + (size_t)(t + 2) * kstep; const char* b2 = last ? nB : cB + (size_t)(t + 2) * kstep;
            const char* a3 = a2 + kstep; const char* b3 = b2 + kstep;
            if (last && has_next) S.a_ready(nxt);
            if constexpr (SP2) {
            PG8_LDB(B0, 0, 0); PG8_LDB(B1, 0, 1); PG8_SCHED; PG8_LDA(At, 0, 0); PG8_STAGE(PG8_SA(1, 1), a1 + hstep, voffA);
            PG8_WAIT_V(8); PG8_WAIT_L(0); PG8_BAR; PG8_MMA(0, 0, At, B0); PG8_MMA(0, 1, At, B1); PG8_BAR; PG8_SCHED;
            PG8_LDA(At, 0, 1); PG8_STAGE(PG8_SB(0, 0), b2, voffB); PG8_STAGE(PG8_SB(0, 1), b2 + hstep, voffB); PG8_STAGE(PG8_SA(0, 0), a2, voffA);
            PG8_WAIT_V(8); PG8_WAIT_L(0); PG8_BAR; PG8_MMA(1, 0, At, B0); PG8_MMA(1, 1, At, B1); PG8_BAR; PG8_SCHED;
            PG8_LDB(B0, 1, 0); PG8_LDB(B1, 1, 1); PG8_SCHED; PG8_LDA(At, 1, 0); PG8_STAGE(PG8_SA(0, 1), a2 + hstep, voffA);
            PG8_WAIT_V(8); PG8_WAIT_L(0); PG8_BAR; PG8_MMA(0, 0, At, B0); PG8_MMA(0, 1, At, B1); PG8_BAR; PG8_SCHED;
            PG8_LDA(At, 1, 1); PG8_STAGE(PG8_SB(1, 0), b3, voffB); PG8_STAGE(PG8_SB(1, 1), b3 + hstep, voffB); PG8_STAGE(PG8_SA(1, 0), a3, voffA);
            PG8_WAIT_V(8); PG8_WAIT_L(0); PG8_BAR; PG8_MMA(1, 0, At, B0); PG8_MMA(1, 1, At, B1); PG8_BAR; PG8_SCHED;
            } else {
            PG8_LDB(B0, 0, 0); PG8_SCHED; PG8_LDA(At, 0, 0); PG8_STAGE(PG8_SA(1, 1), a1 + hstep, voffA);
            PG8_WAIT_L(8); PG8_BAR; PG8_WAIT_L(0); PG8_MMA(0, 0, At, B0); PG8_BAR; PG8_SCHED;
            PG8_LDB(B1, 0, 1); PG8_STAGE(PG8_SB(0, 0), b2, voffB);
            PG8_BAR; PG8_WAIT_L(0); PG8_MMA(0, 1, At, B1); PG8_BAR;
            PG8_LDA(At, 0, 1); PG8_STAGE(PG8_SA(0, 0), a2, voffA);
            PG8_BAR; PG8_WAIT_L(0); PG8_MMA(1, 0, At, B0); PG8_BAR; PG8_SCHED;
            PG8_STAGE(PG8_SB(0, 1), b2 + hstep, voffB);
            PG8_WAIT_V(6); PG8_BAR; PG8_MMA(1, 1, At, B1); PG8_BAR;
            PG8_LDB(B0, 1, 0); PG8_SCHED; PG8_LDA(At, 1, 0); PG8_STAGE(PG8_SA(0, 1), a2 + hstep, voffA);
            PG8_WAIT_L(8); PG8_BAR; PG8_WAIT_L(0); PG8_MMA(0, 0, At, B0); PG8_BAR; PG8_SCHED;
            PG8_LDB(B1, 1, 1); PG8_STAGE(PG8_SB(1, 0), b3, voffB);
            PG8_BAR; PG8_WAIT_L(0); PG8_MMA(0, 1, At, B1); PG8_BAR;
            PG8_LDA(At, 1, 1); PG8_STAGE(PG8_SA(1, 0), a3, voffA);
            PG8_BAR; PG8_WAIT_L(0); PG8_MMA(1, 0, At, B0); PG8_BAR; PG8_SCHED;
            PG8_STAGE(PG8_SB(1, 1), b3 + hstep, voffB);
            PG8_WAIT_V(6); PG8_BAR; PG8_MMA(1, 1, At, B1); PG8_BAR;
            }
        }
        if constexpr (ALIGN_EPI) { if (wr == 0) PG8_BAR; }
        if constexpr (!Epi::AFTER_DRAIN) { E(acc, cur, wr, wc, fr, fq); S.done(cur); }
        if (!has_next) break;
#pragma unroll
        for (int a = 0; a < 2; ++a)
#pragma unroll
            for (int b = 0; b < 2; ++b)
#pragma unroll
                for (int m = 0; m < 4; ++m)
#pragma unroll
                    for (int n = 0; n < 2; ++n) acc[a][b][m][n] = (f32x4){0.f, 0.f, 0.f, 0.f};
        cur = nxt; cA = nA; cB = nB; ++ui;
        if constexpr (ALIGN_EPI) { if (wr == 1) PG8_BAR; }
    }
    PG8_WAIT_V(0);
    if constexpr (!ALIGN_EPI) { if (wr == 0) PG8_BAR; }
    PG8_BAR;
    if constexpr (Epi::AFTER_DRAIN) { E.fused(acc, cur, wr, wc, fr, fq, lds, wid, lane); S.done(cur); }
#undef PG8_SA
#undef PG8_SB
#undef PG8_STAGE
#undef PG8_LDA
#undef PG8_LDB
#undef PG8_MMA
#undef PG8_WAIT_V
#undef PG8_WAIT_L
#undef PG8_BAR
#undef PG8_SCHED
}
}
constexpr int NWAVES = 8, NTHR = 512;
constexpr int NB = 8, T = 8192, D = 1024, M = NB * T;
constexpr int N0 = 3392, N0P = 3584, N1 = 4096;
constexpr int C_R = 0, C_K = 512, C_V = 1024, C_WL = 1536, C_AL = 1568, C_GA = 1600, C_QB = 2112, C_KB = 2624, C_VB = 2752, C_GB = 2880;
constexpr int P0LD = N0P, P1LD = N1;
constexpr size_t MiB = 1u << 20;
constexpr size_t WS_CTL = 0, CTL_ZERO_BYTES = 1 * MiB;
constexpr size_t WS_W0T = 2 * MiB, WS_WO0T = 10 * MiB, WS_W1T = 12 * MiB, WS_WO1T = 20 * MiB, WS_TAB = 23 * MiB;
constexpr size_t WS_HA = 32 * MiB, WS_HB = 160 * MiB, WS_PROJ = 288 * MiB, WS_Y = 800 * MiB, WS_END = 928 * MiB;
constexpr int CW_BAR = 4096;
constexpr int LDS_BYTES = 147456, LDSCTL_OFF = 143360, MISC_OFF = LDSCTL_OFF + 320;

#define GAS __attribute__((address_space(1)))
#define LAS __attribute__((address_space(3)))
typedef unsigned short bf16;
typedef unsigned v4u __attribute__((ext_vector_type(4)));
typedef unsigned v2u __attribute__((ext_vector_type(2)));
typedef float f32x4 __attribute__((ext_vector_type(4)));
typedef float f32x16 __attribute__((ext_vector_type(16)));
typedef short bf16x8 __attribute__((ext_vector_type(8)));
typedef GAS unsigned gu32;
#define RLX_AGENT __ATOMIC_RELAXED, __HIP_MEMORY_SCOPE_AGENT
__device__ __forceinline__ unsigned f2bf(float f) { unsigned u = __builtin_bit_cast(unsigned, f); return (u + 0x7fffu + ((u >> 16) & 1u)) >> 16; }
__device__ __forceinline__ unsigned pk2(float lo, float hi) { return f2bf(lo) | (f2bf(hi) << 16); }
__device__ __forceinline__ float bf2f(unsigned v) { return __uint_as_float(v << 16); }
__device__ __forceinline__ float bflo(unsigned w) { return __uint_as_float(w << 16); }
__device__ __forceinline__ float bfhi(unsigned w) { return __uint_as_float(w & 0xffff0000u); }
__device__ __forceinline__ float wave_sum(float v) {
#pragma unroll
    for (int o = 1; o < 64; o <<= 1) v += __shfl_xor(v, o);
    return v;
}
__device__ __forceinline__ float sigmoidf_(float x) { return 1.0f / (1.0f + expf(-x)); }
__device__ __forceinline__ float siluf_(float x) { return x / (1.0f + expf(-x)); }

#define XB_TMO      128
#define XB_XCNT(j)  (256  + 64 * (j))
#define XB_XSUB(j)  (1280 + 64 * (j))
#define XB_XGEN(j)  (2304 + 64 * (j))
#define XB_TOP      3328
#define XB_TOPGEN   3392
#define XCD_BAR_WORDS 3456
#define XB_SPIN_CAP (1u << 24)

__device__ __forceinline__ unsigned xb_ld(unsigned* p)              { return __hip_atomic_load(p, __ATOMIC_RELAXED, __HIP_MEMORY_SCOPE_AGENT); }
__device__ __forceinline__ unsigned xb_add(unsigned* p, unsigned v) { return __hip_atomic_fetch_add(p, v, __ATOMIC_RELAXED, __HIP_MEMORY_SCOPE_AGENT); }
__device__ __forceinline__ unsigned xb_xcc_id() { return (unsigned)__builtin_amdgcn_s_getreg((3 << 11) | 20) & 0xFu; }
#define XB_SPIN(cond, bar) do { unsigned _sp = 0; while (cond) { __builtin_amdgcn_s_sleep(1); \
    if ((++_sp & 255u) == 0u) { if (xb_ld(&(bar)[XB_TMO])) break; if (_sp > XB_SPIN_CAP) { atomicAdd(&(bar)[XB_TMO], 1u); break; } } } } while (0)

struct XcdBarrier {
    unsigned* bar; unsigned x;
    volatile LAS unsigned* st;
};

__device__ __forceinline__ XcdBarrier xcd_barrier_post(unsigned* bar, volatile LAS unsigned* st) {
    XcdBarrier b; b.bar = bar; b.x = xb_xcc_id(); b.st = st;
    if (threadIdx.x == 0) (void)xb_add(&bar[XB_XCNT(b.x)], 1u);
    return b;
}
__device__ __forceinline__ void xcd_barrier_complete(unsigned* bar, unsigned x, unsigned& nloc, unsigned& nx) {
    const unsigned G = gridDim.x * gridDim.y * gridDim.z;
    unsigned sum, cnt, mine, sp = 0u;
    for (;;) {
        sum = 0u; cnt = 0u; mine = 0u;
#pragma unroll
        for (unsigned j = 0; j < 16; ++j) { const unsigned c = xb_ld(&bar[XB_XCNT(j)]); sum += c; cnt += (c > 0u) ? 1u : 0u; mine = (j == x) ? c : mine; }
        if (sum == G) break;
        __builtin_amdgcn_s_sleep(1);
        if ((++sp & 255u) == 0u) { if (xb_ld(&bar[XB_TMO])) break; if (sp > XB_SPIN_CAP) { atomicAdd(&bar[XB_TMO], 1u); break; } }
    }
    nloc = mine > 0u ? mine : 1u; nx = cnt > 0u ? cnt : 1u;
}

__device__ __forceinline__ void xcd_barrier(const XcdBarrier& b) {
    asm volatile("s_waitcnt vmcnt(0)" ::: "memory");
    __syncthreads();
    if (threadIdx.x == 0) {
        unsigned* bar = b.bar;
        __builtin_amdgcn_s_waitcnt(0);
        unsigned nloc = b.st[0], nx = b.st[1];
        if (nloc == 0u) { xcd_barrier_complete(bar, b.x, nloc, nx); b.st[0] = nloc; b.st[1] = nx; }
        const unsigned old = xb_add(&bar[XB_XSUB(b.x)], 1u);
        const unsigned gen = old / nloc;
        if (old + 1u == (gen + 1u) * nloc) {
            __builtin_amdgcn_fence(__ATOMIC_RELEASE, "agent");
            asm volatile("s_waitcnt vmcnt(0)" ::: "memory");
            const unsigned og = xb_add(&bar[XB_TOP], 1u);
            const unsigned tg = og / nx;
            if (og + 1u == (tg + 1u) * nx) xb_add(&bar[XB_TOPGEN], 1u);
            else XB_SPIN(xb_ld(&bar[XB_TOPGEN]) == tg, bar);
            __builtin_amdgcn_fence(__ATOMIC_ACQUIRE, "agent");
            xb_add(&bar[XB_XGEN(b.x)], 1u);
            asm volatile("s_waitcnt vmcnt(0)" ::: "memory");
        } else {
            XB_SPIN(xb_ld(&bar[XB_XGEN(b.x)]) == gen, bar);
            __builtin_amdgcn_fence(__ATOMIC_ACQUIRE, "agent");
            asm volatile("s_waitcnt vmcnt(0)" ::: "memory");
        }
    }
    __syncthreads();
}
struct Frame {
    LAS unsigned char* lds;
    int tid, lane, wave, vcu, G;
    const float* x; float* out;
    const float *rel_bias, *lower_bounds, *pre0, *post0, *w_in0, *w_out0, *a_mu, *a_w0, *a_w2, *a_a0, *a_a2, *a_k_k, *a_k_a, *a_r_k, *a_ln_w, *a_ln_b, *sinks, *pre1, *post1, *w_in1, *w_out1, *c_norm_w;
    bf16 *W0T, *WO0T, *W1T, *WO1T, *HA, *HB, *PROJ, *Y;
    float *bias_tab, *lb_tab;
};

__device__ __forceinline__ void p0_transpose_item(const float* W, int K, int N, bf16* WT, LAS float* scr, int item, int lane) {
    const int nblk = N / 32, kb = item / nblk, nb = item % nblk, k0 = 64 * kb, n0 = 32 * nb;
#pragma unroll 8
    for (int i = 0; i < 32; ++i) { const int kk = 2 * i + (lane >> 5); scr[kk * 33 + (lane & 31)] = W[(size_t)(k0 + kk) * N + n0 + (lane & 31)]; }
    asm volatile("s_waitcnt lgkmcnt(0)" ::: "memory");
    const int c = lane & 7;
#pragma unroll
    for (int j = 0; j < 4; ++j) { const int n = (lane >> 3) + 8 * j; const LAS float* s = scr + (8 * c) * 33 + n;
        v4u o; o.x = pk2(s[0 * 33], s[1 * 33]); o.y = pk2(s[2 * 33], s[3 * 33]); o.z = pk2(s[4 * 33], s[5 * 33]); o.w = pk2(s[6 * 33], s[7 * 33]);
        *(v4u*)(WT + (size_t)(n0 + n) * K + k0 + 8 * c) = o; }
    asm volatile("s_waitcnt lgkmcnt(0)" ::: "memory");
}
__device__ __forceinline__ void rms_row_to_bf16(const float* xrow, const float* w, bf16* orow, int lane) {
    const f32x4* xr = (const f32x4*)xrow + lane; const f32x4* wr = (const f32x4*)w + lane;
    f32x4 v[4]; float s = 0.f;
#pragma unroll
    for (int j = 0; j < 4; ++j) { v[j] = xr[64 * j]; s += (v[j].x * v[j].x + v[j].y * v[j].y) + (v[j].z * v[j].z + v[j].w * v[j].w); }
    const float rs = 1.0f / sqrtf(wave_sum(s) * (1.f / D) + 1e-6f);
    v2u* o8 = (v2u*)orow + lane;
#pragma unroll
    for (int j = 0; j < 4; ++j) { const f32x4 g = wr[64 * j]; v2u o; o.x = pk2(v[j].x * rs * g.x, v[j].y * rs * g.y); o.y = pk2(v[j].z * rs * g.z, v[j].w * rs * g.w); o8[64 * j] = o; }
}
__device__ __forceinline__ int t5_bucket(int d) {
    if (d < 16) return d;
    int b = 16;
    b += (d >= 19) + (d >= 21) + (d >= 24) + (d >= 27) + (d >= 31) + (d >= 35) + (d >= 40) + (d >= 46) + (d >= 52) + (d >= 59) + (d >= 67) + (d >= 77) + (d >= 87) + (d >= 99) + (d >= 113);
    return b;
}
__device__ __forceinline__ void ph_prologue(Frame& F) {
    LAS float* scr = (LAS float*)(F.lds + F.wave * 16384);
    const int gw = F.vcu * NWAVES + F.wave, NGW = F.G * NWAVES;
    constexpr int I_0 = (D / 64) * (N0 / 32), I_O = (D / 64) * (D / 32), I_1 = (D / 64) * (N1 / 32);
    constexpr int NITEMS = I_0 + I_O + I_1 + I_O;
    for (int it = gw; it < NITEMS; it += NGW) {
        int r = it;
        if (r < I_0) { p0_transpose_item(F.w_in0, D, N0, F.W0T, scr, r, F.lane); continue; } r -= I_0;
        if (r < I_O) { p0_transpose_item(F.w_out0, D, D, F.WO0T, scr, r, F.lane); continue; } r -= I_O;
        if (r < I_1) { p0_transpose_item(F.w_in1, D, N1, F.W1T, scr, r, F.lane); continue; } r -= I_1;
        p0_transpose_item(F.w_out1, D, D, F.WO1T, scr, r, F.lane);
    }
    for (int i = gw * 64 + F.lane; i < (N0P - N0) * D / 8; i += NGW * 64) ((v4u*)(F.W0T + (size_t)N0 * D))[i] = (v4u){0u, 0u, 0u, 0u};
    for (int m = gw; m < M; m += NGW) rms_row_to_bf16(F.x + (size_t)m * D, F.pre0, F.HA + (size_t)m * D, F.lane);
    const int gt = blockIdx.x * NTHR + F.tid;
    if (gt < 1024) { const int h = gt >> 7, d = gt & 127; F.bias_tab[gt] = F.rel_bias[t5_bucket(d) * 8 + h];
        F.lb_tab[gt] = 1.0f / (1.0f + expf(F.lower_bounds[gt] - F.lower_bounds[1024 + gt])); }
}

__device__ __forceinline__ void ph_attention(Frame& F) {
    LAS bf16* Ks = (LAS bf16*)(F.lds);
    LAS bf16* Vt = (LAS bf16*)(F.lds + 36864);
    LAS float* Bt = (LAS float*)(F.lds + 36864 + 33280);
    const int tid = F.tid, lane = F.lane, wave = F.wave, r32 = lane & 31, hh = lane >> 5;
    const bf16* P = F.PROJ;
    for (int u = blockIdx.x; u < 1024; u += F.G) {
        const int hkv = u & 1, nb = (u >> 1) & 63, b = u >> 7;
        {
            const int row = tid >> 1, half = tid & 1;
            const long grow = (long)b * T + nb * 128 - 128 + row;
            const bool ok = (nb > 0) || (row >= 128);
            v4u kv[4], vv[4];
            if (ok) { const v4u* kp = (const v4u*)(P + grow * P0LD + C_KB + hkv * 64 + half * 32); const v4u* vp = (const v4u*)(P + grow * P0LD + C_VB + hkv * 64 + half * 32);
#pragma unroll
                for (int i = 0; i < 4; ++i) { kv[i] = kp[i]; vv[i] = vp[i]; } }
            else {
#pragma unroll
                for (int i = 0; i < 4; ++i) { kv[i] = (v4u){0u, 0u, 0u, 0u}; vv[i] = (v4u){0u, 0u, 0u, 0u}; } }
#pragma unroll
            for (int i = 0; i < 4; ++i) *(LAS v4u*)(Ks + row * 72 + half * 32 + 8 * i) = kv[i];
#pragma unroll
            for (int i = 0; i < 4; ++i)
#pragma unroll
                for (int e = 0; e < 4; ++e) { const unsigned w = vv[i][e]; const int d = half * 32 + 8 * i + 2 * e;
                    Vt[d * 260 + row] = (bf16)(w & 0xffffu); Vt[(d + 1) * 260 + row] = (bf16)(w >> 16); }
            if (tid < 512) { const int g = tid >> 7, d = tid & 127; Bt[tid] = F.bias_tab[(hkv * 4 + g) * 128 + d]; }
        }
        __syncthreads();
#pragma unroll 1
        for (int ii = 0; ii < 2; ++ii) {
            const int item = wave * 2 + ii, g = item >> 2, qt = item & 3, hq = hkv * 4 + g;
            const long qrow = (long)b * T + nb * 128 + qt * 32 + r32;
            const bf16* qp = P + qrow * P0LD + C_QB + hq * 64 + hh * 8;
            bf16x8 qf[4];
#pragma unroll
            for (int s = 0; s < 4; ++s) qf[s] = *(const bf16x8*)(qp + 16 * s);
            f32x16 sc[5];
#pragma unroll
            for (int tt = 0; tt < 5; ++tt) { f32x16 acc = {0.f, 0.f, 0.f, 0.f, 0.f, 0.f, 0.f, 0.f, 0.f, 0.f, 0.f, 0.f, 0.f, 0.f, 0.f, 0.f};
#pragma unroll
                for (int s = 0; s < 4; ++s) { const bf16x8 kf = *(const LAS bf16x8*)(Ks + ((qt + tt) * 32 + r32) * 72 + 16 * s + 8 * hh);
                    acc = __builtin_amdgcn_mfma_f32_32x32x16_bf16(kf, qf[s], acc, 0, 0, 0); }
                sc[tt] = acc; }
            const int qi = qt * 32 + r32; const float sink = F.sinks[hq];
            float mx = sink;
#pragma unroll
            for (int tt = 0; tt < 5; ++tt)
#pragma unroll
                for (int i = 0; i < 16; ++i) { const int kj = (qt + tt) * 32 + (i & 3) + 8 * (i >> 2) + 4 * hh; const int dist = qi + 128 - kj;
                    const bool valid = (dist >= 0) && (dist < 128) && ((nb > 0) || (kj >= 128));
                    const float bv = Bt[g * 128 + (dist & 127)];
                    const float s = valid ? sc[tt][i] * 0.125f + bv : -1e30f; sc[tt][i] = s; mx = fmaxf(mx, s); }
            mx = fmaxf(mx, __shfl_xor(mx, 32));
            float sum = 0.f;
#pragma unroll
            for (int tt = 0; tt < 5; ++tt)
#pragma unroll
                for (int i = 0; i < 16; ++i) { const float p = __expf(sc[tt][i] - mx); sc[tt][i] = p; sum += p; }
            sum += __shfl_xor(sum, 32);
            const float inv = 1.0f / (sum + __expf(sink - mx));
            f32x16 o[2];
#pragma unroll
            for (int dt = 0; dt < 2; ++dt) o[dt] = (f32x16){0.f, 0.f, 0.f, 0.f, 0.f, 0.f, 0.f, 0.f, 0.f, 0.f, 0.f, 0.f, 0.f, 0.f, 0.f, 0.f};
#pragma unroll
            for (int tt = 0; tt < 5; ++tt)
#pragma unroll
                for (int s = 0; s < 2; ++s) {
                    v4u pw; pw.x = pk2(sc[tt][8 * s + 0], sc[tt][8 * s + 1]); pw.y = pk2(sc[tt][8 * s + 2], sc[tt][8 * s + 3]); pw.z = pk2(sc[tt][8 * s + 4], sc[tt][8 * s + 5]); pw.w = pk2(sc[tt][8 * s + 6], sc[tt][8 * s + 7]);
                    const bf16x8 pf = __builtin_bit_cast(bf16x8, pw);
                    const int kb = (qt + tt) * 32 + 16 * s + 4 * hh;
#pragma unroll
                    for (int dt = 0; dt < 2; ++dt) { const LAS bf16* vp = Vt + (dt * 32 + r32) * 260 + kb;
                        const v2u lo = *(const LAS v2u*)(vp), hi = *(const LAS v2u*)(vp + 8);
                        v4u vw; vw.x = lo.x; vw.y = lo.y; vw.z = hi.x; vw.w = hi.y;
                        o[dt] = __builtin_amdgcn_mfma_f32_32x32x16_bf16(__builtin_bit_cast(bf16x8, vw), pf, o[dt], 0, 0, 0); } }
#pragma unroll
            for (int dt = 0; dt < 2; ++dt)
#pragma unroll
                for (int gq = 0; gq < 4; ++gq) { const int d0 = dt * 32 + 8 * gq + 4 * hh;
                    const v2u gw = *(const v2u*)(P + qrow * P0LD + C_GB + hq * 64 + d0);
                    const float g0 = bflo(gw.x), g1 = bfhi(gw.x), g2 = bflo(gw.y), g3 = bfhi(gw.y);
                    v2u ow; ow.x = pk2(o[dt][4 * gq + 0] * inv * siluf_(g0), o[dt][4 * gq + 1] * inv * siluf_(g1)); ow.y = pk2(o[dt][4 * gq + 2] * inv * siluf_(g2), o[dt][4 * gq + 3] * inv * siluf_(g3));
                    *(v2u*)(F.HB + qrow * D + 512 + hq * 64 + d0) = ow; }
        }
        __syncthreads();
    }
}
constexpr int RW_R = 0, RW_W = 4096, RW_KM = 8192, RW_V = 12288, RW_KN = 16384, RW_KA = 20480, RW_G = 24576, RW_TW = 28672, RW_TA = 30720, RW_CT = 32768, RW_RED = 32832;
__device__ __forceinline__ void rwkv_prep(Frame& F, int b, int c, int h) {
    LAS float* L = (LAS float*)F.lds;
    const int tid = F.tid; const bf16* P = F.PROJ; const long rowbase = (long)b * T + c * 64;
#pragma unroll 1
    for (int i = 0; i < 8; ++i) { const int idx = tid + 512 * i, arr = idx >> 11, j = (idx >> 5) & 63, l = idx & 31, col = C_WL + 32 * arr + l;
        const long t = rowbase + j; const float cur = bf2f(P[t * P0LD + col]); const float prev = (c * 64 + j > 0) ? bf2f(P[(t - 1) * P0LD + col]) : 0.f;
        const float sh = cur + F.a_mu[col] * (prev - cur);
        if (arr == 0) L[RW_TW + j * 32 + l] = tanhf(sh); else L[RW_TA + j * 32 + l] = sh; }
    __syncthreads();
    const int ch = tid & 63, jg = tid >> 6, cg = h * 64 + ch;
    const float w0 = F.a_w0[cg], a0 = F.a_a0[cg], kkc = F.a_k_k[cg], kac = F.a_k_a[cg], rk = F.a_r_k[cg];
    const float mu_r = F.a_mu[C_R + cg], mu_k = F.a_mu[C_K + cg], mu_v = F.a_mu[C_V + cg], mu_g = F.a_mu[C_GA + cg];
    const int j0 = jg * 8;
    float pr = 0.f, pk = 0.f, pv = 0.f, pg = 0.f;
    if (c * 64 + j0 > 0) { const bf16* q = P + (rowbase + j0 - 1) * P0LD; pr = bf2f(q[C_R + cg]); pk = bf2f(q[C_K + cg]); pv = bf2f(q[C_V + cg]); pg = bf2f(q[C_GA + cg]); }
#pragma unroll 1
    for (int jj = 0; jj < 8; ++jj) { const int j = j0 + jj; const bf16* q = P + (rowbase + j) * P0LD;
        const float cr = bf2f(q[C_R + cg]), ck = bf2f(q[C_K + cg]), cv = bf2f(q[C_V + cg]), cgt = bf2f(q[C_GA + cg]);
        const float r = cr + mu_r * (pr - cr), k = ck + mu_k * (pk - ck), v = cv + mu_v * (pv - cv), g = cgt + mu_g * (pg - cgt);
        pr = cr; pk = ck; pv = cv; pg = cgt;
        float wpre = w0, apre = a0;
#pragma unroll 4
        for (int l = 0; l < 32; ++l) { wpre += L[RW_TW + j * 32 + l] * F.a_w2[l * 512 + cg]; apre += L[RW_TA + j * 32 + l] * F.a_a2[l * 512 + cg]; }
        const float z = -wpre; const float sp = fmaxf(z, 0.f) + log1pf(expf(-fabsf(z)));
        const float w = -sp - 0.5f; const float decay = expf(-expf(w));
        const float alpha = 1.0f / (1.0f + expf(-apre));
        const float kk = k * kkc; const float ss = wave_sum(kk * kk); const float kkn = kk / fmaxf(sqrtf(ss), 1e-12f);
        const float km = k * (1.0f + (alpha - 1.0f) * kac);
        const float ct = wave_sum(r * km * rk);
        L[RW_R + j * 64 + ch] = r; L[RW_W + j * 64 + ch] = decay; L[RW_KM + j * 64 + ch] = km; L[RW_V + j * 64 + ch] = v;
        L[RW_KN + j * 64 + ch] = kkn; L[RW_KA + j * 64 + ch] = kkn * alpha; L[RW_G + j * 64 + ch] = g;
        if (ch == 0) L[RW_CT + j] = ct; }
    __syncthreads();
}
__device__ __forceinline__ void ph_rwkv_naive(Frame& F) {
    if (blockIdx.x >= 64) return;
    LAS float* L = (LAS float*)F.lds;
    const int bh = blockIdx.x, b = bh >> 3, h = bh & 7, v = F.lane, kq = F.wave;
    float S[8];
#pragma unroll
    for (int i = 0; i < 8; ++i) S[i] = 0.f;
    const float lnw = F.a_ln_w[h * 64 + v], lnb = F.a_ln_b[h * 64 + v];
#pragma unroll 1
    for (int c = 0; c < T / 64; ++c) {
        rwkv_prep(F, b, c, h);
#pragma unroll 1
        for (int j = 0; j < 64; ++j) {
            const int par = j & 1;
            float p1 = 0.f;
#pragma unroll
            for (int i = 0; i < 8; ++i) p1 += S[i] * L[RW_KN + j * 64 + 8 * kq + i];
            L[RW_RED + (par * 2 + 0) * 512 + kq * 64 + v] = p1;
            __syncthreads();
            float sa = 0.f;
#pragma unroll
            for (int q = 0; q < 8; ++q) sa += L[RW_RED + (par * 2 + 0) * 512 + q * 64 + v];
            sa = -sa;
            const float vv = L[RW_V + j * 64 + v];
            float p2 = 0.f;
#pragma unroll
            for (int i = 0; i < 8; ++i) { const int k = 8 * kq + i; S[i] = S[i] * L[RW_W + j * 64 + k] + sa * L[RW_KA + j * 64 + k] + vv * L[RW_KM + j * 64 + k]; p2 += S[i] * L[RW_R + j * 64 + k]; }
            L[RW_RED + (par * 2 + 1) * 512 + kq * 64 + v] = p2;
            __syncthreads();
            if (kq == 0) {
                float y = 0.f;
#pragma unroll
                for (int q = 0; q < 8; ++q) y += L[RW_RED + (par * 2 + 1) * 512 + q * 64 + v];
                const float mean = wave_sum(y) * (1.f / 64.f); const float dd = y - mean; const float var = wave_sum(dd * dd) * (1.f / 64.f);
                float yn = dd * (1.0f / sqrtf(var + 64e-5f)) * lnw + lnb;
                yn += L[RW_CT + j] * vv;
                const float g = L[RW_G + j * 64 + v];
                F.HB[((size_t)b * T + c * 64 + j) * D + h * 64 + v] = (bf16)f2bf(yn * siluf_(g));
            }
        }
        __syncthreads();
    }
}

__device__ __forceinline__ void ph_hgrn_naive(Frame& F) {
    if (blockIdx.x >= 64) return;
    LAS float* L = (LAS float*)F.lds;
    const int bh = blockIdx.x, b = bh >> 3, h = bh & 7, tid = F.tid, v = tid & 127, kq = tid >> 7;
    const bf16* P = F.PROJ;
    float S[32];
#pragma unroll
    for (int i = 0; i < 32; ++i) S[i] = 0.f;
    const float lb = F.lb_tab[h * 128 + v];
    const float cw = F.c_norm_w[v];
#pragma unroll 1
    for (int tb = 0; tb < T / 32; ++tb) {
        const long rowbase = (long)b * T + tb * 32;
#pragma unroll 1
        for (int jj = 0; jj < 8; ++jj) { const int j = kq * 8 + jj; const bf16* q = P + (rowbase + j) * P1LD + h * 128 + v;
            const float qv = bf2f(q[0]), fv = bf2f(q[1024]), iv = bf2f(q[2048]), gv = bf2f(q[3072]);
            const float fg = lb + (1.0f - lb) * sigmoidf_(fv);
            L[j * 128 + v] = siluf_(qv); L[4096 + j * 128 + v] = fg; L[8192 + j * 128 + v] = 1.0f - fg; L[12288 + j * 128 + v] = iv; L[16384 + j * 128 + v] = gv; }
        __syncthreads();
#pragma unroll 1
        for (int j = 0; j < 32; ++j) {
            const float vv = L[12288 + j * 128 + v]; float p = 0.f;
#pragma unroll
            for (int i = 0; i < 32; ++i) { const int k = kq * 32 + i; S[i] = L[4096 + j * 128 + k] * S[i] + L[8192 + j * 128 + k] * vv; p += S[i] * L[j * 128 + k]; }
            L[24576 + (j & 1) * 512 + kq * 128 + v] = p;
            __syncthreads();
            if (kq == 0) L[20480 + j * 128 + v] = (L[24576 + (j & 1) * 512 + v] + L[24576 + (j & 1) * 512 + 128 + v]) + (L[24576 + (j & 1) * 512 + 256 + v] + L[24576 + (j & 1) * 512 + 384 + v]);
        }
        __syncthreads();
#pragma unroll 1
        for (int q = 0; q < 4; ++q) { const int j = F.wave + 8 * q; const int l = F.lane;
            const float o0 = L[20480 + j * 128 + l], o1 = L[20480 + j * 128 + 64 + l];
            const float rs = 1.0f / sqrtf(wave_sum(o0 * o0 + o1 * o1) * (1.f / 128.f) + 1e-6f);
            const float g0 = L[16384 + j * 128 + l], g1 = L[16384 + j * 128 + 64 + l];
            bf16* o = F.HB + (size_t)(rowbase + j) * D + h * 128;
            o[l] = (bf16)f2bf(o0 * rs * F.c_norm_w[l] * siluf_(g0)); o[64 + l] = (bf16)f2bf(o1 * rs * F.c_norm_w[64 + l] * siluf_(g1)); }
        __syncthreads();
    }
    (void)cw;
}

template <bool NEXT> __device__ __forceinline__ void ph_resnorm(Frame& F, const float* xin, const bf16* Y, const float* wpost, float* xo, const float* wpre, bf16* hn) {
    const int gw = F.vcu * NWAVES + F.wave, NGW = F.G * NWAVES, lane = F.lane;
    for (int m = gw; m < M; m += NGW) {
        const v4u* yp = (const v4u*)(Y + (size_t)m * D); const f32x4* xp = (const f32x4*)(xin + (size_t)m * D); f32x4* op = (f32x4*)(xo + (size_t)m * D);
        float yv[16]; float s = 0.f;
#pragma unroll
        for (int j = 0; j < 2; ++j) { const v4u w = yp[lane + 64 * j];
#pragma unroll
            for (int e = 0; e < 4; ++e) { yv[8 * j + 2 * e] = bflo(w[e]); yv[8 * j + 2 * e + 1] = bfhi(w[e]); } }
#pragma unroll
        for (int e = 0; e < 16; ++e) s += yv[e] * yv[e];
        const float rs = 1.0f / sqrtf(wave_sum(s) * (1.f / D) + 1e-6f);
        float x1[16]; float s1 = 0.f;
#pragma unroll
        for (int j = 0; j < 2; ++j)
#pragma unroll
            for (int q = 0; q < 2; ++q) { const int c4 = 2 * (lane + 64 * j) + q; const f32x4 xv = xp[c4]; const f32x4 wv = ((const f32x4*)wpost)[c4]; f32x4 o;
#pragma unroll
                for (int e = 0; e < 4; ++e) { o[e] = xv[e] + yv[8 * j + 4 * q + e] * rs * wv[e]; x1[8 * j + 4 * q + e] = o[e]; s1 += o[e] * o[e]; }
                op[c4] = o; }
        if (NEXT) {
            const float rs1 = 1.0f / sqrtf(wave_sum(s1) * (1.f / D) + 1e-6f);
#pragma unroll
            for (int j = 0; j < 2; ++j) { const int c8 = lane + 64 * j; const f32x4 w0 = ((const f32x4*)wpre)[2 * c8], w1 = ((const f32x4*)wpre)[2 * c8 + 1];
                v4u o; o.x = pk2(x1[8 * j + 0] * rs1 * w0[0], x1[8 * j + 1] * rs1 * w0[1]); o.y = pk2(x1[8 * j + 2] * rs1 * w0[2], x1[8 * j + 3] * rs1 * w0[3]);
                o.z = pk2(x1[8 * j + 4] * rs1 * w1[0], x1[8 * j + 5] * rs1 * w1[1]); o.w = pk2(x1[8 * j + 6] * rs1 * w1[2], x1[8 * j + 7] * rs1 * w1[3]);
                ((v4u*)(hn + (size_t)m * D))[c8] = o; }
        }
    }
}
#ifndef MK_PER_PHASE
#define MK_PER_PHASE 1
#endif
constexpr int N_PHASES = 10;
struct Args { const float* in[23]; float* out; unsigned char* ws; int ph_lo, ph_hi; };
__global__ void __launch_bounds__(NTHR, 2) fwd_kernel(Args args) {
    extern __shared__ __attribute__((aligned(16))) unsigned char lds[];
    Frame F;
    F.lds = (LAS unsigned char*)lds;
    F.tid = threadIdx.x; F.lane = F.tid & 63; F.wave = __builtin_amdgcn_readfirstlane(F.tid >> 6);
    F.G = gridDim.x; { const int bx = blockIdx.x; F.vcu = (F.G % 8 == 0) ? (bx % 8) * (F.G / 8) + bx / 8 : bx; }
    unsigned char* ws = args.ws;
    F.x = args.in[0]; F.rel_bias = args.in[1]; F.lower_bounds = args.in[2]; F.pre0 = args.in[3]; F.post0 = args.in[4]; F.w_in0 = args.in[5]; F.w_out0 = args.in[6];
    F.a_mu = args.in[7]; F.a_w0 = args.in[8]; F.a_w2 = args.in[9]; F.a_a0 = args.in[10]; F.a_a2 = args.in[11]; F.a_k_k = args.in[12]; F.a_k_a = args.in[13]; F.a_r_k = args.in[14];
    F.a_ln_w = args.in[15]; F.a_ln_b = args.in[16]; F.sinks = args.in[17]; F.pre1 = args.in[18]; F.post1 = args.in[19]; F.w_in1 = args.in[20]; F.w_out1 = args.in[21]; F.c_norm_w = args.in[22];
    F.out = args.out;
    F.W0T = (bf16*)(ws + WS_W0T); F.WO0T = (bf16*)(ws + WS_WO0T); F.W1T = (bf16*)(ws + WS_W1T); F.WO1T = (bf16*)(ws + WS_WO1T);
    F.HA = (bf16*)(ws + WS_HA); F.HB = (bf16*)(ws + WS_HB); F.PROJ = (bf16*)(ws + WS_PROJ); F.Y = (bf16*)(ws + WS_Y);
    F.bias_tab = (float*)(ws + WS_TAB); F.lb_tab = (float*)(ws + WS_TAB + 4096);
    for (int u = F.tid; u < (LDS_BYTES - LDSCTL_OFF) / 4; u += NTHR) ((LAS unsigned*)(F.lds + LDSCTL_OFF))[u] = 0u;
    __syncthreads();
    const int lo = args.ph_lo, hi = args.ph_hi;
    XcdBarrier bar; bar.bar = (unsigned*)(ws + WS_CTL) + CW_BAR; bar.x = 0; bar.st = nullptr;
    if (hi - lo > 1) bar = xcd_barrier_post((unsigned*)(ws + WS_CTL) + CW_BAR, (volatile LAS unsigned*)(F.lds + MISC_OFF) + 8);
#define IN(k) (lo <= (k) && (k) < hi)
#define SEAM(k) do { if (IN(k) && IN((k) + 1)) xcd_barrier(bar); } while (0)
    if (IN(0)) { ph_prologue(F); } SEAM(0);
    if (IN(1)) { pg8::Gemm g{F.HA, F.W0T, M, N0P, D}; pg8::StaticOrder S; S.init(M, N0P, F.G, (int)blockIdx.x); pg8::EpiBf16 E{F.PROJ, P0LD};
        pg8::gemm_phase<pg8::EpiBf16, pg8::StaticOrder, true, true>(F.lds, g, S, E); } SEAM(1);
    if (IN(2)) { ph_attention(F); } SEAM(2);
    if (IN(3)) { ph_rwkv_naive(F); } SEAM(3);
    if (IN(4)) { pg8::Gemm g{F.HB, F.WO0T, M, D, D}; pg8::StaticOrder S; S.init(M, D, F.G, (int)blockIdx.x); pg8::EpiBf16 E{F.Y, D};
        pg8::gemm_phase<pg8::EpiBf16, pg8::StaticOrder, true, true>(F.lds, g, S, E); } SEAM(4);
    if (IN(5)) { ph_resnorm<true>(F, F.x, F.Y, F.post0, F.out, F.pre1, F.HA); } SEAM(5);
    if (IN(6)) { pg8::Gemm g{F.HA, F.W1T, M, N1, D}; pg8::StaticOrder S; S.init(M, N1, F.G, (int)blockIdx.x); pg8::EpiBf16 E{F.PROJ, P1LD};
        pg8::gemm_phase<pg8::EpiBf16, pg8::StaticOrder, true, true>(F.lds, g, S, E); } SEAM(6);
    if (IN(7)) { ph_hgrn_naive(F); } SEAM(7);
    if (IN(8)) { pg8::Gemm g{F.HB, F.WO1T, M, D, D}; pg8::StaticOrder S; S.init(M, D, F.G, (int)blockIdx.x); pg8::EpiBf16 E{F.Y, D};
        pg8::gemm_phase<pg8::EpiBf16, pg8::StaticOrder, true, true>(F.lds, g, S, E); } SEAM(8);
    if (IN(9)) { ph_resnorm<false>(F, F.out, F.Y, F.post1, F.out, nullptr, nullptr); }
#undef IN
#undef SEAM
}

extern "C" void kernel_launch(void* const* d_in, const int* in_sizes, int n_in, void* d_out, int out_size, void* d_ws, size_t ws_size, hipStream_t stream) {
    static int grid = 0;
    if (grid == 0) {
        if (n_in != 23 || in_sizes[0] != M * D || out_size != M * D || ws_size < WS_END) { fprintf(stderr, "kernel_launch: unexpected shapes (n_in %d, in0 %d, out %d, ws %zu); nothing launched\n", n_in, n_in > 0 ? in_sizes[0] : -1, out_size, ws_size); grid = -1; return; }
        int dev = 0, cus = 0, per_cu = 0;
        if (hipGetDevice(&dev) != hipSuccess || hipDeviceGetAttribute(&cus, hipDeviceAttributeMultiprocessorCount, dev) != hipSuccess) { grid = -1; return; }
        if (hipFuncSetAttribute((const void*)fwd_kernel, hipFuncAttributeMaxDynamicSharedMemorySize, LDS_BYTES) != hipSuccess) { fprintf(stderr, "kernel_launch: hipFuncSetAttribute failed\n"); grid = -1; return; }
        if (hipOccupancyMaxActiveBlocksPerMultiprocessor(&per_cu, (const void*)fwd_kernel, NTHR, LDS_BYTES) != hipSuccess || per_cu < 1) { fprintf(stderr, "kernel_launch: occupancy query says %d blocks per CU\n", per_cu); (void)hipGetLastError(); grid = -1; return; }
        grid = cus;
    }
    if (grid < 0) return;
    (void)hipMemsetAsync((char*)d_ws + WS_CTL, 0, CTL_ZERO_BYTES, stream);
    Args a{};
    for (int i = 0; i < 23; ++i) a.in[i] = (const float*)d_in[i];
    a.out = (float*)d_out; a.ws = (unsigned char*)d_ws;
#if MK_PER_PHASE
    for (int p = 0; p < N_PHASES; ++p) { a.ph_lo = p; a.ph_hi = p + 1; hipLaunchKernelGGL(fwd_kernel, dim3(grid), dim3(NTHR), LDS_BYTES, stream, a); }
#else
    a.ph_lo = 0; a.ph_hi = N_PHASES; hipLaunchKernelGGL(fwd_kernel, dim3(grid), dim3(NTHR), LDS_BYTES, stream, a);
#endif
}
```

```cpp
#include <hip/hip_runtime.h>
#include <cstdio>
#include <cstdint>
namespace pg8 {
#define PG8_LAS __attribute__((address_space(3)))
typedef unsigned short bf16_t;
typedef short bf16x8 __attribute__((ext_vector_type(8)));
typedef float f32x4 __attribute__((ext_vector_type(4)));
typedef unsigned u32x4 __attribute__((ext_vector_type(4)));
constexpr int BM = 256, BK = 64, HALF = 128, HTB = HALF * BK * 2  , STAGE_BYTES = 8 * HTB, NXCD = 8, WGM = 8;

__host__ __device__ __forceinline__ int lds_byte(int r, int c) { const int st = (r >> 4) * 2 + (c >> 5), rr = r & 15, cc = c & 31, ob = rr * 64 + cc * 2; return st * 1024 + (ob ^ (((ob >> 9) & 1) << 5)); }
__host__ __device__ __forceinline__ void stage_rc(int b, int& R, int& C) { const int st = b / 1024, sb = b % 1024, swz = sb ^ (((sb >> 9) & 1) << 5); R = (st >> 1) * 16 + swz / 64; C = (st & 1) * 32 + (swz % 64) / 2; }
__host__ __device__ __forceinline__ int perm32(int rho) { const int n = rho >> 4, i = rho & 15; return 8 * (i >> 2) + 4 * n + (i & 3); }

struct Unit { int pm, pn; };
struct Gemm { const bf16_t* A; const bf16_t* Bt; int M, N, K; };

struct StaticOrder {
    int nM, nN, nwg, G, c;
    __host__ __device__ void init(int M, int N, int G_, int c_) { nM = M / BM; nN = N / BM; nwg = nM * nN; G = G_; c = c_; }
    __host__ __device__ bool next(int i, Unit& u) const {
        const long L = (long)i * G + c; if (L >= nwg) return false;
        int wgid = (int)L; { const int q = nwg / NXCD, r = nwg % NXCD, xcd = wgid % NXCD, off = wgid / NXCD; wgid = (xcd < r ? xcd * (q + 1) : r * (q + 1) + (xcd - r) * q) + off; }
        const int nig = WGM * nN, gid = wgid / nig, fm = gid * WGM, gsz = (nM - fm) < WGM ? (nM - fm) : WGM;
        u.pm = fm + ((wgid % nig) % gsz); u.pn = (wgid % nig) / gsz; return true;
    }
    __device__ __forceinline__ void a_ready(const Unit&) const {}
    __device__ __forceinline__ void done(const Unit&) const {}
};

__device__ __forceinline__ unsigned cvt_pk_bf16(float lo, float hi) { unsigned r; asm volatile("v_cvt_pk_bf16_f32 %0, %1, %2" : "=v"(r) : "v"(lo), "v"(hi)); return r; }
struct EpiBf16 {
    static constexpr bool PERM = true, AFTER_DRAIN = false;
    bf16_t* O; int ldc;
    __device__ __forceinline__ void operator()(const f32x4 (&acc)[2][2][4][2], const Unit& u, int wr, int wc, int fr, int fq) const {
        const int row0 = u.pm * BM + wr * 64 + fr; const int col0 = u.pn * BM + wc * 32 + 8 * fq;
#pragma unroll
        for (int ai = 0; ai < 2; ++ai)
#pragma unroll
            for (int m = 0; m < 4; ++m) { bf16_t* rowp = O + (size_t)(row0 + ai * HALF + m * 16) * ldc + col0;
#pragma unroll
                for (int bj = 0; bj < 2; ++bj) { const f32x4 v0 = acc[ai][bj][m][0], v1 = acc[ai][bj][m][1];
                    u32x4 w; w.x = cvt_pk_bf16(v0[0], v0[1]); w.y = cvt_pk_bf16(v0[2], v0[3]); w.z = cvt_pk_bf16(v1[0], v1[1]); w.w = cvt_pk_bf16(v1[2], v1[3]);
                    *(u32x4*)(rowp + bj * HALF) = w; } }
    }
};

template <class Epi, class Sched, bool ALIGN_EPI = false, bool SP2 = false>
__device__ __forceinline__ void gemm_phase(PG8_LAS unsigned char* lds, const Gemm g, const Sched& S, const Epi& E) {
    const int tid = threadIdx.x, wid = __builtin_amdgcn_readfirstlane(tid >> 6), lane = tid & 63, wr = wid >> 2, wc = wid & 3, fr = lane & 15, fq = lane >> 4;
    const int K = g.K, nt = K / BK;
    unsigned voffA[2], voffB[2];
#pragma unroll
    for (int i = 0; i < 2; ++i) { int R, C; stage_rc(tid * 16 + i * 8192, R, C); const int Rb = Epi::PERM ? ((R & ~31) + perm32(R & 31)) : R;
        voffA[i] = (unsigned)(R * K + C) * 2u; voffB[i] = (unsigned)(Rb * K + C) * 2u; }
    const size_t kstep = (size_t)(BK * 2);
    const size_t hstep = (size_t)HALF * K * 2;
    const size_t tstep = 2 * hstep;
    const unsigned ldsw = (unsigned)wid * 1024u;
    const int aoff = lds_byte(wr * 64 + fr, fq * 8), boff = lds_byte(wc * 32 + fr, fq * 8);
#define PG8_SA(b, h) (((b) * 2 + (h)) * HTB)
#define PG8_SB(b, h) ((4 + (b) * 2 + (h)) * HTB)
#define PG8_STAGE(bufoff, gbase, voff) do { _Pragma("unroll") for (int _i = 0; _i < 2; ++_i) \
        __builtin_amdgcn_global_load_lds((const unsigned*)((const char*)(gbase) + (voff)[_i]), (PG8_LAS unsigned*)(lds + (bufoff) + ldsw + _i * 8192), 16, 0, 0); } while (0)
#define PG8_LDA(dst, b, h) do { _Pragma("unroll") for (int m = 0; m < 4; ++m) _Pragma("unroll") for (int k = 0; k < 2; ++k) dst[m][k] = *(const PG8_LAS bf16x8*)(lds + PG8_SA(b, h) + aoff + m * 2048 + k * 1024); } while (0)
#define PG8_LDB(dst, b, h) do { _Pragma("unroll") for (int n = 0; n < 2; ++n) _Pragma("unroll") for (int k = 0; k < 2; ++k) dst[n][k] = *(const PG8_LAS bf16x8*)(lds + PG8_SB(b, h) + boff + n * 2048 + k * 1024); } while (0)
#define PG8_MMA(ai, bj, At, Bt) do { __builtin_amdgcn_s_setprio(1); _Pragma("unroll") for (int m = 0; m < 4; ++m) _Pragma("unroll") for (int n = 0; n < 2; ++n) _Pragma("unroll") for (int k = 0; k < 2; ++k) \
        acc[ai][bj][m][n] = __builtin_amdgcn_mfma_f32_16x16x32_bf16(Bt[n][k], At[m][k], acc[ai][bj][m][n], 0, 0, 0); __builtin_amdgcn_s_setprio(0); } while (0)
#define PG8_WAIT_V(n) asm volatile("s_waitcnt vmcnt(" #n ")" ::: "memory")
#define PG8_WAIT_L(n) asm volatile("s_waitcnt lgkmcnt(" #n ")" ::: "memory")
#define PG8_BAR __builtin_amdgcn_s_barrier()
#define PG8_SCHED __builtin_amdgcn_sched_barrier(0)
    Unit cur, nxt; int ui = 0;
    if (!S.next(0, cur)) return;
    f32x4 acc[2][2][4][2];
#pragma unroll
    for (int a = 0; a < 2; ++a)
#pragma unroll
        for (int b = 0; b < 2; ++b)
#pragma unroll
            for (int m = 0; m < 4; ++m)
#pragma unroll
                for (int n = 0; n < 2; ++n) acc[a][b][m][n] = (f32x4){0.f, 0.f, 0.f, 0.f};
    bf16x8 At[4][2], B0[2][2], B1[2][2];
    const char* cA = (const char*)g.A + (size_t)cur.pm * tstep; const char* cB = (const char*)g.Bt + (size_t)cur.pn * tstep;
    S.a_ready(cur);
    if constexpr (SP2) {
        PG8_STAGE(PG8_SB(0, 0), cB, voffB); PG8_STAGE(PG8_SB(0, 1), cB + hstep, voffB); PG8_STAGE(PG8_SA(0, 0), cA, voffA); PG8_STAGE(PG8_SA(0, 1), cA + hstep, voffA);
        if (wr == 1) PG8_BAR;
        PG8_WAIT_V(2); PG8_BAR;
        PG8_STAGE(PG8_SB(1, 0), cB + kstep, voffB); PG8_STAGE(PG8_SA(1, 0), cA + kstep, voffA); PG8_STAGE(PG8_SB(1, 1), cB + hstep + kstep, voffB);
        PG8_WAIT_V(6); PG8_BAR;
    } else {
        PG8_STAGE(PG8_SB(0, 0), cB, voffB); PG8_STAGE(PG8_SA(0, 0), cA, voffA); PG8_STAGE(PG8_SB(0, 1), cB + hstep, voffB); PG8_STAGE(PG8_SA(0, 1), cA + hstep, voffA);
        if (wr == 1) PG8_BAR;
        PG8_WAIT_V(4); PG8_BAR;
        PG8_STAGE(PG8_SB(1, 0), cB + kstep, voffB); PG8_STAGE(PG8_SA(1, 0), cA + kstep, voffA); PG8_STAGE(PG8_SB(1, 1), cB + hstep + kstep, voffB);
        PG8_WAIT_V(6); PG8_BAR;
    }
    for (;;) {
        const bool has_next = S.next(ui + 1, nxt);
        const char* nA = has_next ? (const char*)g.A + (size_t)nxt.pm * tstep : cA; const char* nB = has_next ? (const char*)g.Bt + (size_t)nxt.pn * tstep : cB;
        for (int t = 0; t < nt; t += 2) {
            const bool last = (t == nt - 2);
            const char* a1 = cA + (size_t)(t + 1) * kstep;
            const char* a2 = last ? nA : cA + (size_t)(t + 2) * kstep; const char* b2 = last ? nB : cB + (size_t)(t + 2) * kstep;
            const char* a3 = a2 + kstep; const char* b3 = b2 + kstep;
            if (last && has_next) S.a_ready(nxt);
            if constexpr (SP2) {
            PG8_LDB(B0, 0, 0); PG8_LDB(B1, 0, 1); PG8_SCHED; PG8_LDA(At, 0, 0); PG8_STAGE(PG8_SA(1, 1), a1 + hstep, voffA);
            PG8_WAIT_V(8); PG8_WAIT_L(0); PG8_BAR; PG8_MMA(0, 0, At, B0); PG8_MMA(0, 1, At, B1); PG8_BAR; PG8_SCHED;
            PG8_LDA(At, 0, 1); PG8_STAGE(PG8_SB(0, 0), b2, voffB); PG8_STAGE(PG8_SB(0, 1), b2 + hstep, voffB); PG8_STAGE(PG8_SA(0, 0), a2, voffA);
            PG8_WAIT_V(8); PG8_WAIT_L(0); PG8_BAR; PG8_MMA(1, 0, At, B0); PG8_MMA(1, 1, At, B1); PG8_BAR; PG8_SCHED;
            PG8_LDB(B0, 1, 0); PG8_LDB(B1, 1, 1); PG8_SCHED; PG8_LDA(At, 1, 0); PG8_STAGE(PG8_SA(0, 1), a2 + hstep, voffA);
            PG8_WAIT_V(8); PG8_WAIT_L(0); PG8_BAR; PG8_MMA(0, 0, At, B0); PG8_MMA(0, 1, At, B1); PG8_BAR; PG8_SCHED;
            PG8_LDA(At, 1, 1); PG8_STAGE(PG8_SB(1, 0), b3, voffB); PG8_STAGE(PG8_SB(1, 1), b3 + hstep, voffB); PG8_STAGE(PG8_SA(1, 0), a3, voffA);
            PG8_WAIT_V(8); PG8_WAIT_L(0); PG8_BAR; PG8_MMA(1, 0, At, B0); PG8_MMA(1, 1, At, B1); PG8_BAR; PG8_SCHED;
            } else {
            PG8_LDB(B0, 0, 0); PG8_SCHED; PG8_LDA(At, 0, 0); PG8_STAGE(PG8_SA(1, 1), a1 + hstep, voffA);
            PG8_WAIT_L(8); PG8_BAR; PG8_WAIT_L(0); PG8_MMA(0, 0, At, B0); PG8_BAR; PG8_SCHED;
            PG8_LDB(B1, 0, 1); PG8_STAGE(PG8_SB(0, 0), b2, voffB);
            PG8_BAR; PG8_WAIT_L(0); PG8_MMA(0, 1, At, B1); PG8_BAR;
            PG8_LDA(At, 0, 1); PG8_STAGE(PG8_SA(0, 0), a2, voffA);
            PG8_BAR; PG8_WAIT_L(0); PG8_MMA(1, 0, At, B0); PG8_BAR; PG8_SCHED;
            PG8_STAGE(PG8_SB(0, 1), b2 + hstep, voffB);
            PG8_WAIT_V(6); PG8_BAR; PG8_MMA(1, 1, At, B1); PG8_BAR;
            PG8_LDB(B0, 1, 0); PG8_SCHED; PG8_LDA(At, 1, 0); PG8_STAGE(PG8_SA(0, 1), a2 + hstep, voffA);
            PG8_WAIT_L(8); PG8_BAR; PG8_WAIT_L(0); PG8_MMA(0, 0, At, B0); PG8_BAR; PG8_SCHED;
            PG8_LDB(B1, 1, 1); PG8_STAGE(PG8_SB(1, 0), b3, voffB);
            PG8_BAR; PG8_WAIT_L(0); PG8_MMA(0, 1, At, B1); PG8_BAR;
            PG8_LDA(At, 1, 1); PG8_STAGE(PG8_SA(1, 0), a3, voffA);
            PG8_BAR; PG8_WAIT_L(0); PG8_MMA(1, 0, At, B0); PG8_BAR; PG8_SCHED;
            PG8_STAGE(PG8_SB(1, 1), b3 + hstep, voffB);
            PG8_WAIT_V(6); PG8_BAR; PG8_MMA(1, 1, At, B1); PG8_BAR;
            }
        }
        if constexpr (ALIGN_EPI) { if (wr == 0) PG8_BAR; }
        if constexpr (!Epi::AFTER_DRAIN) { E(acc, cur, wr, wc, fr, fq); S.done(cur); }
        if (!has_next) break;
#pragma unroll
        for (int a = 0; a < 2; ++a)
#pragma unroll
            for (int b = 0; b < 2; ++b)
#pragma unroll
                for (int m = 0; m < 4; ++m)
#pragma unroll
                    for (int n = 0; n < 2; ++n) acc[a][b][m][n] = (f32x4){0.f, 0.f, 0.f, 0.f};
        cur = nxt; cA = nA; cB = nB; ++ui;
        if constexpr (ALIGN_EPI) { if (wr == 1) PG8_BAR; }
    }
    PG8_WAIT_V(0);
    if constexpr (!ALIGN_EPI) { if (wr == 0) PG8_BAR; }
    PG8_BAR;
    if constexpr (Epi::AFTER_DRAIN) { E.fused(acc, cur, wr, wc, fr, fq, lds, wid, lane); S.done(cur); }
#undef PG8_SA
#undef PG8_SB
#undef PG8_STAGE
#undef PG8_LDA
#undef PG8_LDB
#undef PG8_MMA
#undef PG8_WAIT_V
#undef PG8_WAIT_L
#undef PG8_BAR
#undef PG8_SCHED
}
}
constexpr int NWAVES = 8, NTHR = 512;
constexpr int NB = 8, T = 8192, D = 1024, M = NB * T;
constexpr int N0 = 3392, N0P = 3584, N1 = 4096;
constexpr int C_R = 0, C_K = 512, C_V = 1024, C_WL = 1536, C_AL = 1568, C_GA = 1600, C_QB = 2112, C_KB = 2624, C_VB = 2752, C_GB = 2880;
constexpr int P0LD = N0P, P1LD = N1;
constexpr size_t MiB = 1u << 20;
constexpr size_t WS_CTL = 0, CTL_ZERO_BYTES = 65536;
constexpr size_t WS_W0T = 2 * MiB, WS_WO0T = 10 * MiB, WS_W1T = 12 * MiB, WS_WO1T = 20 * MiB, WS_TAB = 23 * MiB;
constexpr size_t WS_HA = 32 * MiB, WS_HB = 160 * MiB, WS_PROJ = 288 * MiB, WS_Y = 800 * MiB, WS_END = 996 * MiB;
constexpr int CW_BAR = 4096;
constexpr int LDS_BYTES = 147456, LDSCTL_OFF = 143360, MISC_OFF = LDSCTL_OFF + 320;

#define GAS __attribute__((address_space(1)))
#define LAS __attribute__((address_space(3)))
typedef unsigned short bf16;
typedef unsigned v4u __attribute__((ext_vector_type(4)));
typedef unsigned v2u __attribute__((ext_vector_type(2)));
typedef float f32x4 __attribute__((ext_vector_type(4)));
typedef float f32x16 __attribute__((ext_vector_type(16)));
typedef short bf16x8 __attribute__((ext_vector_type(8)));
typedef GAS unsigned gu32;
#define RLX_AGENT __ATOMIC_RELAXED, __HIP_MEMORY_SCOPE_AGENT
typedef float f32x2_t __attribute__((ext_vector_type(2))); typedef __bf16 bf16x2_t __attribute__((ext_vector_type(2)));
__device__ __forceinline__ unsigned pk2(float lo, float hi) { const f32x2_t v = {lo, hi}; const bf16x2_t b = __builtin_convertvector(v, bf16x2_t); return __builtin_bit_cast(unsigned, b); }
__device__ __forceinline__ unsigned f2bf(float f) { return pk2(f, 0.f) & 0xffffu; }
__device__ __forceinline__ float bf2f(unsigned v) { return __uint_as_float(v << 16); }
__device__ __forceinline__ float bflo(unsigned w) { return __uint_as_float(w << 16); }
__device__ __forceinline__ float bfhi(unsigned w) { return __uint_as_float(w & 0xffff0000u); }
__device__ __forceinline__ float wave_sum(float v) {
#pragma unroll
    for (int o = 1; o < 64; o <<= 1) v += __shfl_xor(v, o);
    return v;
}
#define LBAR() do { asm volatile("s_waitcnt lgkmcnt(0)" ::: "memory"); __builtin_amdgcn_s_barrier(); asm volatile("" ::: "memory"); } while (0)
__device__ __forceinline__ void gstore8_nowait(void* p, v2u v) { asm volatile("global_store_dwordx2 %0, %1, off\n\ts_nop 1" :: "v"(p), "v"(v) : "memory"); }
__device__ __forceinline__ v4u gload16_asm(const void* p) { v4u r; asm volatile("global_load_dwordx4 %0, %1, off" : "=v"(r) : "v"(p)); return r; }
__device__ __forceinline__ float gload4_asm(const void* p) { float r; asm volatile("global_load_dword %0, %1, off" : "=v"(r) : "v"(p)); return r; }
__device__ __forceinline__ void gstore4_nowait(void* p, float v) { asm volatile("global_store_dword %0, %1, off\n\ts_nop 1" :: "v"(p), "v"(v)); }
__device__ __forceinline__ float frcp(float x) { return __builtin_amdgcn_rcpf(x); }
__device__ __forceinline__ float sigmoidf_(float x) { return frcp(1.0f + __expf(-x)); }
__device__ __forceinline__ float siluf_(float x) { return x * frcp(1.0f + __expf(-x)); }

#define XB_TMO      128
#define XB_XCNT(j)  (256  + 64 * (j))
#define XB_XSUB(j)  (1280 + 64 * (j))
#define XB_XGEN(j)  (2304 + 64 * (j))
#define XB_TOP      3328
#define XB_TOPGEN   3392
#define XCD_BAR_WORDS 3456
#define XB_SPIN_CAP (1u << 24)

__device__ __forceinline__ unsigned xb_ld(unsigned* p)              { return __hip_atomic_load(p, __ATOMIC_RELAXED, __HIP_MEMORY_SCOPE_AGENT); }
__device__ __forceinline__ unsigned xb_add(unsigned* p, unsigned v) { return __hip_atomic_fetch_add(p, v, __ATOMIC_RELAXED, __HIP_MEMORY_SCOPE_AGENT); }
__device__ __forceinline__ unsigned xb_xcc_id() { return (unsigned)__builtin_amdgcn_s_getreg((3 << 11) | 20) & 0xFu; }
#define XB_SPIN(cond, bar) do { unsigned _sp = 0; while (cond) { __builtin_amdgcn_s_sleep(1); \
    if ((++_sp & 255u) == 0u) { if (xb_ld(&(bar)[XB_TMO])) break; if (_sp > XB_SPIN_CAP) { atomicAdd(&(bar)[XB_TMO], 1u); break; } } } } while (0)

struct XcdBarrier {
    unsigned* bar; unsigned x;
    volatile LAS unsigned* st;
};

__device__ __forceinline__ XcdBarrier xcd_barrier_post(unsigned* bar, volatile LAS unsigned* st) {
    XcdBarrier b; b.bar = bar; b.x = xb_xcc_id(); b.st = st;
    if (threadIdx.x == 0) (void)xb_add(&bar[XB_XCNT(b.x)], 1u);
    return b;
}
__device__ __forceinline__ void xcd_barrier_complete(unsigned* bar, unsigned x, unsigned& nloc, unsigned& nx) {
    const unsigned G = gridDim.x * gridDim.y * gridDim.z;
    unsigned sum, cnt, mine, sp = 0u;
    for (;;) {
        sum = 0u; cnt = 0u; mine = 0u;
#pragma unroll
        for (unsigned j = 0; j < 16; ++j) { const unsigned c = xb_ld(&bar[XB_XCNT(j)]); sum += c; cnt += (c > 0u) ? 1u : 0u; mine = (j == x) ? c : mine; }
        if (sum == G) break;
        __builtin_amdgcn_s_sleep(1);
        if ((++sp & 255u) == 0u) { if (xb_ld(&bar[XB_TMO])) break; if (sp > XB_SPIN_CAP) { atomicAdd(&bar[XB_TMO], 1u); break; } }
    }
    nloc = mine > 0u ? mine : 1u; nx = cnt > 0u ? cnt : 1u;
}

__device__ __forceinline__ void xcd_barrier(const XcdBarrier& b) {
    asm volatile("s_waitcnt vmcnt(0)" ::: "memory");
    __syncthreads();
    if (threadIdx.x == 0) {
        unsigned* bar = b.bar;
        __builtin_amdgcn_s_waitcnt(0);
        unsigned nloc = b.st[0], nx = b.st[1];
        if (nloc == 0u) { xcd_barrier_complete(bar, b.x, nloc, nx); b.st[0] = nloc; b.st[1] = nx; }
        const unsigned old = xb_add(&bar[XB_XSUB(b.x)], 1u);
        const unsigned gen = old / nloc;
        if (old + 1u == (gen + 1u) * nloc) {
            __builtin_amdgcn_fence(__ATOMIC_RELEASE, "agent");
            asm volatile("s_waitcnt vmcnt(0)" ::: "memory");
            const unsigned og = xb_add(&bar[XB_TOP], 1u);
            const unsigned tg = og / nx;
            if (og + 1u == (tg + 1u) * nx) xb_add(&bar[XB_TOPGEN], 1u);
            else XB_SPIN(xb_ld(&bar[XB_TOPGEN]) == tg, bar);
            __builtin_amdgcn_fence(__ATOMIC_ACQUIRE, "agent");
            xb_add(&bar[XB_XGEN(b.x)], 1u);
            asm volatile("s_waitcnt vmcnt(0)" ::: "memory");
        } else {
            XB_SPIN(xb_ld(&bar[XB_XGEN(b.x)]) == gen, bar);
            __builtin_amdgcn_fence(__ATOMIC_ACQUIRE, "agent");
            asm volatile("s_waitcnt vmcnt(0)" ::: "memory");
        }
    }
    __syncthreads();
}
struct Frame {
    LAS unsigned char* lds;
    int tid, lane, wave, vcu, G;
    const float* x; float* out;
    const float *rel_bias, *lower_bounds, *pre0, *post0, *w_in0, *w_out0, *a_mu, *a_w0, *a_w2, *a_a0, *a_a2, *a_k_k, *a_k_a, *a_r_k, *a_ln_w, *a_ln_b, *sinks, *pre1, *post1, *w_in1, *w_out1, *c_norm_w;
    bf16 *W0T, *WO0T, *W1T, *WO1T, *HA, *HB, *PROJ, *Y;
    float *bias_tab, *lb_tab;
};

__device__ __forceinline__ void p0_transpose_item(const float* W, int K, int N, bf16* WT, LAS float* scr, int item, int lane) {
    const int nblk = N / 32, kb = item / nblk, nb = item % nblk, k0 = 64 * kb, n0 = 32 * nb;
#pragma unroll 8
    for (int i = 0; i < 32; ++i) { const int kk = 2 * i + (lane >> 5); scr[kk * 33 + (lane & 31)] = W[(size_t)(k0 + kk) * N + n0 + (lane & 31)]; }
    asm volatile("s_waitcnt lgkmcnt(0)" ::: "memory");
    const int c = lane & 7;
#pragma unroll
    for (int j = 0; j < 4; ++j) { const int n = (lane >> 3) + 8 * j; const LAS float* s = scr + (8 * c) * 33 + n;
        v4u o; o.x = pk2(s[0 * 33], s[1 * 33]); o.y = pk2(s[2 * 33], s[3 * 33]); o.z = pk2(s[4 * 33], s[5 * 33]); o.w = pk2(s[6 * 33], s[7 * 33]);
        *(v4u*)(WT + (size_t)(n0 + n) * K + k0 + 8 * c) = o; }
    asm volatile("s_waitcnt lgkmcnt(0)" ::: "memory");
}
__device__ __forceinline__ void rms_row_to_bf16(const float* xrow, const float* w, bf16* orow, int lane) {
    const f32x4* xr = (const f32x4*)xrow + lane; const f32x4* wr = (const f32x4*)w + lane;
    f32x4 v[4]; float s = 0.f;
#pragma unroll
    for (int j = 0; j < 4; ++j) { v[j] = xr[64 * j]; s += (v[j].x * v[j].x + v[j].y * v[j].y) + (v[j].z * v[j].z + v[j].w * v[j].w); }
    const float rs = 1.0f / sqrtf(wave_sum(s) * (1.f / D) + 1e-6f);
    v2u* o8 = (v2u*)orow + lane;
#pragma unroll
    for (int j = 0; j < 4; ++j) { const f32x4 g = wr[64 * j]; v2u o; o.x = pk2(v[j].x * rs * g.x, v[j].y * rs * g.y); o.y = pk2(v[j].z * rs * g.z, v[j].w * rs * g.w); o8[64 * j] = o; }
}
__device__ __forceinline__ int t5_bucket(int d) {
    if (d < 16) return d;
    int b = 16;
    b += (d >= 19) + (d >= 21) + (d >= 24) + (d >= 27) + (d >= 31) + (d >= 35) + (d >= 40) + (d >= 46) + (d >= 52) + (d >= 59) + (d >= 67) + (d >= 77) + (d >= 87) + (d >= 99) + (d >= 113);
    return b;
}
__device__ __forceinline__ void ph_prologue(Frame& F, unsigned char* ws) {
    LAS float* scr = (LAS float*)(F.lds + F.wave * 16384);
    const int gw = F.vcu * NWAVES + F.wave, NGW = F.G * NWAVES;
    constexpr int I_0 = (D / 64) * (N0 / 32), I_O = (D / 64) * (D / 32), I_1 = (D / 64) * (N1 / 32);
    constexpr int NITEMS = I_0 + I_O + I_1 + I_O;
    for (int it = gw; it < NITEMS; it += NGW) {
        int r = it;
        if (r < I_0) { p0_transpose_item(F.w_in0, D, N0, F.W0T, scr, r, F.lane); continue; } r -= I_0;
        if (r < I_O) { p0_transpose_item(F.w_out0, D, D, F.WO0T, scr, r, F.lane); continue; } r -= I_O;
        if (r < I_1) { p0_transpose_item(F.w_in1, D, N1, F.W1T, scr, r, F.lane); continue; } r -= I_1;
        p0_transpose_item(F.w_out1, D, D, F.WO1T, scr, r, F.lane);
    }
    for (int i = gw * 64 + F.lane; i < (N0P - N0) * D / 8; i += NGW * 64) ((v4u*)(F.W0T + (size_t)N0 * D))[i] = (v4u){0u, 0u, 0u, 0u};
    {
        const int lane = F.lane; f32x4 g[4];
#pragma unroll
        for (int j = 0; j < 4; ++j) g[j] = ((const f32x4*)F.pre0 + lane)[64 * j];
        f32x4 a0[4], a1[4], b0[4], b1[4];
#define PRO_LD(v, mm) do { if ((mm) < M) { const f32x4* xr_ = (const f32x4*)(F.x + (size_t)(mm) * D) + lane; _Pragma("unroll") for (int j = 0; j < 4; ++j) v[j] = xr_[64 * j]; } } while (0)
#define PRO_PR(v, mm) do { if ((mm) < M) { float s_ = 0.f; _Pragma("unroll") for (int j = 0; j < 4; ++j) s_ += (v[j].x * v[j].x + v[j].y * v[j].y) + (v[j].z * v[j].z + v[j].w * v[j].w); \
            const float rs_ = 1.0f / sqrtf(wave_sum(s_) * (1.f / D) + 1e-6f); v2u* o8_ = (v2u*)(F.HA + (size_t)(mm) * D) + lane; \
            _Pragma("unroll") for (int j = 0; j < 4; ++j) { v2u o_; o_.x = pk2(v[j].x * rs_ * g[j].x, v[j].y * rs_ * g[j].y); o_.y = pk2(v[j].z * rs_ * g[j].z, v[j].w * rs_ * g[j].w); o8_[64 * j] = o_; } } } while (0)
        int m = gw; PRO_LD(a0, m); PRO_LD(a1, m + NGW);
#pragma unroll 1
        for (; m < M; m += 4 * NGW) {
            PRO_LD(b0, m + 2 * NGW); PRO_LD(b1, m + 3 * NGW);
            PRO_PR(a0, m); PRO_PR(a1, m + NGW);
            PRO_LD(a0, m + 4 * NGW); PRO_LD(a1, m + 5 * NGW);
            PRO_PR(b0, m + 2 * NGW); PRO_PR(b1, m + 3 * NGW);
        }
#undef PRO_LD
#undef PRO_PR
    }
    const int gt = blockIdx.x * NTHR + F.tid;
    if (gt < 1024) { const int h = gt >> 7, d = gt & 127; F.bias_tab[gt] = F.rel_bias[t5_bucket(d) * 8 + h];
        F.lb_tab[gt] = 1.0f / (1.0f + expf(F.lower_bounds[gt] - F.lower_bounds[1024 + gt])); }
    if (gt < 16384) { const int cc = gt >> 5, l = gt & 31; ((bf16*)(ws + WS_TAB + 8192))[gt] = (bf16)f2bf(F.a_w2[l * 512 + cc]); ((bf16*)(ws + WS_TAB + 8192 + 32768))[gt] = (bf16)f2bf(F.a_a2[l * 512 + cc]); }
}

__device__ __forceinline__ void ph_attention(Frame& F) {
    LAS bf16* Ks = (LAS bf16*)(F.lds);
    LAS bf16* Vt = (LAS bf16*)(F.lds + 36864);
    LAS float* Bt = (LAS float*)(F.lds + 36864 + 33280);
    const int tid = F.tid, lane = F.lane, wave = F.wave, r32 = lane & 31, hh = lane >> 5;
    const bf16* P = F.PROJ;
    const int row = tid >> 1, half = tid & 1;
    v4u kv[4], vv[4];
#define AT_LOADKV(u_) do { const int hkv_ = (u_) & 1, nb_ = ((u_) >> 1) & 63, b_ = (u_) >> 7; const long grow_ = (long)b_ * T + nb_ * 128 - 128 + row; \
        if ((nb_ > 0) || (row >= 128)) { const v4u* kp_ = (const v4u*)(P + grow_ * P0LD + C_KB + hkv_ * 64 + half * 32); const v4u* vp_ = (const v4u*)(P + grow_ * P0LD + C_VB + hkv_ * 64 + half * 32); \
            _Pragma("unroll") for (int i_ = 0; i_ < 4; ++i_) { kv[i_] = kp_[i_]; vv[i_] = vp_[i_]; } } \
        else { _Pragma("unroll") for (int i_ = 0; i_ < 4; ++i_) { kv[i_] = (v4u){0u, 0u, 0u, 0u}; vv[i_] = (v4u){0u, 0u, 0u, 0u}; } } } while (0)
    int u = blockIdx.x;
    if (u < 1024) AT_LOADKV(u);
    for (; u < 1024; u += F.G) {
        const int hkv = u & 1, nb = (u >> 1) & 63, b = u >> 7;
        bf16x8 qf0[4], qf1[4];
#define AT_QLOAD(ii_, qf_) do { const int item_ = wave * 2 + (ii_), g_ = item_ >> 2, qt_ = item_ & 3, hq_ = hkv * 4 + g_; \
            const bf16* qp_ = P + ((long)b * T + nb * 128 + qt_ * 32 + r32) * P0LD + C_QB + hq_ * 64 + hh * 8; \
            _Pragma("unroll") for (int s_ = 0; s_ < 4; ++s_) qf_[s_] = *(const bf16x8*)(qp_ + 16 * s_); } while (0)
        AT_QLOAD(0, qf0); AT_QLOAD(1, qf1);
        {
#pragma unroll
            for (int i = 0; i < 4; ++i) *(LAS v4u*)(Ks + row * 72 + half * 32 + 8 * i) = kv[i];
#pragma unroll
            for (int i = 0; i < 4; ++i)
#pragma unroll
                for (int e = 0; e < 4; ++e) { const unsigned w = vv[i][e]; const int d = half * 32 + 8 * i + 2 * e;
                    Vt[d * 260 + row] = (bf16)(w & 0xffffu); Vt[(d + 1) * 260 + row] = (bf16)(w >> 16); }
            for (int x = tid; x < 768; x += NTHR) { const int g = x / 192, e = x - g * 192 - 32; Bt[x] = (e >= 0 && e < 128) ? F.bias_tab[(hkv * 4 + g) * 128 + e] * 1.44269504f : 0.f; }
        }
        LBAR();
        if (u + F.G < 1024) AT_LOADKV(u + F.G);
#define AT_ITEM(ii, qf) do { \
            const int item = wave * 2 + ii, g = item >> 2, qt = item & 3, hq = hkv * 4 + g; \
            const long qrow = (long)b * T + nb * 128 + qt * 32 + r32; \
            v2u gwv[2][4]; \
            _Pragma("unroll") \
            for (int dt = 0; dt < 2; ++dt) \
            _Pragma("unroll") \
                for (int gq = 0; gq < 4; ++gq) gwv[dt][gq] = *(const v2u*)(P + qrow * P0LD + C_GB + hq * 64 + dt * 32 + 8 * gq + 4 * hh); \
            f32x16 sc[5]; \
            _Pragma("unroll") \
            for (int tt = 0; tt < 5; ++tt) { f32x16 acc = {0.f, 0.f, 0.f, 0.f, 0.f, 0.f, 0.f, 0.f, 0.f, 0.f, 0.f, 0.f, 0.f, 0.f, 0.f, 0.f}; \
            _Pragma("unroll") \
                for (int s = 0; s < 4; ++s) { const bf16x8 kf = *(const LAS bf16x8*)(Ks + ((qt + tt) * 32 + r32) * 72 + 16 * s + 8 * hh); \
                    acc = __builtin_amdgcn_mfma_f32_32x32x16_bf16(kf, qf[s], acc, 0, 0, 0); } \
                sc[tt] = acc; } \
              \
              \
            const int dl = r32 - 4 * hh; const LAS float* bp = Bt + g * 192 + (dl + 5); const float sink2 = F.sinks[hq] * 1.44269504f; \
            float mx = sink2; \
            _Pragma("unroll") \
            for (int tt = 0; tt < 5; ++tt) { \
                if ((nb == 0) && (qt + tt < 4)) { \
            _Pragma("unroll") \
                    for (int i = 0; i < 16; ++i) sc[tt][i] = -1e30f; } \
                else { \
            _Pragma("unroll") \
                    for (int i = 0; i < 16; ++i) { const int c = (i & 3) + 8 * (i >> 2); \
                        float s = sc[tt][i] * (0.125f * 1.44269504f) + bp[155 - 32 * tt - c]; \
                        if (tt == 0) s = (c > dl) ? s : -1e30f; \
                        if (tt == 4) s = (c <= dl) ? s : -1e30f; \
                        sc[tt][i] = s; mx = fmaxf(mx, s); } } } \
            mx = fmaxf(mx, __shfl_xor(mx, 32)); \
            float sum = 0.f; \
            _Pragma("unroll") \
            for (int tt = 0; tt < 5; ++tt) \
            _Pragma("unroll") \
                for (int i = 0; i < 16; ++i) { const float p = __builtin_amdgcn_exp2f(sc[tt][i] - mx); sc[tt][i] = p; sum += p; } \
            sum += __shfl_xor(sum, 32); \
            const float inv = frcp(sum + __builtin_amdgcn_exp2f(sink2 - mx)); \
            f32x16 o[2]; \
            _Pragma("unroll") \
            for (int dt = 0; dt < 2; ++dt) o[dt] = (f32x16){0.f, 0.f, 0.f, 0.f, 0.f, 0.f, 0.f, 0.f, 0.f, 0.f, 0.f, 0.f, 0.f, 0.f, 0.f, 0.f}; \
            _Pragma("unroll") \
            for (int tt = 0; tt < 5; ++tt) \
            _Pragma("unroll") \
                for (int s = 0; s < 2; ++s) { \
                    v4u pw; pw.x = pk2(sc[tt][8 * s + 0], sc[tt][8 * s + 1]); pw.y = pk2(sc[tt][8 * s + 2], sc[tt][8 * s + 3]); pw.z = pk2(sc[tt][8 * s + 4], sc[tt][8 * s + 5]); pw.w = pk2(sc[tt][8 * s + 6], sc[tt][8 * s + 7]); \
                    const bf16x8 pf = __builtin_bit_cast(bf16x8, pw); \
                    const int kb = (qt + tt) * 32 + 16 * s + 4 * hh; \
            _Pragma("unroll") \
                    for (int dt = 0; dt < 2; ++dt) { const LAS bf16* vp = Vt + (dt * 32 + r32) * 260 + kb; \
                        const v2u lo = *(const LAS v2u*)(vp), hi = *(const LAS v2u*)(vp + 8); \
                        v4u vw; vw.x = lo.x; vw.y = lo.y; vw.z = hi.x; vw.w = hi.y; \
                        o[dt] = __builtin_amdgcn_mfma_f32_32x32x16_bf16(__builtin_bit_cast(bf16x8, vw), pf, o[dt], 0, 0, 0); } } \
            _Pragma("unroll") \
            for (int dt = 0; dt < 2; ++dt) \
            _Pragma("unroll") \
                for (int gq = 0; gq < 4; ++gq) { const int d0 = dt * 32 + 8 * gq + 4 * hh; const v2u gv = gwv[dt][gq]; \
                    const float g0 = bflo(gv.x), g1 = bfhi(gv.x), g2 = bflo(gv.y), g3 = bfhi(gv.y); \
                    v2u ow; ow.x = pk2(o[dt][4 * gq + 0] * inv * siluf_(g0), o[dt][4 * gq + 1] * inv * siluf_(g1)); ow.y = pk2(o[dt][4 * gq + 2] * inv * siluf_(g2), o[dt][4 * gq + 3] * inv * siluf_(g3)); \
                    *(v2u*)(F.HB + qrow * D + 512 + hq * 64 + d0) = ow; } \
        } while (0)
#pragma unroll 1
        for (int ii = 0; ii < 2; ++ii) { bf16x8 qf[4];
#pragma unroll
            for (int s = 0; s < 4; ++s) qf[s] = ii ? qf1[s] : qf0[s];
            AT_ITEM(ii, qf); }
        LBAR();
    }
#undef AT_LOADKV
#undef AT_QLOAD
#undef AT_ITEM
}
constexpr int RW_R = 0, RW_W = 4096, RW_KM = 8192, RW_V = 12288, RW_KN = 16384, RW_KA = 20480, RW_G = 24576, RW_TW = 28672, RW_TA = 30720, RW_CT = 32768, RW_RED = 32832;
__device__ __forceinline__ void rwkv_prep(Frame& F, int b, int c, int h) {
    LAS float* L = (LAS float*)F.lds;
    const int tid = F.tid; const bf16* P = F.PROJ; const long rowbase = (long)b * T + c * 64;
#pragma unroll 1
    for (int i = 0; i < 8; ++i) { const int idx = tid + 512 * i, arr = idx >> 11, j = (idx >> 5) & 63, l = idx & 31, col = C_WL + 32 * arr + l;
        const long t = rowbase + j; const float cur = bf2f(P[t * P0LD + col]); const float prev = (c * 64 + j > 0) ? bf2f(P[(t - 1) * P0LD + col]) : 0.f;
        const float sh = cur + F.a_mu[col] * (prev - cur);
        if (arr == 0) L[RW_TW + j * 32 + l] = tanhf(sh); else L[RW_TA + j * 32 + l] = sh; }
    __syncthreads();
    const int ch = tid & 63, jg = tid >> 6, cg = h * 64 + ch;
    const float w0 = F.a_w0[cg], a0 = F.a_a0[cg], kkc = F.a_k_k[cg], kac = F.a_k_a[cg], rk = F.a_r_k[cg];
    const float mu_r = F.a_mu[C_R + cg], mu_k = F.a_mu[C_K + cg], mu_v = F.a_mu[C_V + cg], mu_g = F.a_mu[C_GA + cg];
    const int j0 = jg * 8;
    float pr = 0.f, pk = 0.f, pv = 0.f, pg = 0.f;
    if (c * 64 + j0 > 0) { const bf16* q = P + (rowbase + j0 - 1) * P0LD; pr = bf2f(q[C_R + cg]); pk = bf2f(q[C_K + cg]); pv = bf2f(q[C_V + cg]); pg = bf2f(q[C_GA + cg]); }
#pragma unroll 1
    for (int jj = 0; jj < 8; ++jj) { const int j = j0 + jj; const bf16* q = P + (rowbase + j) * P0LD;
        const float cr = bf2f(q[C_R + cg]), ck = bf2f(q[C_K + cg]), cv = bf2f(q[C_V + cg]), cgt = bf2f(q[C_GA + cg]);
        const float r = cr + mu_r * (pr - cr), k = ck + mu_k * (pk - ck), v = cv + mu_v * (pv - cv), g = cgt + mu_g * (pg - cgt);
        pr = cr; pk = ck; pv = cv; pg = cgt;
        float wpre = w0, apre = a0;
#pragma unroll 4
        for (int l = 0; l < 32; ++l) { wpre += L[RW_TW + j * 32 + l] * F.a_w2[l * 512 + cg]; apre += L[RW_TA + j * 32 + l] * F.a_a2[l * 512 + cg]; }
        const float z = -wpre; const float sp = fmaxf(z, 0.f) + log1pf(expf(-fabsf(z)));
        const float w = -sp - 0.5f; const float decay = expf(-expf(w));
        const float alpha = 1.0f / (1.0f + expf(-apre));
        const float kk = k * kkc; const float ss = wave_sum(kk * kk); const float kkn = kk / fmaxf(sqrtf(ss), 1e-12f);
        const float km = k * (1.0f + (alpha - 1.0f) * kac);
        const float ct = wave_sum(r * km * rk);
        L[RW_R + j * 64 + ch] = r; L[RW_W + j * 64 + ch] = decay; L[RW_KM + j * 64 + ch] = km; L[RW_V + j * 64 + ch] = v;
        L[RW_KN + j * 64 + ch] = kkn; L[RW_KA + j * 64 + ch] = kkn * alpha; L[RW_G + j * 64 + ch] = g;
        if (ch == 0) L[RW_CT + j] = ct; }
    __syncthreads();
}
__device__ __forceinline__ void ph_rwkv_naive(Frame& F) {
    if (blockIdx.x >= 64) return;
    LAS float* L = (LAS float*)F.lds;
    const int bh = blockIdx.x, b = bh >> 3, h = bh & 7, v = F.lane, kq = F.wave;
    float S[8];
#pragma unroll
    for (int i = 0; i < 8; ++i) S[i] = 0.f;
    const float lnw = F.a_ln_w[h * 64 + v], lnb = F.a_ln_b[h * 64 + v];
#pragma unroll 1
    for (int c = 0; c < T / 64; ++c) {
        rwkv_prep(F, b, c, h);
#pragma unroll 1
        for (int j = 0; j < 64; ++j) {
            const int par = j & 1;
            float p1 = 0.f;
#pragma unroll
            for (int i = 0; i < 8; ++i) p1 += S[i] * L[RW_KN + j * 64 + 8 * kq + i];
            L[RW_RED + (par * 2 + 0) * 512 + kq * 64 + v] = p1;
            __syncthreads();
            float sa = 0.f;
#pragma unroll
            for (int q = 0; q < 8; ++q) sa += L[RW_RED + (par * 2 + 0) * 512 + q * 64 + v];
            sa = -sa;
            const float vv = L[RW_V + j * 64 + v];
            float p2 = 0.f;
#pragma unroll
            for (int i = 0; i < 8; ++i) { const int k = 8 * kq + i; S[i] = S[i] * L[RW_W + j * 64 + k] + sa * L[RW_KA + j * 64 + k] + vv * L[RW_KM + j * 64 + k]; p2 += S[i] * L[RW_R + j * 64 + k]; }
            L[RW_RED + (par * 2 + 1) * 512 + kq * 64 + v] = p2;
            __syncthreads();
            if (kq == 0) {
                float y = 0.f;
#pragma unroll
                for (int q = 0; q < 8; ++q) y += L[RW_RED + (par * 2 + 1) * 512 + q * 64 + v];
                const float mean = wave_sum(y) * (1.f / 64.f); const float dd = y - mean; const float var = wave_sum(dd * dd) * (1.f / 64.f);
                float yn = dd * (1.0f / sqrtf(var + 64e-5f)) * lnw + lnb;
                yn += L[RW_CT + j] * vv;
                const float g = L[RW_G + j * 64 + v];
                F.HB[((size_t)b * T + c * 64 + j) * D + h * 64 + v] = (bf16)f2bf(yn * siluf_(g));
            }
        }
        __syncthreads();
    }
}

__device__ __forceinline__ void ph_hgrn_naive(Frame& F) {
    if (blockIdx.x >= 64) return;
    LAS float* L = (LAS float*)F.lds;
    const int bh = blockIdx.x, b = bh >> 3, h = bh & 7, tid = F.tid, v = tid & 127, kq = tid >> 7;
    const bf16* P = F.PROJ;
    float S[32];
#pragma unroll
    for (int i = 0; i < 32; ++i) S[i] = 0.f;
    const float lb = F.lb_tab[h * 128 + v];
    const float cw = F.c_norm_w[v];
#pragma unroll 1
    for (int tb = 0; tb < T / 32; ++tb) {
        const long rowbase = (long)b * T + tb * 32;
#pragma unroll 1
        for (int jj = 0; jj < 8; ++jj) { const int j = kq * 8 + jj; const bf16* q = P + (rowbase + j) * P1LD + h * 128 + v;
            const float qv = bf2f(q[0]), fv = bf2f(q[1024]), iv = bf2f(q[2048]), gv = bf2f(q[3072]);
            const float fg = lb + (1.0f - lb) * sigmoidf_(fv);
            L[j * 128 + v] = siluf_(qv); L[4096 + j * 128 + v] = fg; L[8192 + j * 128 + v] = 1.0f - fg; L[12288 + j * 128 + v] = iv; L[16384 + j * 128 + v] = gv; }
        __syncthreads();
#pragma unroll 1
        for (int j = 0; j < 32; ++j) {
            const float vv = L[12288 + j * 128 + v]; float p = 0.f;
#pragma unroll
            for (int i = 0; i < 32; ++i) { const int k = kq * 32 + i; S[i] = L[4096 + j * 128 + k] * S[i] + L[8192 + j * 128 + k] * vv; p += S[i] * L[j * 128 + k]; }
            L[24576 + (j & 1) * 512 + kq * 128 + v] = p;
            __syncthreads();
            if (kq == 0) L[20480 + j * 128 + v] = (L[24576 + (j & 1) * 512 + v] + L[24576 + (j & 1) * 512 + 128 + v]) + (L[24576 + (j & 1) * 512 + 256 + v] + L[24576 + (j & 1) * 512 + 384 + v]);
        }
        __syncthreads();
#pragma unroll 1
        for (int q = 0; q < 4; ++q) { const int j = F.wave + 8 * q; const int l = F.lane;
            const float o0 = L[20480 + j * 128 + l], o1 = L[20480 + j * 128 + 64 + l];
            const float rs = 1.0f / sqrtf(wave_sum(o0 * o0 + o1 * o1) * (1.f / 128.f) + 1e-6f);
            const float g0 = L[16384 + j * 128 + l], g1 = L[16384 + j * 128 + 64 + l];
            bf16* o = F.HB + (size_t)(rowbase + j) * D + h * 128;
            o[l] = (bf16)f2bf(o0 * rs * F.c_norm_w[l] * siluf_(g0)); o[64 + l] = (bf16)f2bf(o1 * rs * F.c_norm_w[64 + l] * siluf_(g1)); }
        __syncthreads();
    }
    (void)cw;
}

__device__ __forceinline__ void ph_resnorm0(Frame& F, const float* xin, bf16* YX, const float* wpost, const float* wpre, bf16* hn) {
    const int gw = F.vcu * NWAVES + F.wave, NGW = F.G * NWAVES, lane = F.lane;
    for (int m = gw; m < M; m += NGW) {
        v4u* yp = (v4u*)(YX + (size_t)m * D); const f32x4* xp = (const f32x4*)(xin + (size_t)m * D);
        float yv[16]; float s = 0.f;
#pragma unroll
        for (int j = 0; j < 2; ++j) { const v4u w = yp[lane + 64 * j];
#pragma unroll
            for (int e = 0; e < 4; ++e) { yv[8 * j + 2 * e] = bflo(w[e]); yv[8 * j + 2 * e + 1] = bfhi(w[e]); } }
#pragma unroll
        for (int e = 0; e < 16; ++e) s += yv[e] * yv[e];
        const float rs = __builtin_amdgcn_rsqf(wave_sum(s) * (1.f / D) + 1e-6f);
        float x1[16]; float s1 = 0.f;
#pragma unroll
        for (int j = 0; j < 2; ++j)
#pragma unroll
            for (int q = 0; q < 2; ++q) { const int c4 = 2 * (lane + 64 * j) + q; const f32x4 xv = xp[c4]; const f32x4 wv = ((const f32x4*)wpost)[c4];
#pragma unroll
                for (int e = 0; e < 4; ++e) { const float o = xv[e] + yv[8 * j + 4 * q + e] * rs * wv[e]; x1[8 * j + 4 * q + e] = o; s1 += o * o; } }
        const float rs1 = __builtin_amdgcn_rsqf(wave_sum(s1) * (1.f / D) + 1e-6f);
#pragma unroll
        for (int j = 0; j < 2; ++j) { const int c8 = lane + 64 * j; const f32x4 w0 = ((const f32x4*)wpre)[2 * c8], w1 = ((const f32x4*)wpre)[2 * c8 + 1];
            v4u xo; xo.x = pk2(x1[8 * j + 0], x1[8 * j + 1]); xo.y = pk2(x1[8 * j + 2], x1[8 * j + 3]); xo.z = pk2(x1[8 * j + 4], x1[8 * j + 5]); xo.w = pk2(x1[8 * j + 6], x1[8 * j + 7]);
            yp[c8] = xo;
            v4u o; o.x = pk2(x1[8 * j + 0] * rs1 * w0[0], x1[8 * j + 1] * rs1 * w0[1]); o.y = pk2(x1[8 * j + 2] * rs1 * w0[2], x1[8 * j + 3] * rs1 * w0[3]);
            o.z = pk2(x1[8 * j + 4] * rs1 * w1[0], x1[8 * j + 5] * rs1 * w1[1]); o.w = pk2(x1[8 * j + 6] * rs1 * w1[2], x1[8 * j + 7] * rs1 * w1[3]);
            ((v4u*)(hn + (size_t)m * D))[c8] = o; }
    }
}
__device__ __forceinline__ void ph_resnorm1(Frame& F, const bf16* X1, const bf16* Y, const float* wpost, float* out) {
    const int gw = F.vcu * NWAVES + F.wave, NGW = F.G * NWAVES, lane = F.lane;
    for (int m = gw; m < M; m += NGW) {
        const v4u* yp = (const v4u*)(Y + (size_t)m * D); const v4u* xp = (const v4u*)(X1 + (size_t)m * D); f32x4* op = (f32x4*)(out + (size_t)m * D);
        float yv[16], xv[16]; float s = 0.f;
#pragma unroll
        for (int j = 0; j < 2; ++j) { const v4u w = yp[lane + 64 * j], xw = xp[lane + 64 * j];
#pragma unroll
            for (int e = 0; e < 4; ++e) { yv[8 * j + 2 * e] = bflo(w[e]); yv[8 * j + 2 * e + 1] = bfhi(w[e]); xv[8 * j + 2 * e] = bflo(xw[e]); xv[8 * j + 2 * e + 1] = bfhi(xw[e]); } }
#pragma unroll
        for (int e = 0; e < 16; ++e) s += yv[e] * yv[e];
        const float rs = __builtin_amdgcn_rsqf(wave_sum(s) * (1.f / D) + 1e-6f);
#pragma unroll
        for (int j = 0; j < 2; ++j)
#pragma unroll
            for (int q = 0; q < 2; ++q) { const int c4 = 2 * (lane + 64 * j) + q; const f32x4 wv = ((const f32x4*)wpost)[c4]; f32x4 o;
#pragma unroll
                for (int e = 0; e < 4; ++e) o[e] = xv[8 * j + 4 * q + e] + yv[8 * j + 4 * q + e] * rs * wv[e];
                op[c4] = o; }
    }
}
typedef float f32x4v __attribute__((ext_vector_type(4)));
__device__ __forceinline__ f32x4v mm_tile(const LAS bf16* X, const LAS bf16* Y, int n0, int m0, int lane, f32x4v acc) {
    const int r = lane & 15, q = lane >> 4;
#pragma unroll
    for (int s = 0; s < 2; ++s) { const bf16x8 a = *(const LAS bf16x8*)(Y + (m0 + r) * 72 + 32 * s + 8 * q); const bf16x8 b = *(const LAS bf16x8*)(X + (n0 + r) * 72 + 32 * s + 8 * q);
        acc = __builtin_amdgcn_mfma_f32_16x16x32_bf16(a, b, acc, 0, 0, 0); }
    return acc;
}
__device__ __forceinline__ void st_tile(LAS bf16* dst, int n0, int m0, int lane, f32x4v a) { v2u w; w.x = pk2(a[0], a[1]); w.y = pk2(a[2], a[3]); *(LAS v2u*)(dst + (n0 + (lane & 15)) * 72 + m0 + 4 * (lane >> 4)) = w; }
__device__ __forceinline__ void st_tile_g(bf16* dst, int n0, int m0, int lane, f32x4v a) { v2u w; w.x = pk2(a[0], a[1]); w.y = pk2(a[2], a[3]); *(v2u*)(dst + (n0 + (lane & 15)) * 64 + m0 + 4 * (lane >> 4)) = w; }
__device__ __forceinline__ f32x4v blk16(const LAS float* X, const LAS float* Y, int lane, f32x4v acc) {
    const int r = lane & 15, q = lane >> 4;
#pragma unroll
    for (int s = 0; s < 4; ++s) acc = __builtin_amdgcn_mfma_f32_16x16x4f32(X[r * 68 + 4 * s + q], Y[(4 * s + q) * 68 + r], acc, 0, 0, 0);
    return acc;
}
constexpr int RA_AT = 0, RA_BH = 9216, RA_KH = 18432, RA_RT = 27648, RA_ATT = 36864, RA_VT = 46080, RA_BTT = 55296, RA_KTT = 64512, RA_AAK = 73728, RA_ARB = 82944, RA_ARK = 92160,
              RA_FM = 101376, RA_TF = 118784, RA_MISC = 136192;
constexpr int RA_WPRE = 73728, RA_APRE = 90112, RA_TWB = 106496, RA_TAB = 111616, RA_W2T = 116736, RA_A2T = 121856;
constexpr size_t WS_MPT = 32 * MiB, WS_NM = 96 * MiB, WS_QE = 800 * MiB, WS_Y0 = 864 * MiB, WS_S0 = 928 * MiB, WS_GCE = 992 * MiB, WS_CT = 994 * MiB, WS_W2T = WS_TAB + 8192, WS_A2T = WS_TAB + 8192 + 32768;

__device__ __forceinline__ float dpp_add(float v, const int ctrl_sel) {
    int r;
    if (ctrl_sel == 0) r = __builtin_amdgcn_update_dpp(0, __builtin_bit_cast(int, v), 0xB1, 0xf, 0xf, true);
    else if (ctrl_sel == 1) r = __builtin_amdgcn_update_dpp(0, __builtin_bit_cast(int, v), 0x4E, 0xf, 0xf, true);
    else if (ctrl_sel == 2) r = __builtin_amdgcn_update_dpp(0, __builtin_bit_cast(int, v), 0x141, 0xf, 0xf, true);
    else r = __builtin_amdgcn_update_dpp(0, __builtin_bit_cast(int, v), 0x140, 0xf, 0xf, true);
    return v + __builtin_bit_cast(float, r);
}
__device__ __forceinline__ float wave_sum_dpp(float v) {
    v = dpp_add(v, 0); v = dpp_add(v, 1); v = dpp_add(v, 2); v = dpp_add(v, 3);
    const int iv = __builtin_bit_cast(int, v);
    const float r0 = __builtin_bit_cast(float, __builtin_amdgcn_readlane(iv, 0)), r1 = __builtin_bit_cast(float, __builtin_amdgcn_readlane(iv, 16));
    const float r2 = __builtin_bit_cast(float, __builtin_amdgcn_readlane(iv, 32)), r3 = __builtin_bit_cast(float, __builtin_amdgcn_readlane(iv, 48));
    return (r0 + r1) + (r2 + r3);
}
__device__ __forceinline__ float swap32_sum(float a, float b) { asm volatile("s_nop 1\n\tv_permlane32_swap_b32 %0, %1" : "+v"(a), "+v"(b)); return a + b; }
__device__ __forceinline__ float swap16_sum(float a, float b) { asm volatile("s_nop 1\n\tv_permlane16_swap_b32 %0, %1" : "+v"(a), "+v"(b)); return a + b; }
constexpr int RA_RKV = 0;
struct RaPf { v4u rkv[4]; v4u lc, lp; v2u tw, ta; };
__device__ __forceinline__ void rwkv_pf_load(RaPf& pf, Frame& F, int b, int c, int h, unsigned char* ws) {
    const int tid = F.tid; const bf16* P = F.PROJ; const long rowbase = (long)b * T + c * 64;
#pragma unroll
    for (int k = 0; k < 4; ++k) { const int pc = tid + 512 * k; pf.rkv[k] = (v4u){0u, 0u, 0u, 0u};
        if (pc < 1560) { const int row = pc / 24, rem = pc - row * 24, arr = rem >> 3, p8 = rem & 7;
            if (row > 0 || c > 0) pf.rkv[k] = *(const v4u*)(P + (rowbase - 1 + row) * P0LD + arr * 512 + h * 64 + 8 * p8); } }
    { const int j = tid >> 3, p = tid & 7; pf.lc = *(const v4u*)(P + (rowbase + j) * P0LD + C_WL + 8 * p); pf.lp = (v4u){0u, 0u, 0u, 0u};
      if (c * 64 + j > 0) pf.lp = *(const v4u*)(P + (rowbase + j - 1) * P0LD + C_WL + 8 * p);
      const int l4 = 4 * (tid & 7);
      pf.tw = *(const v2u*)((const bf16*)(ws + WS_W2T) + (h * 64 + j) * 32 + l4); pf.ta = *(const v2u*)((const bf16*)(ws + WS_A2T) + (h * 64 + j) * 32 + l4); }
}
template <bool HAS_NEXT> __device__ __forceinline__ void rwkv_passA_item(Frame& F, int b, int c, int h, unsigned char* ws, RaPf& pf, int nb_, int nc_, int nh_) {
    LAS unsigned char* L = F.lds; const int tid = F.tid, lane = F.lane, wave = F.wave;
    const long rowbase = (long)b * T + c * 64; const int chd = (b * 128 + c) * 8 + h;
    LAS bf16* At = (LAS bf16*)(L + RA_AT); LAS bf16* Bh = (LAS bf16*)(L + RA_BH); LAS bf16* Kh = (LAS bf16*)(L + RA_KH); LAS bf16* Rt = (LAS bf16*)(L + RA_RT);
    LAS bf16* AtT = (LAS bf16*)(L + RA_ATT); LAS bf16* VT = (LAS bf16*)(L + RA_VT); LAS bf16* BtT = (LAS bf16*)(L + RA_BTT); LAS bf16* KtT = (LAS bf16*)(L + RA_KTT);
    LAS bf16* Aak = (LAS bf16*)(L + RA_AAK); LAS bf16* Arb = (LAS bf16*)(L + RA_ARB); LAS bf16* Ark = (LAS bf16*)(L + RA_ARK);
    LAS float* Fm = (LAS float*)(L + RA_FM); LAS float* Tf = (LAS float*)(L + RA_TF); LAS float* Misc = (LAS float*)(L + RA_MISC);
    LAS bf16* Tm = At; LAS bf16* XT = Bh; LAS bf16* WT = Kh; LAS bf16* U0T = Aak;
    LAS float* Wpre = (LAS float*)(L + RA_WPRE); LAS float* Apre = (LAS float*)(L + RA_APRE);
    LAS bf16* TWb = (LAS bf16*)(L + RA_TWB); LAS bf16* TAb = (LAS bf16*)(L + RA_TAB); LAS bf16* W2s = (LAS bf16*)(L + RA_W2T); LAS bf16* A2s = (LAS bf16*)(L + RA_A2T);
    LAS bf16* RKV = (LAS bf16*)(L + RA_RKV);
    const f32x4v z4 = {0.f, 0.f, 0.f, 0.f};
#pragma unroll
    for (int k = 0; k < 4; ++k) { const int pc = tid + 512 * k; if (pc < 1560) { const int row = pc / 24, rem = pc - row * 24; *(LAS v4u*)(RKV + (row * 3 + (rem >> 3)) * 72 + 8 * (rem & 7)) = pf.rkv[k]; } }
    { const int j = tid >> 3, p = tid & 7, arr = p >> 2, l8 = 8 * (p & 3), l4 = 4 * p;
      *(LAS v2u*)(W2s + j * 40 + l4) = pf.tw; *(LAS v2u*)(A2s + j * 40 + l4) = pf.ta;
      const f32x4v m0 = *(const f32x4v*)(F.a_mu + C_WL + 8 * p), m1 = *(const f32x4v*)(F.a_mu + C_WL + 8 * p + 4);
      const float mu[8] = {m0[0], m0[1], m0[2], m0[3], m1[0], m1[1], m1[2], m1[3]}; float sh[8];
#pragma unroll
      for (int e = 0; e < 4; ++e) { const float c0 = bflo(pf.lc[e]), c1 = bfhi(pf.lc[e]), p0 = bflo(pf.lp[e]), p1 = bfhi(pf.lp[e]);
          sh[2 * e] = c0 + mu[2 * e] * (p0 - c0); sh[2 * e + 1] = c1 + mu[2 * e + 1] * (p1 - c1); }
      if (arr == 0) {
#pragma unroll
          for (int e = 0; e < 8; ++e) sh[e] = 1.0f - 2.0f * frcp(1.0f + __expf(2.0f * sh[e])); }
      v4u o; o.x = pk2(sh[0], sh[1]); o.y = pk2(sh[2], sh[3]); o.z = pk2(sh[4], sh[5]); o.w = pk2(sh[6], sh[7]);
      *(LAS v4u*)((arr ? TAb : TWb) + j * 40 + l8) = o; }
    LBAR();
    if (HAS_NEXT) rwkv_pf_load(pf, F, nb_, nc_, nh_, ws);
    { const int r = lane & 15, q = lane >> 4;
#pragma unroll
      for (int i = 0; i < 4; ++i) { const int tt = wave * 4 + i, arr = tt >> 4, n0 = ((tt >> 2) & 3) * 16, m0 = (tt & 3) * 16;
          const LAS bf16* X = arr ? TAb : TWb; const LAS bf16* Y = arr ? A2s : W2s;
          const bf16x8 a = *(const LAS bf16x8*)(Y + (m0 + r) * 40 + 8 * q); const bf16x8 bb = *(const LAS bf16x8*)(X + (n0 + r) * 40 + 8 * q);
          const f32x4v d = __builtin_amdgcn_mfma_f32_16x16x32_bf16(a, bb, z4, 0, 0, 0);
          *(LAS f32x4v*)((arr ? Apre : Wpre) + (n0 + r) * 64 + m0 + 4 * q) = d; } }
    LBAR();
    const int ch = lane, cg = h * 64 + ch, j0 = wave * 8;
    float rr[8], kn[8], ka[8], km[8], vv[8], lw[8], gg[8];
    { const float w0 = F.a_w0[cg], a0 = F.a_a0[cg], kkc = F.a_k_k[cg], kac = F.a_k_a[cg], rk = F.a_r_k[cg];
      const float mu_r = F.a_mu[C_R + cg], mu_k = F.a_mu[C_K + cg], mu_v = F.a_mu[C_V + cg];
      float pr = bf2f(RKV[(j0 * 3 + 0) * 72 + ch]), pk = bf2f(RKV[(j0 * 3 + 1) * 72 + ch]), pv = bf2f(RKV[(j0 * 3 + 2) * 72 + ch]);
      float run = 0.f; float xr[16];
#pragma unroll
      for (int jj = 0; jj < 8; ++jj) { const int j = j0 + jj;
          const float cr = bf2f(RKV[((j + 1) * 3 + 0) * 72 + ch]), ck = bf2f(RKV[((j + 1) * 3 + 1) * 72 + ch]), cv = bf2f(RKV[((j + 1) * 3 + 2) * 72 + ch]);
          const float r = cr + mu_r * (pr - cr), k = ck + mu_k * (pk - ck), v = cv + mu_v * (pv - cv); pr = cr; pk = ck; pv = cv;
          const float wpre = w0 + Wpre[j * 64 + ch], apre = a0 + Apre[j * 64 + ch];
          const float lwv = -0.6065306597126334f * frcp(1.0f + __expf(-wpre));
          const float alpha = frcp(1.0f + __expf(-apre));
          const float kk = k * kkc; const float kmv = k * (1.0f + (alpha - 1.0f) * kac);
          xr[jj] = kk * kk; xr[8 + jj] = r * kmv * rk; kn[jj] = kk; ka[jj] = alpha;
          run += lwv;
          rr[jj] = r; km[jj] = kmv; vv[jj] = v; lw[jj] = lwv; gg[jj] = run; }
      float y8[8], z4[4], y2[2], wsum;
#pragma unroll
      for (int i = 0; i < 8; ++i) y8[i] = swap32_sum(xr[i], xr[8 + i]);
#pragma unroll
      for (int i = 0; i < 4; ++i) z4[i] = swap16_sum(y8[i], y8[4 + i]);
      { const bool b3 = (lane & 8) != 0, b2 = (lane & 4) != 0;
#pragma unroll
        for (int i = 0; i < 2; ++i) { const float keep = b3 ? z4[2 + i] : z4[i], send = b3 ? z4[i] : z4[2 + i];
            y2[i] = keep + __builtin_bit_cast(float, __builtin_amdgcn_update_dpp(0, __builtin_bit_cast(int, send), 0x128, 0xf, 0xf, true)); }
        const float keep = b2 ? y2[1] : y2[0], send = b2 ? y2[0] : y2[1];
        wsum = keep + __shfl_xor(send, 4);
        wsum = dpp_add(wsum, 1); wsum = dpp_add(wsum, 0); }
      { LAS float* red = Misc + 512 + wave * 16; if ((lane & 3) == 0) red[(lane >> 2) & 15] = wsum;
        if ((lane & 3) == 0 && lane >= 32) ((float*)(ws + WS_CT))[(rowbase + j0 + ((lane >> 2) & 7)) * 8 + h] = wsum;
        const f32x4v s0 = *(const LAS f32x4v*)(red), s1 = *(const LAS f32x4v*)(red + 4); const float ssv[8] = {s0[0], s0[1], s0[2], s0[3], s1[0], s1[1], s1[2], s1[3]};
#pragma unroll
        for (int jj = 0; jj < 8; ++jj) { kn[jj] *= fminf(__builtin_amdgcn_rsqf(ssv[jj]), 1e12f); ka[jj] *= kn[jj]; } }
      Misc[wave * 64 + ch] = run; }
    LBAR();
    { float off = 0.f, tot = 0.f;
#pragma unroll
      for (int w = 0; w < 8; ++w) { const float p = Misc[w * 64 + ch]; tot += p; if (w < wave) off += p; }
      const float eC = __expf(tot);
      if (wave == 0) ((float*)(ws + WS_GCE))[chd * 64 + ch] = eC;
      unsigned at8[8], bh8[8], kh8[8], rt8[8], v8[8], bt8[8], kt8[8];
#pragma unroll
      for (int jj = 0; jj < 8; ++jj) { const float g = gg[jj] + off; const float e1 = __expf(g), e2 = __expf(-g), em = __expf(-lw[jj]);
          const float at = -kn[jj] * e1 * em, bh = ka[jj] * e2, kh = km[jj] * e2, rt = rr[jj] * e1;
          at8[jj] = f2bf(at); bh8[jj] = f2bf(bh); kh8[jj] = f2bf(kh); rt8[jj] = f2bf(rt); v8[jj] = f2bf(vv[jj]); bt8[jj] = f2bf(bh * eC); kt8[jj] = f2bf(kh * eC);
          const int j = j0 + jj;
          At[j * 72 + ch] = (bf16)at8[jj]; Bh[j * 72 + ch] = (bf16)bh8[jj]; Kh[j * 72 + ch] = (bf16)kh8[jj]; Rt[j * 72 + ch] = (bf16)rt8[jj]; }
      v4u o;
      o.x = at8[0] | (at8[1] << 16); o.y = at8[2] | (at8[3] << 16); o.z = at8[4] | (at8[5] << 16); o.w = at8[6] | (at8[7] << 16); *(LAS v4u*)(AtT + ch * 72 + j0) = o;
      o.x = v8[0] | (v8[1] << 16); o.y = v8[2] | (v8[3] << 16); o.z = v8[4] | (v8[5] << 16); o.w = v8[6] | (v8[7] << 16); *(LAS v4u*)(VT + ch * 72 + j0) = o;
      o.x = bt8[0] | (bt8[1] << 16); o.y = bt8[2] | (bt8[3] << 16); o.z = bt8[4] | (bt8[5] << 16); o.w = bt8[6] | (bt8[7] << 16); *(LAS v4u*)(BtT + ch * 72 + j0) = o;
      o.x = kt8[0] | (kt8[1] << 16); o.y = kt8[2] | (kt8[3] << 16); o.z = kt8[4] | (kt8[5] << 16); o.w = kt8[6] | (kt8[7] << 16); *(LAS v4u*)(KtT + ch * 72 + j0) = o; }
    LBAR();
    { const int n0 = (wave >> 1) * 16, r = lane & 15, q = lane >> 4, i = n0 + r;
#pragma unroll
      for (int mm = 0; mm < 2; ++mm) { const int m0 = (2 * (wave & 1) + mm) * 16;
          f32x4v ab = mm_tile(At, Bh, n0, m0, lane, z4), ak = mm_tile(At, Kh, n0, m0, lane, z4), rb = mm_tile(Rt, Bh, n0, m0, lane, z4), rkk = mm_tile(Rt, Kh, n0, m0, lane, z4);
#pragma unroll
          for (int e = 0; e < 4; ++e) { const int j = m0 + 4 * q + e; if (!(j < i)) { ab[e] = 0.f; ak[e] = 0.f; } if (!(j <= i)) { rb[e] = 0.f; rkk[e] = 0.f; } }
          *(LAS f32x4v*)(Fm + i * 68 + m0 + 4 * q) = ab; st_tile(Aak, n0, m0, lane, ak); st_tile(Arb, n0, m0, lane, rb); st_tile(Ark, n0, m0, lane, rkk); } }
    LBAR();
    if (wave < 4) {
        const int blk = wave, cc = lane & 15; const LAS float* Ab = Fm + (16 * blk) * 68 + 16 * blk;
        float sv[16]; f32x4v av[16][4];
#pragma unroll
        for (int i = 1; i < 16; ++i)
#pragma unroll
            for (int jq = 0; jq < 4; ++jq) if (4 * jq < i) av[i][jq] = *(const LAS f32x4v*)(Ab + i * 68 + 4 * jq);
#pragma unroll
        for (int i = 0; i < 16; ++i) sv[i] = (i == cc) ? 1.f : 0.f;
#pragma unroll
        for (int j = 0; j < 15; ++j) { const float tj = sv[j];
#pragma unroll
            for (int i = j + 1; i < 16; ++i) sv[i] += av[i][j >> 2][j & 3] * tj; }
        if (lane < 16) {
#pragma unroll
            for (int i = 0; i < 16; ++i) { Tf[(16 * blk + i) * 68 + 16 * blk + cc] = sv[i]; Tm[(16 * blk + i) * 72 + 16 * blk + cc] = (bf16)f2bf(sv[i]); } }
        asm volatile("s_waitcnt lgkmcnt(0)" ::: "memory");
#pragma unroll
        for (int bk = 0; bk < 3; ++bk) if (bk < blk) {
            const f32x4v d = blk16(Tf + (16 * blk) * 68 + 16 * blk, Fm + (16 * blk) * 68 + 16 * bk, lane, z4);
            const int r = lane & 15, q = lane >> 4;
#pragma unroll
            for (int e = 0; e < 4; ++e) Fm[(16 * blk + 4 * q + e) * 68 + 16 * bk + r] = d[e]; }
    } else {
        for (int tt = wave - 4; tt < 16; tt += 4) { const int n0 = (tt >> 2) * 16, m0 = (tt & 3) * 16; st_tile(XT, n0, m0, lane, mm_tile(VT, Aak, n0, m0, lane, z4)); }
        if (wave >= 5) { const int k0 = (wave - 5) * 2;
#pragma unroll
            for (int kk2 = 0; kk2 < 2; ++kk2) { const int k = k0 + kk2; const int bi = (k < 3) ? 0 : (k < 5 ? 1 : 2), bj = (k < 3) ? k + 1 : (k < 5 ? k - 1 : 3);
                st_tile(Tm, bi * 16, bj * 16, lane, z4); } }
    }
    LBAR();
#define RA_TOUT(bi, bj, d) do { const int r_ = lane & 15, q_ = lane >> 4; _Pragma("unroll") for (int e = 0; e < 4; ++e) { Tf[(16 * (bi) + 4 * q_ + e) * 68 + 16 * (bj) + r_] = d[e]; Tm[(16 * (bi) + 4 * q_ + e) * 72 + 16 * (bj) + r_] = (bf16)f2bf(d[e]); } } while (0)
#define RA_BLK(M_, bi, bj) ((M_) + (16 * (bi)) * 68 + 16 * (bj))
    if (wave < 3) { const int bi = wave + 1, bj = wave; const f32x4v d = blk16(RA_BLK(Fm, bi, bj), RA_BLK(Tf, bj, bj), lane, z4); RA_TOUT(bi, bj, d); }
    LBAR();
    if (wave < 2) { const int bi = wave + 2, bj = wave; f32x4v d = blk16(RA_BLK(Fm, bi, bj), RA_BLK(Tf, bj, bj), lane, z4); d = blk16(RA_BLK(Fm, bi, bj + 1), RA_BLK(Tf, bj + 1, bj), lane, d); RA_TOUT(bi, bj, d); }
    LBAR();
    if (wave == 0) { f32x4v d = blk16(RA_BLK(Fm, 3, 0), RA_BLK(Tf, 0, 0), lane, z4); d = blk16(RA_BLK(Fm, 3, 1), RA_BLK(Tf, 1, 0), lane, d); d = blk16(RA_BLK(Fm, 3, 2), RA_BLK(Tf, 2, 0), lane, d); RA_TOUT(3, 0, d); }
    LBAR();
#undef RA_TOUT
#undef RA_BLK
#pragma unroll
    for (int i = 0; i < 4; ++i) { const int tt = wave * 4 + i, arr = tt >> 4, n0 = ((tt >> 2) & 3) * 16, m0 = (tt & 3) * 16;
        st_tile(arr ? U0T : WT, n0, m0, lane, mm_tile(arr ? XT : AtT, Tm, n0, m0, lane, z4)); }
    LBAR();
    { bf16* gM = (bf16*)(ws + WS_MPT) + (size_t)chd * 4096; bf16* gN = (bf16*)(ws + WS_NM) + (size_t)chd * 4096; bf16* gQ = (bf16*)(ws + WS_QE) + (size_t)chd * 4096; bf16* gY = (bf16*)(ws + WS_Y0) + (size_t)chd * 4096;
      const int n0 = (wave >> 1) * 16;
#pragma unroll
      for (int mm = 0; mm < 2; ++mm) { const int m0 = (2 * (wave & 1) + mm) * 16;
          st_tile_g(gM, n0, m0, lane, mm_tile(BtT, WT, n0, m0, lane, z4));
          st_tile_g(gN, n0, m0, lane, mm_tile(VT, KtT, n0, m0, lane, mm_tile(U0T, BtT, n0, m0, lane, z4)));
          f32x4v qe = mm_tile(Arb, WT, n0, m0, lane, z4); { const v2u rw = *(const LAS v2u*)(Rt + (n0 + (lane & 15)) * 72 + m0 + 4 * (lane >> 4)); qe[0] += bflo(rw.x); qe[1] += bfhi(rw.x); qe[2] += bflo(rw.y); qe[3] += bfhi(rw.y); }
          st_tile_g(gQ, n0, m0, lane, qe);
          st_tile_g(gY, n0, m0, lane, mm_tile(Ark, VT, n0, m0, lane, mm_tile(Arb, U0T, n0, m0, lane, z4))); } }
    LBAR();
}
__device__ __forceinline__ void ra_item_of(int G, int it, int& b, int& c, int& h) {
    int id = it; if (G == 256) id = blockIdx.x * 32 + (it / 256);
    h = id & 7; const int bc = id >> 3; b = bc >> 7; c = bc & 127;
}
__device__ __forceinline__ void ph_rwkv_passA(Frame& F, unsigned char* ws) {
    const int NIT = NB * 128 * 8; int it = blockIdx.x; if (it >= NIT) return;
    int b, c, h; ra_item_of(F.G, it, b, c, h);
    RaPf pf; rwkv_pf_load(pf, F, b, c, h, ws);
#pragma unroll 1
    for (; it < NIT; it += F.G) {
        const int nit = it + F.G; int nb_ = b, nc_ = c, nh_ = h;
        if (nit < NIT) { ra_item_of(F.G, nit, nb_, nc_, nh_); rwkv_passA_item<true>(F, b, c, h, ws, pf, nb_, nc_, nh_); }
        else rwkv_passA_item<false>(F, b, c, h, ws, pf, nb_, nc_, nh_);
        b = nb_; c = nc_; h = nh_;
    }
}
constexpr int RB_SLOT = 11776, RB_NOFF = 9216, RB_GOFF = 11520, RB_R = 6, RB_NBATCH = 22;
struct RbThr { const unsigned char* p0; const unsigned char* p1; unsigned st0, st1; int d0, d1; bool has1; };
__device__ __forceinline__ void rb_piece(unsigned char* ws, int b, int h, int vq, int w, const unsigned char*& p, unsigned& st, int& d) {
    const size_t chd0 = (size_t)(b * 128 * 8 + h);
    if (w < 512) { p = (const unsigned char*)((const bf16*)(ws + WS_MPT) + chd0 * 4096) + 16 * w; st = 65536u; d = (w >> 3) * 144 + (w & 7) * 16; }
    else if (w < 640) { p = (const unsigned char*)((const bf16*)(ws + WS_NM) + chd0 * 4096 + (size_t)vq * 16 * 64) + 16 * (w - 512); st = 65536u; d = RB_NOFF + ((w - 512) >> 3) * 144 + ((w - 512) & 7) * 16; }
    else { p = (const unsigned char*)((const float*)(ws + WS_GCE) + chd0 * 64) + 16 * (w - 640); st = 2048u; d = RB_GOFF + 16 * (w - 640); }
}
__device__ __forceinline__ void rb_issue(v4u (&reg)[2 * RB_R], const RbThr& th, int batch) {
#pragma unroll
    for (int cs = 0; cs < RB_R; ++cs) { int c = batch * RB_R + cs; if (c > 127) c = 127;
        reg[2 * cs] = *(const v4u*)(th.p0 + (size_t)c * th.st0); reg[2 * cs + 1] = (v4u){0u, 0u, 0u, 0u}; if (th.has1) reg[2 * cs + 1] = *(const v4u*)(th.p1 + (size_t)c * th.st1); }
}
__device__ __forceinline__ void rb_commit(const v4u (&reg)[2 * RB_R], const RbThr& th, LAS unsigned char* ring, int half) {
#pragma unroll
    for (int cs = 0; cs < RB_R; ++cs) { LAS unsigned char* slot = ring + (half * RB_R + cs) * RB_SLOT; *(LAS v4u*)(slot + th.d0) = reg[2 * cs]; if (th.has1) *(LAS v4u*)(slot + th.d1) = reg[2 * cs + 1]; }
}
struct RbLds { v2u lo[4][2], hi[4][2], nn[4]; f32x4v ge[4]; };
__device__ __forceinline__ void rb_lds(RbLds& o, const LAS unsigned char* slot, int r, int q) {
#pragma unroll
    for (int mt = 0; mt < 4; ++mt) {
#pragma unroll
        for (int s2 = 0; s2 < 2; ++s2) { const LAS unsigned char* rowp = slot + (16 * mt + r) * 144 + (32 * s2 + 4 * q) * 2; o.lo[mt][s2] = *(const LAS v2u*)rowp; o.hi[mt][s2] = *(const LAS v2u*)(rowp + 32); }
        o.nn[mt] = *(const LAS v2u*)(slot + RB_NOFF + r * 144 + (16 * mt + 4 * q) * 2); o.ge[mt] = *(const LAS f32x4v*)(slot + RB_GOFF + (16 * mt + 4 * q) * 4); }
}
__device__ __forceinline__ void ph_rwkv_passB(Frame& F, unsigned char* ws) {
    const int lane = F.lane, r = lane & 15, q = lane >> 4, wave = F.wave; LAS unsigned char* ring = F.lds;
    for (int task0 = blockIdx.x; task0 < NB * 8 * 4; task0 += F.G) {
        int task = task0; if (F.G == 256) { const int xcd = task0 & 7, sl = task0 >> 3; task = (xcd * 8 + (sl >> 2)) * 4 + (sl & 3); }
        const int vq = task & 3, h = (task >> 2) & 7, b = task >> 5, v = vq * 16 + r; const int lt = (F.tid >= 64) ? F.tid - 64 : 0;
        f32x4v S[4];
#pragma unroll
        for (int mt = 0; mt < 4; ++mt) S[mt] = (f32x4v){0.f, 0.f, 0.f, 0.f};
        RbThr th; rb_piece(ws, b, h, vq, lt, th.p0, th.st0, th.d0); th.has1 = (lt + 448) < 656; rb_piece(ws, b, h, vq, th.has1 ? lt + 448 : lt, th.p1, th.st1, th.d1);
        if (wave != 0) {
            v4u ra[2 * RB_R];
            rb_issue(ra, th, 0); rb_commit(ra, th, ring, 0); rb_issue(ra, th, 1);
            LBAR();
#pragma unroll 1
            for (int k = 0; k < RB_NBATCH; ++k) { rb_commit(ra, th, ring, (k & 1) ^ 1); rb_issue(ra, th, k + 2); LBAR(); }
        } else {
            __builtin_amdgcn_s_waitcnt(0x0F70);
            LBAR();
#pragma unroll 1
            for (int k = 0; k < RB_NBATCH; ++k) { const LAS unsigned char* half = ring + ((k & 1) * RB_R) * RB_SLOT;
                RbLds cur; rb_lds(cur, half, r, q);
#pragma unroll
                for (int cs = 0; cs < RB_R; ++cs) { const int c = k * RB_R + cs;
                    RbLds nxt; if (cs + 1 < RB_R) rb_lds(nxt, half + (cs + 1) * RB_SLOT, r, q);
                    v2u sb[4];
#pragma unroll
                    for (int mt = 0; mt < 4; ++mt) { sb[mt].x = pk2(S[mt][0], S[mt][1]); sb[mt].y = pk2(S[mt][2], S[mt][3]); }
                    if (c < 128) { bf16* gS = (bf16*)(ws + WS_S0) + (size_t)((b * 128 + c) * 8 + h) * 4096;
#pragma unroll
                        for (int mt = 0; mt < 4; ++mt) gstore8_nowait(gS + v * 64 + 16 * mt + 4 * q, sb[mt]); }
                    bf16x8 bfr[2];
#pragma unroll
                    for (int s2 = 0; s2 < 2; ++s2) { v4u w; w.x = sb[2 * s2].x; w.y = sb[2 * s2].y; w.z = sb[2 * s2 + 1].x; w.w = sb[2 * s2 + 1].y; bfr[s2] = __builtin_bit_cast(bf16x8, w); }
#pragma unroll
                    for (int mt = 0; mt < 4; ++mt) { f32x4v d = {0.f, 0.f, 0.f, 0.f};
#pragma unroll
                        for (int s2 = 0; s2 < 2; ++s2) { v4u w; w.x = cur.lo[mt][s2].x; w.y = cur.lo[mt][s2].y; w.z = cur.hi[mt][s2].x; w.w = cur.hi[mt][s2].y;
                            d = __builtin_amdgcn_mfma_f32_16x16x32_bf16(__builtin_bit_cast(bf16x8, w), bfr[s2], d, 0, 0, 0); }
                        S[mt][0] = S[mt][0] * cur.ge[mt][0] + d[0] + bflo(cur.nn[mt].x); S[mt][1] = S[mt][1] * cur.ge[mt][1] + d[1] + bfhi(cur.nn[mt].x);
                        S[mt][2] = S[mt][2] * cur.ge[mt][2] + d[2] + bflo(cur.nn[mt].y); S[mt][3] = S[mt][3] * cur.ge[mt][3] + d[3] + bfhi(cur.nn[mt].y); }
                    if (cs + 1 < RB_R) cur = nxt; }
                LBAR();
            }
        }
    }
}
constexpr int RC_LD = 136, RC_BYTES = 65 * RC_LD * 2;
__device__ __forceinline__ void ph_rwkv_passC(Frame& F, unsigned char* ws) {
    const int lane = F.lane, r = lane & 15, q = lane >> 4; const bf16* P = F.PROJ;
    LAS bf16* VG = (LAS bf16*)(F.lds + F.wave * RC_BYTES);
    const int gwv = blockIdx.x * NWAVES + F.wave, NGW = F.G * NWAVES;
    for (int it = gwv; it < NB * 128 * 8; it += NGW) {
        int id = it; if (F.G == 256) id = blockIdx.x * 32 + (it / NGW) * 8 + F.wave;
        const int h = id & 7, bc = id >> 3, b = bc >> 7, c = bc & 127; const size_t chd = (size_t)id;
        const bf16* gQ = (const bf16*)(ws + WS_QE) + chd * 4096; const bf16* gY = (const bf16*)(ws + WS_Y0) + chd * 4096; const bf16* gS = (const bf16*)(ws + WS_S0) + chd * 4096;
        const long rowbase = (long)b * T + c * 64;
        v4u vp[9], gp[9];
#pragma unroll
        for (int k = 0; k < 9; ++k) { const int idx = lane + 64 * k; vp[k] = (v4u){0u, 0u, 0u, 0u}; gp[k] = (v4u){0u, 0u, 0u, 0u};
            if (idx < 520) { const int row = idx >> 3, p8 = idx & 7; if (row > 0 || c > 0) { const bf16* src = P + (rowbase - 1 + row) * P0LD + h * 64 + 8 * p8; vp[k] = *(const v4u*)(src + C_V); gp[k] = *(const v4u*)(src + C_GA); } } }
        bf16x8 sf[4][2];
#pragma unroll
        for (int mt = 0; mt < 4; ++mt)
#pragma unroll
            for (int s = 0; s < 2; ++s) sf[mt][s] = *(const bf16x8*)(gS + (16 * mt + r) * 64 + 32 * s + 8 * q);
        f32x4v lnw[4], lnb[4], muv[4], mug[4];
#pragma unroll
        for (int mt = 0; mt < 4; ++mt) { const int cg = h * 64 + 16 * mt + 4 * q; lnw[mt] = *(const f32x4v*)(F.a_ln_w + cg); lnb[mt] = *(const f32x4v*)(F.a_ln_b + cg);
            muv[mt] = *(const f32x4v*)(F.a_mu + C_V + cg); mug[mt] = *(const f32x4v*)(F.a_mu + C_GA + cg); }
#pragma unroll
        for (int k = 0; k < 9; ++k) { const int idx = lane + 64 * k; if (idx < 520) { const int row = idx >> 3, p8 = idx & 7; *(LAS v4u*)(VG + row * RC_LD + 8 * p8) = vp[k]; *(LAS v4u*)(VG + row * RC_LD + 64 + 8 * p8) = gp[k]; } }
#pragma unroll 1
        for (int nt = 0; nt < 4; ++nt) {
            const int i = 16 * nt + r; const long t = rowbase + i;
            bf16x8 qf[2];
#pragma unroll
            for (int s = 0; s < 2; ++s) qf[s] = *(const bf16x8*)(gQ + i * 64 + 32 * s + 8 * q);
            v2u y0w[4];
#pragma unroll
            for (int mt = 0; mt < 4; ++mt) y0w[mt] = *(const v2u*)(gY + i * 64 + 16 * mt + 4 * q);
            const float ct = ((const float*)(ws + WS_CT))[t * 8 + h];
            f32x4v y[4]; float sum = 0.f;
#pragma unroll
            for (int mt = 0; mt < 4; ++mt) { const v2u y0 = y0w[mt];
                f32x4v d = {bflo(y0.x), bfhi(y0.x), bflo(y0.y), bfhi(y0.y)};
#pragma unroll
                for (int s = 0; s < 2; ++s) d = __builtin_amdgcn_mfma_f32_16x16x32_bf16(sf[mt][s], qf[s], d, 0, 0, 0);
                y[mt] = d; sum += (d[0] + d[1]) + (d[2] + d[3]); }
            sum += __shfl_xor(sum, 16); sum += __shfl_xor(sum, 32);
            const float mean = sum * (1.f / 64.f); float sq = 0.f;
#pragma unroll
            for (int mt = 0; mt < 4; ++mt)
#pragma unroll
                for (int e = 0; e < 4; ++e) { const float dd = y[mt][e] - mean; y[mt][e] = dd; sq += dd * dd; }
            sq += __shfl_xor(sq, 16); sq += __shfl_xor(sq, 32);
            const float rstd = __builtin_amdgcn_rsqf(sq * (1.f / 64.f) + 64e-5f);
#pragma unroll
            for (int mt = 0; mt < 4; ++mt) { const int col = h * 64 + 16 * mt + 4 * q;
                const LAS bf16* lp = VG + i * RC_LD + 16 * mt + 4 * q;
                const v2u pv = *(const LAS v2u*)lp, pg = *(const LAS v2u*)(lp + 64), cv = *(const LAS v2u*)(lp + RC_LD), cgt = *(const LAS v2u*)(lp + RC_LD + 64);
                const float cvf[4] = {bflo(cv.x), bfhi(cv.x), bflo(cv.y), bfhi(cv.y)}, pvf[4] = {bflo(pv.x), bfhi(pv.x), bflo(pv.y), bfhi(pv.y)};
                const float cgf[4] = {bflo(cgt.x), bfhi(cgt.x), bflo(cgt.y), bfhi(cgt.y)}, pgf[4] = {bflo(pg.x), bfhi(pg.x), bflo(pg.y), bfhi(pg.y)};
                float o[4];
#pragma unroll
                for (int e = 0; e < 4; ++e) { const float vs = cvf[e] + muv[mt][e] * (pvf[e] - cvf[e]), gs = cgf[e] + mug[mt][e] * (pgf[e] - cgf[e]);
                    o[e] = (y[mt][e] * rstd * lnw[mt][e] + lnb[mt][e] + ct * vs) * siluf_(gs); }
                v2u ow; ow.x = pk2(o[0], o[1]); ow.y = pk2(o[2], o[3]);
                *(v2u*)(F.HB + (size_t)t * D + col) = ow; }
        }
    }
}
constexpr size_t WS_OB = 32 * MiB  , WS_GAM = 928 * MiB, WS_SSQ = 936 * MiB;
__device__ __forceinline__ void ph_hgrn_prep(Frame& F, unsigned char* ws) {
    const int gw = F.vcu * NWAVES + F.wave, NGW = F.G * NWAVES, lane = F.lane;
    bf16* P = F.PROJ; float* gam = (float*)(ws + WS_GAM);
    for (int task = gw; task < (M / 64) * 2; task += NGW) {
        const int bc = task >> 1, c0 = (task & 1) * 512 + 8 * lane;
        const f32x4 l0 = *(const f32x4*)(F.lb_tab + c0), l1 = *(const f32x4*)(F.lb_tab + c0 + 4); const float lb[8] = {l0[0], l0[1], l0[2], l0[3], l1[0], l1[1], l1[2], l1[3]};
        float run[8];
#pragma unroll
        for (int e = 0; e < 8; ++e) run[e] = 0.f;
        bf16* p = P + (size_t)bc * 64 * P1LD + c0;
#pragma unroll 4
        for (int j = 0; j < 64; ++j) { const v4u qw = *(const v4u*)(p + (size_t)j * P1LD), fw = *(const v4u*)(p + (size_t)j * P1LD + 1024);
            float qd[8], ki[8];
#pragma unroll
            for (int e = 0; e < 8; ++e) { const float qv = (e & 1) ? bfhi(qw[e >> 1]) : bflo(qw[e >> 1]), fv = (e & 1) ? bfhi(fw[e >> 1]) : bflo(fw[e >> 1]);
                const float sg = frcp(1.0f + __expf(-fv)); const float fg = lb[e] + (1.0f - lb[e]) * sg; run[e] += __logf(fg);
                const float ee = __expf(run[e]); qd[e] = qv * frcp(1.0f + __expf(-qv)) * ee; ki[e] = (1.0f - lb[e]) * (1.0f - sg) * __expf(-run[e]); }
            v4u qo, ko;
#pragma unroll
            for (int e = 0; e < 4; ++e) { qo[e] = pk2(qd[2 * e], qd[2 * e + 1]); ko[e] = pk2(ki[2 * e], ki[2 * e + 1]); }
            *(v4u*)(p + (size_t)j * P1LD) = qo; *(v4u*)(p + (size_t)j * P1LD + 1024) = ko; }
        f32x4 g0, g1;
#pragma unroll
        for (int e = 0; e < 4; ++e) { g0[e] = __expf(run[e]); g1[e] = __expf(run[4 + e]); }
        *(f32x4*)(gam + (size_t)bc * 1024 + c0) = g0; *(f32x4*)(gam + (size_t)bc * 1024 + c0 + 4) = g1;
    }
}
typedef short v4s __attribute__((ext_vector_type(4)));
__device__ __forceinline__ bf16x8 tr_frag(const LAS bf16* Mx, int ld, int j0, int c0, int lane) {
    const int q = lane >> 4, i = lane & 15; const LAS bf16* a = Mx + (j0 + 8 * q + (i >> 2)) * ld + c0 + 4 * (i & 3);
    const v4s lo = __builtin_amdgcn_ds_read_tr16_b64_v4i16((LAS v4s*)a), hi = __builtin_amdgcn_ds_read_tr16_b64_v4i16((LAS v4s*)(a + 4 * ld));
    return (bf16x8){lo[0], lo[1], lo[2], lo[3], hi[0], hi[1], hi[2], hi[3]};
}
__device__ __forceinline__ bf16x8 tr_frag_perm(const LAS bf16* Mx, int ld, int s2, int c0, int lane) {
    const int q = lane >> 4, i = lane & 15; const LAS bf16* a = Mx + (32 * s2 + 4 * q + (i >> 2)) * ld + c0 + 4 * (i & 3);
    const v4s lo = __builtin_amdgcn_ds_read_tr16_b64_v4i16((LAS v4s*)a), hi = __builtin_amdgcn_ds_read_tr16_b64_v4i16((LAS v4s*)(a + 16 * ld));
    return (bf16x8){lo[0], lo[1], lo[2], lo[3], hi[0], hi[1], hi[2], hi[3]};
}
constexpr int HG_QD = 0, HG_KI = 34816, HG_VS = 69632, HG_ST = 79872, HG_GAM = 97280;
__device__ __forceinline__ void ph_hgrn_chunk(Frame& F, unsigned char* ws) {
    LAS unsigned char* L = F.lds; const int tid = F.tid, lane = F.lane, wave = F.wave, r = lane & 15, q = lane >> 4;
    const bf16* P = F.PROJ; const float* gam = (const float*)(ws + WS_GAM); bf16* OB = (bf16*)(ws + WS_OB); float* SSQ = (float*)(ws + WS_SSQ);
    for (int task0 = blockIdx.x; task0 < NB * 8 * 4; task0 += F.G) {
        int task = task0; if (F.G == 256) { const int xcd = task0 & 7, sl = task0 >> 3; task = (xcd * 8 + (sl >> 2)) * 4 + (sl & 3); }
        const int vq = task & 3, h = (task >> 2) & 7, b = task >> 5, ib = wave >> 1, vt = wave & 1;
        f32x4v S[2]; S[0] = (f32x4v){0.f, 0.f, 0.f, 0.f}; S[1] = S[0];
        for (int u = tid; u < 8704 / 4; u += NTHR) ((LAS unsigned*)(L + HG_ST))[u] = 0u;
        const int prow0 = tid >> 4, pc = tid & 15, vrow = tid >> 2, vpc = tid & 3;
        v4u rqA[2], rkA[2], rvA = {0u, 0u, 0u, 0u}, rqB[2], rkB[2], rvB = {0u, 0u, 0u, 0u}; float rgA = 0.f, rgB = 0.f;
#define HG_LOAD(c_, rq, rk, rv, rg) do { const size_t rb_ = (size_t)b * T + (size_t)(c_) * 64; \
            _Pragma("unroll") for (int i_ = 0; i_ < 2; ++i_) { const bf16* s_ = P + (rb_ + prow0 + 32 * i_) * P1LD + h * 128 + 8 * pc; rq[i_] = *(const v4u*)s_; rk[i_] = *(const v4u*)(s_ + 1024); } \
            if (wave < 4) rv = *(const v4u*)(P + (rb_ + vrow) * P1LD + 2048 + h * 128 + vq * 32 + 8 * vpc); \
            if (wave < 2) rg = gam[((size_t)b * 128 + (c_)) * 1024 + h * 128 + tid]; } while (0)
#define HG_STAGE(bufi, rq, rk, rv, rg) do { LAS bf16* QDs_ = (LAS bf16*)(L + HG_QD + (bufi) * 17408); LAS bf16* KIs_ = (LAS bf16*)(L + HG_KI + (bufi) * 17408); \
            _Pragma("unroll") for (int i_ = 0; i_ < 2; ++i_) { *(LAS v4u*)(QDs_ + (prow0 + 32 * i_) * 136 + 8 * pc) = rq[i_]; *(LAS v4u*)(KIs_ + (prow0 + 32 * i_) * 136 + 8 * pc) = rk[i_]; } \
            if (wave < 4) *(LAS v4u*)((LAS bf16*)(L + HG_VS + (bufi) * 5120) + vrow * 40 + 8 * vpc) = rv; \
            if (wave < 2) ((LAS float*)(L + HG_GAM + (bufi) * 512))[tid] = rg; } while (0)
        HG_LOAD(0, rqA, rkA, rvA, rgA); HG_LOAD(1, rqB, rkB, rvB, rgB);
        HG_STAGE(0, rqA, rkA, rvA, rgA); HG_LOAD(2, rqA, rkA, rvA, rgA);
        LBAR();
#pragma unroll 1
        for (int c2 = 0; c2 < 128; c2 += 2) {
#pragma unroll
          for (int par = 0; par < 2; ++par) { const int c = c2 + par;
            if (c + 1 < 128) {
                if (par == 0) { HG_STAGE(1, rqB, rkB, rvB, rgB); if (c + 3 < 128) HG_LOAD(c + 3, rqB, rkB, rvB, rgB); }
                else { HG_STAGE(0, rqA, rkA, rvA, rgA); if (c + 3 < 128) HG_LOAD(c + 3, rqA, rkA, rvA, rgA); } }
            const LAS bf16* QD = (const LAS bf16*)(L + HG_QD + par * 17408); const LAS bf16* KI = (const LAS bf16*)(L + HG_KI + par * 17408); const LAS bf16* VS = (const LAS bf16*)(L + HG_VS + par * 5120);
            const LAS float* GAM = (const LAS float*)(L + HG_GAM + par * 512);
            const LAS bf16* STc = (const LAS bf16*)(L + HG_ST + par * 8704); LAS bf16* STn = (LAS bf16*)(L + HG_ST + (par ^ 1) * 8704);
            bf16x8 bq[4], kf[4][4], stf[4], vtf[2], ktf[2][2];
#pragma unroll
            for (int s = 0; s < 4; ++s) bq[s] = *(const LAS bf16x8*)(QD + (16 * ib + r) * 136 + 32 * s + 8 * q);
            vtf[0] = tr_frag_perm(VS, 40, 0, 16 * vt, lane); vtf[1] = tr_frag_perm(VS, 40, 1, 16 * vt, lane);
#pragma unroll
            for (int jt = 0; jt < 4; ++jt) if (jt <= ib) {
#pragma unroll
                for (int s = 0; s < 4; ++s) kf[jt][s] = *(const LAS bf16x8*)(KI + (16 * jt + r) * 136 + 32 * s + 8 * q); }
#pragma unroll
            for (int s = 0; s < 4; ++s) stf[s] = *(const LAS bf16x8*)(STc + (16 * vt + r) * 136 + 32 * s + 8 * q);
#pragma unroll
            for (int k2 = 0; k2 < 2; ++k2) { ktf[k2][0] = tr_frag_perm(KI, 136, 0, (2 * ib + k2) * 16, lane); ktf[k2][1] = tr_frag_perm(KI, 136, 1, (2 * ib + k2) * 16, lane); }
            const f32x4v g0 = *(const LAS f32x4v*)(GAM + (2 * ib) * 16 + 4 * q), g1 = *(const LAS f32x4v*)(GAM + (2 * ib + 1) * 16 + 4 * q);
            __builtin_amdgcn_sched_barrier(0);
            f32x4v sc[4];
#pragma unroll
            for (int jt = 0; jt < 4; ++jt) { f32x4v d = {0.f, 0.f, 0.f, 0.f};
                if (jt <= ib) {
#pragma unroll
                    for (int s = 0; s < 4; ++s) d = __builtin_amdgcn_mfma_f32_16x16x32_bf16(kf[jt][s], bq[s], d, 0, 0, 0);
                    if (jt == ib) {
#pragma unroll
                        for (int e = 0; e < 4; ++e) if (4 * q + e > r) d[e] = 0.f; } }
                sc[jt] = d; }
            f32x4v o = {0.f, 0.f, 0.f, 0.f};
#pragma unroll
            for (int s = 0; s < 4; ++s) o = __builtin_amdgcn_mfma_f32_16x16x32_bf16(stf[s], bq[s], o, 0, 0, 0);
#pragma unroll
            for (int k2 = 0; k2 < 2; ++k2) { f32x4v d = S[k2];
                d = __builtin_amdgcn_mfma_f32_16x16x32_bf16(ktf[k2][0], vtf[0], d, 0, 0, 0);
                d = __builtin_amdgcn_mfma_f32_16x16x32_bf16(ktf[k2][1], vtf[1], d, 0, 0, 0);
                d = d * (k2 ? g1 : g0); S[k2] = d;
                v2u w; w.x = pk2(d[0], d[1]); w.y = pk2(d[2], d[3]); *(LAS v2u*)(STn + (16 * vt + r) * 136 + (2 * ib + k2) * 16 + 4 * q) = w; }
#pragma unroll
            for (int s2 = 0; s2 < 2; ++s2) { v4u w; w.x = pk2(sc[2 * s2][0], sc[2 * s2][1]); w.y = pk2(sc[2 * s2][2], sc[2 * s2][3]); w.z = pk2(sc[2 * s2 + 1][0], sc[2 * s2 + 1][1]); w.w = pk2(sc[2 * s2 + 1][2], sc[2 * s2 + 1][3]);
                o = __builtin_amdgcn_mfma_f32_16x16x32_bf16(vtf[s2], __builtin_bit_cast(bf16x8, w), o, 0, 0, 0); }
            { const size_t t = (size_t)b * T + (size_t)c * 64 + 16 * ib + r;
              v2u w; w.x = pk2(o[0], o[1]); w.y = pk2(o[2], o[3]); *(v2u*)(OB + t * D + h * 128 + vq * 32 + 16 * vt + 4 * q) = w;
              float ss = (o[0] * o[0] + o[1] * o[1]) + (o[2] * o[2] + o[3] * o[3]); ss += __shfl_xor(ss, 16); ss += __shfl_xor(ss, 32);
              if (q == 0) SSQ[(t * 8 + h) * 8 + vq * 2 + vt] = ss; }
            LBAR();
          }
        }
#undef HG_LOAD
#undef HG_STAGE
    }
}
constexpr int FQ_QD = 0, FQ_KI = 34816, FQ_VS = 69632, FQ_ST = 104448, FQ_GAM = 139264, FQ_G = 140288;
constexpr int HG_NSEG = 4, HG_CPS = 128 / HG_NSEG;
constexpr size_t WS_SEND = 960 * MiB, WS_GSEG = 980 * MiB, WS_GV = 982 * MiB;
__device__ __forceinline__ void ph_hgrn_fat(Frame& F, unsigned char* ws) {
    LAS unsigned char* L = F.lds; const int tid = F.tid, lane = F.lane, wave = F.wave, r = lane & 15, q = lane >> 4;
    const bf16* P = F.PROJ; const float* gam = (const float*)(ws + WS_GAM); bf16* OB = (bf16*)(ws + WS_OB);
    for (int task = blockIdx.x; task < NB * 8 * HG_NSEG; task += F.G) {
        const int seg = task % HG_NSEG, bh = task / HG_NSEG, h = bh & 7, b = bh >> 3, ib = wave >> 1, vh = wave & 1, cbeg = seg * HG_CPS;
        f32x4v S[2][4];
#pragma unroll
        for (int k2 = 0; k2 < 2; ++k2)
#pragma unroll
            for (int vt = 0; vt < 4; ++vt) S[k2][vt] = (f32x4v){0.f, 0.f, 0.f, 0.f};
        float gprod = 1.f;
        for (int u = tid; u < 34816 / 4; u += NTHR) ((LAS unsigned*)(L + FQ_ST))[u] = 0u;
        const int prow0 = tid >> 4, pc = tid & 15;
        v4u rqA[2], rkA[2], rvA[2]; float rgA = 0.f;
#define HF_LOAD(c_, rq, rk, rv, rg) do { const size_t rb_ = (size_t)b * T + (size_t)(cbeg + (c_)) * 64; \
            _Pragma("unroll") for (int i_ = 0; i_ < 2; ++i_) { const bf16* s_ = P + (rb_ + prow0 + 32 * i_) * P1LD + h * 128 + 8 * pc; rq[i_] = *(const v4u*)s_; rk[i_] = *(const v4u*)(s_ + 1024); rv[i_] = *(const v4u*)(s_ + 2048); } \
            if (wave < 2) rg = gam[((size_t)b * 128 + cbeg + (c_)) * 1024 + h * 128 + tid]; } while (0)
#define HF_STAGE(bufi, rq, rk, rv, rg) do { LAS bf16* QDs_ = (LAS bf16*)(L + FQ_QD + (bufi) * 17408); LAS bf16* KIs_ = (LAS bf16*)(L + FQ_KI + (bufi) * 17408); LAS bf16* VSs_ = (LAS bf16*)(L + FQ_VS + (bufi) * 17408); \
            _Pragma("unroll") for (int i_ = 0; i_ < 2; ++i_) { const int o_ = (prow0 + 32 * i_) * 136 + 8 * pc; *(LAS v4u*)(QDs_ + o_) = rq[i_]; *(LAS v4u*)(KIs_ + o_) = rk[i_]; *(LAS v4u*)(VSs_ + o_) = rv[i_]; } \
            if (wave < 2) { ((LAS float*)(L + FQ_GAM + (bufi) * 512))[tid] = rg; gprod *= rg; } } while (0)
        HF_LOAD(0, rqA, rkA, rvA, rgA);
        HF_STAGE(0, rqA, rkA, rvA, rgA); HF_LOAD(1, rqA, rkA, rvA, rgA);
        LBAR();
        LAS bf16* ST = (LAS bf16*)(L + FQ_ST);
#pragma unroll 1
        for (int c2 = 0; c2 < HG_CPS; c2 += 2) {
#pragma unroll
          for (int par = 0; par < 2; ++par) { const int c = c2 + par;
            if (c + 1 < HG_CPS) {
                HF_STAGE(par ^ 1, rqA, rkA, rvA, rgA); if (c + 2 < HG_CPS) HF_LOAD(c + 2, rqA, rkA, rvA, rgA); }
            const LAS bf16* QD = (const LAS bf16*)(L + FQ_QD + par * 17408); const LAS bf16* KI = (const LAS bf16*)(L + FQ_KI + par * 17408); const LAS bf16* VS = (const LAS bf16*)(L + FQ_VS + par * 17408);
            const LAS float* GAM = (const LAS float*)(L + FQ_GAM + par * 512);
            bf16x8 bq[4], kf[2][4], stf[4][4], vtf[4][2];
#pragma unroll
            for (int s = 0; s < 4; ++s) bq[s] = *(const LAS bf16x8*)(QD + (16 * ib + r) * 136 + 32 * s + 8 * q);
            f32x4v sc[4];
#pragma unroll
            for (int jh = 0; jh < 2; ++jh) {
#pragma unroll
                for (int j2 = 0; j2 < 2; ++j2) if (2 * jh + j2 <= ib) {
#pragma unroll
                    for (int s = 0; s < 4; ++s) kf[j2][s] = *(const LAS bf16x8*)(KI + (16 * (2 * jh + j2) + r) * 136 + 32 * s + 8 * q); }
                __builtin_amdgcn_sched_barrier(0);
#pragma unroll
                for (int j2 = 0; j2 < 2; ++j2) { const int jt = 2 * jh + j2; f32x4v d = {0.f, 0.f, 0.f, 0.f};
                    if (jt <= ib) {
#pragma unroll
                        for (int s = 0; s < 4; ++s) d = __builtin_amdgcn_mfma_f32_16x16x32_bf16(kf[j2][s], bq[s], d, 0, 0, 0);
                        if (jt == ib) {
#pragma unroll
                            for (int e = 0; e < 4; ++e) if (4 * q + e > r) d[e] = 0.f; } }
                    sc[jt] = d; }
                __builtin_amdgcn_sched_barrier(0); }
            bf16x8 pw[2];
#pragma unroll
            for (int s2 = 0; s2 < 2; ++s2) { v4u w; w.x = pk2(sc[2 * s2][0], sc[2 * s2][1]); w.y = pk2(sc[2 * s2][2], sc[2 * s2][3]); w.z = pk2(sc[2 * s2 + 1][0], sc[2 * s2 + 1][1]); w.w = pk2(sc[2 * s2 + 1][2], sc[2 * s2 + 1][3]);
                pw[s2] = __builtin_bit_cast(bf16x8, w); }
            __builtin_amdgcn_sched_barrier(0);
#pragma unroll
            for (int vt = 0; vt < 4; ++vt)
#pragma unroll
                for (int s = 0; s < 4; ++s) stf[vt][s] = *(const LAS bf16x8*)(ST + (64 * vh + 16 * vt + r) * 136 + 32 * s + 8 * q);
            __builtin_amdgcn_sched_barrier(0);
            f32x4v o[4];
#pragma unroll
            for (int vt = 0; vt < 4; ++vt) { f32x4v d = {0.f, 0.f, 0.f, 0.f};
#pragma unroll
                for (int s = 0; s < 4; ++s) d = __builtin_amdgcn_mfma_f32_16x16x32_bf16(stf[vt][s], bq[s], d, 0, 0, 0);
                o[vt] = d; }
            __builtin_amdgcn_sched_barrier(0);
#pragma unroll
            for (int vt = 0; vt < 4; ++vt) { vtf[vt][0] = tr_frag_perm(VS, 136, 0, 64 * vh + 16 * vt, lane); vtf[vt][1] = tr_frag_perm(VS, 136, 1, 64 * vh + 16 * vt, lane); }
            __builtin_amdgcn_sched_barrier(0);
#pragma unroll
            for (int vt = 0; vt < 4; ++vt)
#pragma unroll
                for (int s2 = 0; s2 < 2; ++s2) o[vt] = __builtin_amdgcn_mfma_f32_16x16x32_bf16(vtf[vt][s2], pw[s2], o[vt], 0, 0, 0);
            LBAR();
            { bf16x8 ktf[2][2];
#pragma unroll
              for (int k2 = 0; k2 < 2; ++k2) { ktf[k2][0] = tr_frag_perm(KI, 136, 0, (2 * ib + k2) * 16, lane); ktf[k2][1] = tr_frag_perm(KI, 136, 1, (2 * ib + k2) * 16, lane); }
              const f32x4v g0 = *(const LAS f32x4v*)(GAM + (2 * ib) * 16 + 4 * q), g1 = *(const LAS f32x4v*)(GAM + (2 * ib + 1) * 16 + 4 * q);
#pragma unroll
              for (int vt = 0; vt < 4; ++vt) { const int v0 = 64 * vh + 16 * vt; const bf16x8 vf0 = tr_frag_perm(VS, 136, 0, v0, lane), vf1 = tr_frag_perm(VS, 136, 1, v0, lane);
#pragma unroll
                for (int k2 = 0; k2 < 2; ++k2) { f32x4v d = S[k2][vt];
                    d = __builtin_amdgcn_mfma_f32_16x16x32_bf16(ktf[k2][0], vf0, d, 0, 0, 0);
                    d = __builtin_amdgcn_mfma_f32_16x16x32_bf16(ktf[k2][1], vf1, d, 0, 0, 0);
                    d = d * (k2 ? g1 : g0); S[k2][vt] = d;
                    v2u w; w.x = pk2(d[0], d[1]); w.y = pk2(d[2], d[3]); *(LAS v2u*)(ST + (v0 + r) * 136 + (2 * ib + k2) * 16 + 4 * q) = w; } } }
            { LAS bf16* OT = (LAS bf16*)(L + FQ_QD + par * 17408);
#pragma unroll
              for (int vt = 0; vt < 4; ++vt) { const f32x4v d = o[vt]; v2u w; w.x = pk2(d[0], d[1]); w.y = pk2(d[2], d[3]); *(LAS v2u*)(OT + (16 * ib + r) * 136 + 64 * vh + 16 * vt + 4 * q) = w; }
              LBAR();
              const size_t rb = (size_t)b * T + (size_t)(cbeg + c) * 64;
#pragma unroll
              for (int i_ = 0; i_ < 2; ++i_) *(v4u*)(OB + (rb + prow0 + 32 * i_) * D + h * 128 + 8 * pc) = *(const LAS v4u*)(OT + (prow0 + 32 * i_) * 136 + 8 * pc); }
          }
        }
#undef HF_LOAD
#undef HF_STAGE
        { float* se = (float*)(ws + WS_SEND) + (size_t)task * 16384;
#pragma unroll
          for (int k2 = 0; k2 < 2; ++k2)
#pragma unroll
              for (int vt = 0; vt < 4; ++vt) *(f32x4v*)(se + (64 * vh + 16 * vt + r) * 128 + (2 * ib + k2) * 16 + 4 * q) = S[k2][vt];
          if (wave < 2) ((float*)(ws + WS_GSEG))[(size_t)task * 128 + tid] = gprod; }
    }
}
__device__ __forceinline__ void ph_hgrn_post2(Frame& F, unsigned char* ws) {
    LAS unsigned char* L = F.lds; const int tid = F.tid, lane = F.lane, wave = F.wave, r = lane & 15, q = lane >> 4, ib = wave >> 1, vh = wave & 1;
    const bf16* P = F.PROJ; const bf16* OB = (const bf16*)(ws + WS_OB); const float* gam = (const float*)(ws + WS_GAM);
    LAS bf16* SI = (LAS bf16*)L; LAS float* XS = (LAS float*)(L + 140288);
    f32x4v cw[4];
#pragma unroll
    for (int vt = 0; vt < 4; ++vt) cw[vt] = *(const f32x4v*)(F.c_norm_w + 64 * vh + 16 * vt + 4 * q);
    const int prow0 = tid >> 4, pc = tid & 15;
    for (int task = blockIdx.x; task < NB * 8 * HG_NSEG; task += F.G) {
        const int seg = task % HG_NSEG, bh = task / HG_NSEG, h = bh & 7, b = bh >> 3, cbeg = seg * HG_CPS;
        LBAR();
        for (int u = tid; u < 128 * 32; u += NTHR) { const int v = u >> 5, k4 = (u & 31) * 4; f32x4v acc = {0.f, 0.f, 0.f, 0.f};
            for (int s1 = 0; s1 < seg; ++s1) { const size_t tk = (size_t)(bh * HG_NSEG + s1);
                const f32x4v gm = *(const f32x4v*)((const float*)(ws + WS_GSEG) + tk * 128 + k4), se = *(const f32x4v*)((const float*)(ws + WS_SEND) + tk * 16384 + v * 128 + k4); acc = acc * gm + se; }
            v2u w; w.x = pk2(acc[0], acc[1]); w.y = pk2(acc[2], acc[3]); *(LAS v2u*)(SI + v * 136 + k4) = w; }
        v4u rqA[2], roA[2], rtA[2]; f32x4v ggA[2], gr0 = {1.f, 1.f, 1.f, 1.f}, gr1 = gr0;
#pragma unroll
        for (int i = 0; i < 2; ++i) rqA[i] = (v4u){0u, 0u, 0u, 0u};
#define P2_LOAD(c_, rq, ro, rt, gg) do { const size_t rb_ = (size_t)b * T + (size_t)(cbeg + (c_)) * 64; \
            _Pragma("unroll") for (int i_ = 0; i_ < 2; ++i_) { const size_t row_ = rb_ + prow0 + 32 * i_; if (seg > 0) rq[i_] = *(const v4u*)(P + row_ * P1LD + h * 128 + 8 * pc); \
                ro[i_] = *(const v4u*)(OB + row_ * D + h * 128 + 8 * pc); rt[i_] = *(const v4u*)(P + row_ * P1LD + 3072 + h * 128 + 8 * pc); } \
            if (seg > 0) { const float* g_ = gam + ((size_t)b * 128 + cbeg + (c_)) * 1024 + h * 128 + 8 * pc; gg[0] = *(const f32x4v*)g_; gg[1] = *(const f32x4v*)(g_ + 4); } } while (0)
#define P2_STAGE(bufi, rq, ro, rt, gg) do { \
            _Pragma("unroll") for (int i_ = 0; i_ < 2; ++i_) { const int o_ = (prow0 + 32 * i_) * 136 + 8 * pc; v4u w_ = rq[i_]; \
                if (seg > 0) { w_.x = pk2(bflo(w_.x) * gr0[0], bfhi(w_.x) * gr0[1]); w_.y = pk2(bflo(w_.y) * gr0[2], bfhi(w_.y) * gr0[3]); w_.z = pk2(bflo(w_.z) * gr1[0], bfhi(w_.z) * gr1[1]); w_.w = pk2(bflo(w_.w) * gr1[2], bfhi(w_.w) * gr1[3]); } \
                *(LAS v4u*)((LAS bf16*)(L + 34816 + (bufi) * 17408) + o_) = w_; \
                *(LAS v4u*)((LAS bf16*)(L + 69632 + (bufi) * 17408) + o_) = ro[i_]; *(LAS v4u*)((LAS bf16*)(L + 104448 + (bufi) * 17408) + o_) = rt[i_]; } \
            if (seg > 0) { gr0 = gr0 * gg[0]; gr1 = gr1 * gg[1]; } } while (0)
        P2_LOAD(0, rqA, roA, rtA, ggA);
        P2_STAGE(0, rqA, roA, rtA, ggA); P2_LOAD(1, rqA, roA, rtA, ggA);
        LBAR();
#pragma unroll 1
        for (int c2 = 0; c2 < HG_CPS; c2 += 2) {
#pragma unroll
          for (int par = 0; par < 2; ++par) { const int c = c2 + par;
            if (c + 1 < HG_CPS) { P2_STAGE(par ^ 1, rqA, roA, rtA, ggA); if (c + 2 < HG_CPS) P2_LOAD(c + 2, rqA, roA, rtA, ggA); }
            const LAS bf16* TQ = (const LAS bf16*)(L + 34816 + par * 17408); LAS bf16* TO = (LAS bf16*)(L + 69632 + par * 17408); const LAS bf16* TG = (const LAS bf16*)(L + 104448 + par * 17408);
            v2u ovr[4]; bf16x8 bq_[4], sif[4][4];
#pragma unroll
            for (int vt = 0; vt < 4; ++vt) ovr[vt] = *(const LAS v2u*)(TO + (16 * ib + r) * 136 + 64 * vh + 16 * vt + 4 * q);
            if (seg > 0) {
#pragma unroll
                for (int s = 0; s < 4; ++s) bq_[s] = *(const LAS bf16x8*)(TQ + (16 * ib + r) * 136 + 32 * s + 8 * q);
#pragma unroll
                for (int vt = 0; vt < 4; ++vt)
#pragma unroll
                    for (int s = 0; s < 4; ++s) sif[vt][s] = *(const LAS bf16x8*)(SI + (64 * vh + 16 * vt + r) * 136 + 32 * s + 8 * q); }
            __builtin_amdgcn_sched_barrier(0);
            f32x4v o_[4];
#pragma unroll
            for (int vt = 0; vt < 4; ++vt) o_[vt] = (f32x4v){bflo(ovr[vt].x), bfhi(ovr[vt].x), bflo(ovr[vt].y), bfhi(ovr[vt].y)};
            if (seg > 0) {
#pragma unroll
                for (int vt = 0; vt < 4; ++vt) { f32x4v d_ = o_[vt];
#pragma unroll
                    for (int s = 0; s < 4; ++s) d_ = __builtin_amdgcn_mfma_f32_16x16x32_bf16(sif[vt][s], bq_[s], d_, 0, 0, 0);
                    o_[vt] = d_; } }
            float ss_ = 0.f;
#pragma unroll
            for (int vt = 0; vt < 4; ++vt) ss_ += (o_[vt][0] * o_[vt][0] + o_[vt][1] * o_[vt][1]) + (o_[vt][2] * o_[vt][2] + o_[vt][3] * o_[vt][3]);
            ss_ += __shfl_xor(ss_, 16); ss_ += __shfl_xor(ss_, 32);
            if (q == 0) XS[par * 128 + ib * 32 + vh * 16 + r] = ss_;
            LBAR();
            const float rs_ = __builtin_amdgcn_rsqf((XS[par * 128 + ib * 32 + r] + XS[par * 128 + ib * 32 + 16 + r]) * (1.f / 128.f) + 1e-6f);
#pragma unroll
            for (int vt = 0; vt < 4; ++vt) { const int off_ = (16 * ib + r) * 136 + 64 * vh + 16 * vt + 4 * q; const v2u tv = *(const LAS v2u*)(TG + off_);
                const float g0_ = bflo(tv.x), g1_ = bfhi(tv.x), g2_ = bflo(tv.y), g3_ = bfhi(tv.y); v2u w_;
                w_.x = pk2(o_[vt][0] * rs_ * cw[vt][0] * siluf_(g0_), o_[vt][1] * rs_ * cw[vt][1] * siluf_(g1_)); w_.y = pk2(o_[vt][2] * rs_ * cw[vt][2] * siluf_(g2_), o_[vt][3] * rs_ * cw[vt][3] * siluf_(g3_));
                *(LAS v2u*)(TO + off_) = w_; }
            LBAR();
            { const size_t rb_ = (size_t)b * T + (size_t)(cbeg + c) * 64;
#pragma unroll
              for (int i_ = 0; i_ < 2; ++i_) *(v4u*)(F.HB + (rb_ + prow0 + 32 * i_) * D + h * 128 + 8 * pc) = *(const LAS v4u*)(TO + (prow0 + 32 * i_) * 136 + 8 * pc); }
          }
        }
#undef P2_LOAD
#undef P2_STAGE
    }
}
__device__ __forceinline__ void ph_hgrn_post(Frame& F, unsigned char* ws) {
    const int gw = F.vcu * NWAVES + F.wave, NGW = F.G * NWAVES, lane = F.lane;
    const bf16* OB = (const bf16*)(ws + WS_OB); const float* SSQ = (const float*)(ws + WS_SSQ); const bf16* P = F.PROJ;
    const int hd = lane >> 3, c0 = 16 * lane;
    f32x4v cw[4];
#pragma unroll
    for (int i = 0; i < 4; ++i) cw[i] = *(const f32x4v*)(F.c_norm_w + (c0 & 127) + 4 * i);
    v4u a0[6], a1[6], b0[6], b1[6];
#define POST_LD(v, mm) do { if ((mm) < M) { const v4u* s_ = (const v4u*)(SSQ + ((size_t)(mm) * 8 + hd) * 8); v[0] = s_[0]; v[1] = s_[1]; \
        const v4u* o_ = (const v4u*)(OB + (size_t)(mm) * D + c0); v[2] = o_[0]; v[3] = o_[1]; const v4u* g_ = (const v4u*)(P + (size_t)(mm) * P1LD + 3072 + c0); v[4] = g_[0]; v[5] = g_[1]; } } while (0)
#define POST_PR(v, mm) do { if ((mm) < M) { const f32x4v s0_ = __builtin_bit_cast(f32x4v, v[0]), s1_ = __builtin_bit_cast(f32x4v, v[1]); \
        const float rs_ = __builtin_amdgcn_rsqf(((s0_[0] + s0_[1]) + (s0_[2] + s0_[3]) + (s1_[0] + s1_[1]) + (s1_[2] + s1_[3])) * (1.f / 128.f) + 1e-6f); \
        _Pragma("unroll") for (int i = 0; i < 2; ++i) { const v4u ow_ = v[2 + i], gw_ = v[4 + i]; v4u res_; \
            _Pragma("unroll") for (int e = 0; e < 4; ++e) { const float w0_ = cw[2 * i + (e >> 1)][2 * (e & 1)], w1_ = cw[2 * i + (e >> 1)][2 * (e & 1) + 1]; \
                res_[e] = pk2(bflo(ow_[e]) * rs_ * w0_ * siluf_(bflo(gw_[e])), bfhi(ow_[e]) * rs_ * w1_ * siluf_(bfhi(gw_[e]))); } \
            *(v4u*)(F.HB + (size_t)(mm) * D + c0 + 8 * i) = res_; } } } while (0)
    int m = gw; POST_LD(a0, m); POST_LD(a1, m + NGW);
#pragma unroll 1
    for (; m < M; m += 4 * NGW) {
        POST_LD(b0, m + 2 * NGW); POST_LD(b1, m + 3 * NGW);
        POST_PR(a0, m); POST_PR(a1, m + NGW);
        POST_LD(a0, m + 4 * NGW); POST_LD(a1, m + 5 * NGW);
        POST_PR(b0, m + 2 * NGW); POST_PR(b1, m + 3 * NGW);
    }
#undef POST_LD
#undef POST_PR
}
#ifndef MK_PER_PHASE
#define MK_PER_PHASE 0
#endif
#ifndef RWKV_NAIVE
#define RWKV_NAIVE 0
#endif
#ifndef HGRN_NAIVE
#define HGRN_NAIVE 0
#endif
constexpr int N_PHASES = 13;
struct Args { const float* in[23]; float* out; unsigned char* ws; int ph_lo, ph_hi; };
__global__ void __launch_bounds__(NTHR, 2) fwd_kernel(Args args) {
    extern __shared__ __attribute__((aligned(16))) unsigned char lds[];
    Frame F;
    F.lds = (LAS unsigned char*)lds;
    F.tid = threadIdx.x; F.lane = F.tid & 63; F.wave = __builtin_amdgcn_readfirstlane(F.tid >> 6);
    F.G = gridDim.x; { const int bx = blockIdx.x; F.vcu = (F.G % 8 == 0) ? (bx % 8) * (F.G / 8) + bx / 8 : bx; }
    unsigned char* ws = args.ws;
    F.x = args.in[0]; F.rel_bias = args.in[1]; F.lower_bounds = args.in[2]; F.pre0 = args.in[3]; F.post0 = args.in[4]; F.w_in0 = args.in[5]; F.w_out0 = args.in[6];
    F.a_mu = args.in[7]; F.a_w0 = args.in[8]; F.a_w2 = args.in[9]; F.a_a0 = args.in[10]; F.a_a2 = args.in[11]; F.a_k_k = args.in[12]; F.a_k_a = args.in[13]; F.a_r_k = args.in[14];
    F.a_ln_w = args.in[15]; F.a_ln_b = args.in[16]; F.sinks = args.in[17]; F.pre1 = args.in[18]; F.post1 = args.in[19]; F.w_in1 = args.in[20]; F.w_out1 = args.in[21]; F.c_norm_w = args.in[22];
    F.out = args.out;
    F.W0T = (bf16*)(ws + WS_W0T); F.WO0T = (bf16*)(ws + WS_WO0T); F.W1T = (bf16*)(ws + WS_W1T); F.WO1T = (bf16*)(ws + WS_WO1T);
    F.HA = (bf16*)(ws + WS_HA); F.HB = (bf16*)(ws + WS_HB); F.PROJ = (bf16*)(ws + WS_PROJ); F.Y = (bf16*)(ws + WS_Y);
    F.bias_tab = (float*)(ws + WS_TAB); F.lb_tab = (float*)(ws + WS_TAB + 4096);
    for (int u = F.tid; u < (LDS_BYTES - LDSCTL_OFF) / 4; u += NTHR) ((LAS unsigned*)(F.lds + LDSCTL_OFF))[u] = 0u;
    __syncthreads();
    const int lo = args.ph_lo, hi = args.ph_hi;
    XcdBarrier bar; bar.bar = (unsigned*)(ws + WS_CTL) + CW_BAR; bar.x = 0; bar.st = nullptr;
    if (hi - lo > 1) bar = xcd_barrier_post((unsigned*)(ws + WS_CTL) + CW_BAR, (volatile LAS unsigned*)(F.lds + MISC_OFF) + 8);
#define IN(k) (lo <= (k) && (k) < hi)
#define SEAM(k) do { if (IN(k) && IN((k) + 1)) xcd_barrier(bar); } while (0)
    if (IN(0)) { ph_prologue(F, ws); } SEAM(0);
    if (IN(1)) { pg8::Gemm g{F.HA, F.W0T, M, N0P, D}; pg8::StaticOrder S; S.init(M, N0P, F.G, (int)blockIdx.x); pg8::EpiBf16 E{F.PROJ, P0LD};
        pg8::gemm_phase<pg8::EpiBf16, pg8::StaticOrder, true, true>(F.lds, g, S, E); } SEAM(1);
#if RWKV_NAIVE
    if (IN(2)) { ph_attention(F); __syncthreads(); ph_rwkv_naive(F); } SEAM(2);
    SEAM(3);
    SEAM(4);
#else
    if (IN(2)) { ph_attention(F); __syncthreads(); ph_rwkv_passA(F, ws); } SEAM(2);
    if (IN(3)) { ph_rwkv_passB(F, ws); } SEAM(3);
    if (IN(4)) { ph_rwkv_passC(F, ws); } SEAM(4);
#endif
    if (IN(5)) { pg8::Gemm g{F.HB, F.WO0T, M, D, D}; pg8::StaticOrder S; S.init(M, D, F.G, (int)blockIdx.x); pg8::EpiBf16 E{F.Y, D};
        pg8::gemm_phase<pg8::EpiBf16, pg8::StaticOrder, true, true>(F.lds, g, S, E); } SEAM(5);
    if (IN(6)) { ph_resnorm0(F, F.x, F.Y, F.post0, F.pre1, F.HA); } SEAM(6);
    if (IN(7)) { pg8::Gemm g{F.HA, F.W1T, M, N1, D}; pg8::StaticOrder S; S.init(M, N1, F.G, (int)blockIdx.x); pg8::EpiBf16 E{F.PROJ, P1LD};
        pg8::gemm_phase<pg8::EpiBf16, pg8::StaticOrder, true, true>(F.lds, g, S, E); } SEAM(7);
#if HGRN_NAIVE
    if (IN(8)) { ph_hgrn_naive(F); } SEAM(8);
    SEAM(9);
    SEAM(10);
#else
    if (IN(8)) { ph_hgrn_prep(F, ws); } SEAM(8);
    if (IN(9)) { ph_hgrn_fat(F, ws); } SEAM(9);
    if (IN(10)) { ph_hgrn_post2(F, ws); } SEAM(10);
#endif
    if (IN(11)) { pg8::Gemm g{F.HB, F.WO1T, M, D, D}; pg8::StaticOrder S; S.init(M, D, F.G, (int)blockIdx.x); pg8::EpiBf16 E{F.HA, D};
        pg8::gemm_phase<pg8::EpiBf16, pg8::StaticOrder, true, true>(F.lds, g, S, E); } SEAM(11);
    if (IN(12)) { ph_resnorm1(F, F.Y, F.HA, F.post1, F.out); }
#undef IN
#undef SEAM
}

extern "C" void kernel_launch(void* const* d_in, const int* in_sizes, int n_in, void* d_out, int out_size, void* d_ws, size_t ws_size, hipStream_t stream) {
    static int grid = 0;
    if (grid == 0) {
        if (n_in != 23 || in_sizes[0] != M * D || out_size != M * D || ws_size < WS_END) { fprintf(stderr, "kernel_launch: unexpected shapes (n_in %d, in0 %d, out %d, ws %zu); nothing launched\n", n_in, n_in > 0 ? in_sizes[0] : -1, out_size, ws_size); grid = -1; return; }
        int dev = 0, cus = 0, per_cu = 0;
        if (hipGetDevice(&dev) != hipSuccess || hipDeviceGetAttribute(&cus, hipDeviceAttributeMultiprocessorCount, dev) != hipSuccess) { grid = -1; return; }
        if (hipFuncSetAttribute((const void*)fwd_kernel, hipFuncAttributeMaxDynamicSharedMemorySize, LDS_BYTES) != hipSuccess) { fprintf(stderr, "kernel_launch: hipFuncSetAttribute failed\n"); grid = -1; return; }
        if (hipOccupancyMaxActiveBlocksPerMultiprocessor(&per_cu, (const void*)fwd_kernel, NTHR, LDS_BYTES) != hipSuccess || per_cu < 1) { fprintf(stderr, "kernel_launch: occupancy query says %d blocks per CU\n", per_cu); (void)hipGetLastError(); grid = -1; return; }
        grid = cus;
    }
    if (grid < 0) return;
    (void)hipMemsetAsync((char*)d_ws + WS_CTL, 0, CTL_ZERO_BYTES, stream);
    Args a{};
    for (int i = 0; i < 23; ++i) a.in[i] = (const float*)d_in[i];
    a.out = (float*)d_out; a.ws = (unsigned char*)d_ws;
#if MK_PER_PHASE
    for (int p = 0; p < N_PHASES; ++p) { a.ph_lo = p; a.ph_hi = p + 1; hipLaunchKernelGGL(fwd_kernel, dim3(grid), dim3(NTHR), LDS_BYTES, stream, a); }
#else
    a.ph_lo = 0; a.ph_hi = N_PHASES; hipLaunchKernelGGL(fwd_kernel, dim3(grid), dim3(NTHR), LDS_BYTES, stream, a);
#endif
}
```

```cpp
#include <hip/hip_runtime.h>
#include <cstdio>
#include <cstdint>
namespace pg8 {
#define PG8_LAS __attribute__((address_space(3)))
typedef unsigned short bf16_t;
typedef short bf16x8 __attribute__((ext_vector_type(8)));
typedef float f32x4 __attribute__((ext_vector_type(4)));
typedef unsigned u32x4 __attribute__((ext_vector_type(4)));
constexpr int BM = 256, BK = 64, HALF = 128, HTB = HALF * BK * 2  , STAGE_BYTES = 8 * HTB, NXCD = 8, WGM = 8;

__host__ __device__ __forceinline__ int lds_byte(int r, int c) { const int st = (r >> 4) * 2 + (c >> 5), rr = r & 15, cc = c & 31, ob = rr * 64 + cc * 2; return st * 1024 + (ob ^ (((ob >> 9) & 1) << 5)); }
__host__ __device__ __forceinline__ void stage_rc(int b, int& R, int& C) { const int st = b / 1024, sb = b % 1024, swz = sb ^ (((sb >> 9) & 1) << 5); R = (st >> 1) * 16 + swz / 64; C = (st & 1) * 32 + (swz % 64) / 2; }
__host__ __device__ __forceinline__ int perm32(int rho) { const int n = rho >> 4, i = rho & 15; return 8 * (i >> 2) + 4 * n + (i & 3); }

struct Unit { int pm, pn; };
struct Gemm { const bf16_t* A; const bf16_t* Bt; int M, N, K; };

struct StaticOrder {
    int nM, nN, nwg, G, c;
    __host__ __device__ void init(int M, int N, int G_, int c_) { nM = M / BM; nN = N / BM; nwg = nM * nN; G = G_; c = c_; }
    __host__ __device__ bool next(int i, Unit& u) const {
        const long L = (long)i * G + c; if (L >= nwg) return false;
        int wgid = (int)L; { const int q = nwg / NXCD, r = nwg % NXCD, xcd = wgid % NXCD, off = wgid / NXCD; wgid = (xcd < r ? xcd * (q + 1) : r * (q + 1) + (xcd - r) * q) + off; }
        const int nig = WGM * nN, gid = wgid / nig, fm = gid * WGM, gsz = (nM - fm) < WGM ? (nM - fm) : WGM;
        u.pm = fm + ((wgid % nig) % gsz); u.pn = (wgid % nig) / gsz; return true;
    }
    __device__ __forceinline__ void a_ready(const Unit&) const {}
    __device__ __forceinline__ void done(const Unit&) const {}
};

__device__ __forceinline__ unsigned cvt_pk_bf16(float lo, float hi) { unsigned r; asm volatile("v_cvt_pk_bf16_f32 %0, %1, %2" : "=v"(r) : "v"(lo), "v"(hi)); return r; }
struct EpiBf16 {
    static constexpr bool PERM = true, AFTER_DRAIN = false;
    bf16_t* O; int ldc;
    __device__ __forceinline__ void operator()(const f32x4 (&acc)[2][2][4][2], const Unit& u, int wr, int wc, int fr, int fq) const {
        const int row0 = u.pm * BM + wr * 64 + fr; const int col0 = u.pn * BM + wc * 32 + 8 * fq;
#pragma unroll
        for (int ai = 0; ai < 2; ++ai)
#pragma unroll
            for (int m = 0; m < 4; ++m) { bf16_t* rowp = O + (size_t)(row0 + ai * HALF + m * 16) * ldc + col0;
#pragma unroll
                for (int bj = 0; bj < 2; ++bj) { const f32x4 v0 = acc[ai][bj][m][0], v1 = acc[ai][bj][m][1];
                    u32x4 w; w.x = cvt_pk_bf16(v0[0], v0[1]); w.y = cvt_pk_bf16(v0[2], v0[3]); w.z = cvt_pk_bf16(v1[0], v1[1]); w.w = cvt_pk_bf16(v1[2], v1[3]);
                    *(u32x4*)(rowp + bj * HALF) = w; } }
    }
};

template <class Epi, class Sched, bool ALIGN_EPI = false, bool SP2 = false>
__device__ __forceinline__ void gemm_phase(PG8_LAS unsigned char* lds, const Gemm g, const Sched& S, const Epi& E) {
    const int tid = threadIdx.x, wid = __builtin_amdgcn_readfirstlane(tid >> 6), lane = tid & 63, wr = wid >> 2, wc = wid & 3, fr = lane & 15, fq = lane >> 4;
    const int K = g.K, nt = K / BK;
    unsigned voffA[2], voffB[2];
#pragma unroll
    for (int i = 0; i < 2; ++i) { int R, C; stage_rc(tid * 16 + i * 8192, R, C); const int Rb = Epi::PERM ? ((R & ~31) + perm32(R & 31)) : R;
        voffA[i] = (unsigned)(R * K + C) * 2u; voffB[i] = (unsigned)(Rb * K + C) * 2u; }
    const size_t kstep = (size_t)(BK * 2);
    const size_t hstep = (size_t)HALF * K * 2;
    const size_t tstep = 2 * hstep;
    const unsigned ldsw = (unsigned)wid * 1024u;
    const int aoff = lds_byte(wr * 64 + fr, fq * 8), boff = lds_byte(wc * 32 + fr, fq * 8);
#define PG8_SA(b, h) (((b) * 2 + (h)) * HTB)
#define PG8_SB(b, h) ((4 + (b) * 2 + (h)) * HTB)
#define PG8_STAGE(bufoff, gbase, voff) do { _Pragma("unroll") for (int _i = 0; _i < 2; ++_i) \
        __builtin_amdgcn_global_load_lds((const unsigned*)((const char*)(gbase) + (voff)[_i]), (PG8_LAS unsigned*)(lds + (bufoff) + ldsw + _i * 8192), 16, 0, 0); } while (0)
#define PG8_LDA(dst, b, h) do { _Pragma("unroll") for (int m = 0; m < 4; ++m) _Pragma("unroll") for (int k = 0; k < 2; ++k) dst[m][k] = *(const PG8_LAS bf16x8*)(lds + PG8_SA(b, h) + aoff + m * 2048 + k * 1024); } while (0)
#define PG8_LDB(dst, b, h) do { _Pragma("unroll") for (int n = 0; n < 2; ++n) _Pragma("unroll") for (int k = 0; k < 2; ++k) dst[n][k] = *(const PG8_LAS bf16x8*)(lds + PG8_SB(b, h) + boff + n * 2048 + k * 1024); } while (0)
#define PG8_MMA(ai, bj, At, Bt) do { __builtin_amdgcn_s_setprio(1); _Pragma("unroll") for (int m = 0; m < 4; ++m) _Pragma("unroll") for (int n = 0; n < 2; ++n) _Pragma("unroll") for (int k = 0; k < 2; ++k) \
        acc[ai][bj][m][n] = __builtin_amdgcn_mfma_f32_16x16x32_bf16(Bt[n][k], At[m][k], acc[ai][bj][m][n], 0, 0, 0); __builtin_amdgcn_s_setprio(0); } while (0)
#define PG8_WAIT_V(n) asm volatile("s_waitcnt vmcnt(" #n ")" ::: "memory")
#define PG8_WAIT_L(n) asm volatile("s_waitcnt lgkmcnt(" #n ")" ::: "memory")
#define PG8_BAR __builtin_amdgcn_s_barrier()
#define PG8_SCHED __builtin_amdgcn_sched_barrier(0)
    Unit cur, nxt; int ui = 0;
    if (!S.next(0, cur)) return;
    f32x4 acc[2][2][4][2];
#pragma unroll
    for (int a = 0; a < 2; ++a)
#pragma unroll
        for (int b = 0; b < 2; ++b)
#pragma unroll
            for (int m = 0; m < 4; ++m)
#pragma unroll
                for (int n = 0; n < 2; ++n) acc[a][b][m][n] = (f32x4){0.f, 0.f, 0.f, 0.f};
    bf16x8 At[4][2], B0[2][2], B1[2][2];
    const char* cA = (const char*)g.A + (size_t)cur.pm * tstep; const char* cB = (const char*)g.Bt + (size_t)cur.pn * tstep;
    S.a_ready(cur);
    if constexpr (SP2) {
        PG8_STAGE(PG8_SB(0, 0), cB, voffB); PG8_STAGE(PG8_SB(0, 1), cB + hstep, voffB); PG8_STAGE(PG8_SA(0, 0), cA, voffA); PG8_STAGE(PG8_SA(0, 1), cA + hstep, voffA);
        if (wr == 1) PG8_BAR;
        PG8_WAIT_V(2); PG8_BAR;
        PG8_STAGE(PG8_SB(1, 0), cB + kstep, voffB); PG8_STAGE(PG8_SA(1, 0), cA + kstep, voffA); PG8_STAGE(PG8_SB(1, 1), cB + hstep + kstep, voffB);
        PG8_WAIT_V(6); PG8_BAR;
    } else {
        PG8_STAGE(PG8_SB(0, 0), cB, voffB); PG8_STAGE(PG8_SA(0, 0), cA, voffA); PG8_STAGE(PG8_SB(0, 1), cB + hstep, voffB); PG8_STAGE(PG8_SA(0, 1), cA + hstep, voffA);
        if (wr == 1) PG8_BAR;
        PG8_WAIT_V(4); PG8_BAR;
        PG8_STAGE(PG8_SB(1, 0), cB + kstep, voffB); PG8_STAGE(PG8_SA(1, 0), cA + kstep, voffA); PG8_STAGE(PG8_SB(1, 1), cB + hstep + kstep, voffB);
        PG8_WAIT_V(6); PG8_BAR;
    }
    for (;;) {
        const bool has_next = S.next(ui + 1, nxt);
        const char* nA = has_next ? (const char*)g.A + (size_t)nxt.pm * tstep : cA; const char* nB = has_next ? (const char*)g.Bt + (size_t)nxt.pn * tstep : cB;
        for (int t = 0; t < nt; t += 2) {
            const bool last = (t == nt - 2);
            const char* a1 = cA + (size_t)(t + 1) * kstep;
            const char* a2 = last ? nA : cA + (size_t)(t + 2) * kstep; const char* b2 = last ? nB : cB + (size_t)(t + 2) * kstep;
            const char* a3 = a2 + kstep; const char* b3 = b2 + kstep;
            if (last && has_next) S.a_ready(nxt);
            if constexpr (SP2) {
            PG8_LDB(B0, 0, 0); PG8_LDB(B1, 0, 1); PG8_SCHED; PG8_LDA(At, 0, 0); PG8_STAGE(PG8_SA(1, 1), a1 + hstep, voffA);
            PG8_WAIT_V(8); PG8_WAIT_L(0); PG8_BAR; PG8_MMA(0, 0, At, B0); PG8_MMA(0, 1, At, B1); PG8_BAR; PG8_SCHED;
            PG8_LDA(At, 0, 1); PG8_STAGE(PG8_SB(0, 0), b2, voffB); PG8_STAGE(PG8_SB(0, 1), b2 + hstep, voffB); PG8_STAGE(PG8_SA(0, 0), a2, voffA);
            PG8_WAIT_V(8); PG8_WAIT_L(0); PG8_BAR; PG8_MMA(1, 0, At, B0); PG8_MMA(1, 1, At, B1); PG8_BAR; PG8_SCHED;
            PG8_LDB(B0, 1, 0); PG8_LDB(B1, 1, 1); PG8_SCHED; PG8_LDA(At, 1, 0); PG8_STAGE(PG8_SA(0, 1), a2 + hstep, voffA);
            PG8_WAIT_V(8); PG8_WAIT_L(0); PG8_BAR; PG8_MMA(0, 0, At, B0); PG8_MMA(0, 1, At, B1); PG8_BAR; PG8_SCHED;
            PG8_LDA(At, 1, 1); PG8_STAGE(PG8_SB(1, 0), b3, voffB); PG8_STAGE(PG8_SB(1, 1), b3 + hstep, voffB); PG8_STAGE(PG8_SA(1, 0), a3, voffA);
            PG8_WAIT_V(8); PG8_WAIT_L(0); PG8_BAR; PG8_MMA(1, 0, At, B0); PG8_MMA(1, 1, At, B1); PG8_BAR; PG8_SCHED;
            } else {
            PG8_LDB(B0, 0, 0); PG8_SCHED; PG8_LDA(At, 0, 0); PG8_STAGE(PG8_SA(1, 1), a1 + hstep, voffA);
            PG8_WAIT_L(8); PG8_BAR; PG8_WAIT_L(0); PG8_MMA(0, 0, At, B0); PG8_BAR; PG8_SCHED;
            PG8_LDB(B1, 0, 1); PG8_STAGE(PG8_SB(0, 0), b2, voffB);
            PG8_BAR; PG8_WAIT_L(0); PG8_MMA(0, 1, At, B1); PG8_BAR;
            PG8_LDA(At, 0, 1); PG8_STAGE(PG8_SA(0, 0), a2, voffA);
            PG8_BAR; PG8_WAIT_L(0); PG8_MMA(1, 0, At, B0); PG8_BAR; PG8_SCHED;
            PG8_STAGE(PG8_SB(0, 1), b2 + hstep, voffB);
            PG8_WAIT_V(6); PG8_BAR; PG8_MMA(1, 1, At, B1); PG8_BAR;
            PG8_LDB(B0, 1, 0); PG8_SCHED; PG8_LDA(At, 1, 0); PG8_STAGE(PG8_SA(0, 1), a2 + hstep, voffA);
            PG8_WAIT_L(8); PG8_BAR; PG8_WAIT_L(0); PG8_MMA(0, 0, At, B0); PG8_BAR; PG8_SCHED;
            PG8_LDB(B1, 1, 1); PG8_STAGE(PG8_SB(1, 0), b3, voffB);
            PG8_BAR; PG8_WAIT_L(0); PG8_MMA(0, 1, At, B1); PG8_BAR;
            PG8_LDA(At, 1, 1); PG8_STAGE(PG8_SA(1, 0), a3, voffA);
            PG8_BAR; PG8_WAIT_L(0); PG8_MMA(1, 0, At, B0); PG8_BAR; PG8_SCHED;
            PG8_STAGE(PG8_SB(1, 1), b3 + hstep, voffB);
            PG8_WAIT_V(6); PG8_BAR; PG8_MMA(1, 1, At, B1); PG8_BAR;
            }
        }
        if constexpr (ALIGN_EPI) { if (wr == 0) PG8_BAR; }
        if constexpr (!Epi::AFTER_DRAIN) { E(acc, cur, wr, wc, fr, fq); S.done(cur); }
        if (!has_next) break;
#pragma unroll
        for (int a = 0; a < 2; ++a)
#pragma unroll
            for (int b = 0; b < 2; ++b)
#pragma unroll
                for (int m = 0; m < 4; ++m)
#pragma unroll
                    for (int n = 0; n < 2; ++n) acc[a][b][m][n] = (f32x4){0.f, 0.f, 0.f, 0.f};
        cur = nxt; cA = nA; cB = nB; ++ui;
        if constexpr (ALIGN_EPI) { if (wr == 1) PG8_BAR; }
    }
    PG8_WAIT_V(0);
    if constexpr (!ALIGN_EPI) { if (wr == 0) PG8_BAR; }
    PG8_BAR;
    if constexpr (Epi::AFTER_DRAIN) { E.fused(acc, cur, wr, wc, fr, fq, lds, wid, lane); S.done(cur); }
#undef PG8_SA
#undef PG8_SB
#undef PG8_STAGE
#undef PG8_LDA
#undef PG8_LDB
#undef PG8_MMA
#undef PG8_WAIT_V
#undef PG8_WAIT_L
#undef PG8_BAR
#undef PG8_SCHED
}
}
constexpr int NWAVES = 8, NTHR = 512;
constexpr int NB = 8, T = 8192, D = 1024, M = NB * T;
constexpr int N0 = 3392, N0P = 3584, N1 = 4096;
constexpr int C_R = 0, C_K = 512, C_V = 1024, C_WL = 1536, C_AL = 1568, C_GA = 1600, C_QB = 2112, C_KB = 2624, C_VB = 2752, C_GB = 2880;
constexpr int P0LD = N0P, P1LD = N1;
constexpr size_t MiB = 1u << 20;
constexpr size_t WS_CTL = 0, CTL_ZERO_BYTES = 65536;
constexpr size_t WS_W0T = 2 * MiB, WS_WO0T = 10 * MiB, WS_W1T = 12 * MiB, WS_WO1T = 20 * MiB, WS_TAB = 23 * MiB;
constexpr size_t WS_HA = 32 * MiB, WS_HB = 160 * MiB, WS_PROJ = 288 * MiB, WS_Y = 800 * MiB, WS_END = 996 * MiB;
constexpr int CW_BAR = 4096;
constexpr int LDS_BYTES = 147456, LDSCTL_OFF = 143360, MISC_OFF = LDSCTL_OFF + 320;

#define GAS __attribute__((address_space(1)))
#define LAS __attribute__((address_space(3)))
typedef unsigned short bf16;
typedef unsigned v4u __attribute__((ext_vector_type(4)));
typedef unsigned v2u __attribute__((ext_vector_type(2)));
typedef float f32x4 __attribute__((ext_vector_type(4)));
typedef float f32x16 __attribute__((ext_vector_type(16)));
typedef short bf16x8 __attribute__((ext_vector_type(8)));
typedef GAS unsigned gu32;
#define RLX_AGENT __ATOMIC_RELAXED, __HIP_MEMORY_SCOPE_AGENT
typedef float f32x2_t __attribute__((ext_vector_type(2))); typedef __bf16 bf16x2_t __attribute__((ext_vector_type(2)));
__device__ __forceinline__ unsigned pk2(float lo, float hi) { const f32x2_t v = {lo, hi}; const bf16x2_t b = __builtin_convertvector(v, bf16x2_t); return __builtin_bit_cast(unsigned, b); }
__device__ __forceinline__ unsigned f2bf(float f) { return pk2(f, 0.f) & 0xffffu; }
__device__ __forceinline__ float bf2f(unsigned v) { return __uint_as_float(v << 16); }
__device__ __forceinline__ float bflo(unsigned w) { return __uint_as_float(w << 16); }
__device__ __forceinline__ float bfhi(unsigned w) { return __uint_as_float(w & 0xffff0000u); }
__device__ __forceinline__ float wave_sum(float v) {
#pragma unroll
    for (int o = 1; o < 64; o <<= 1) v += __shfl_xor(v, o);
    return v;
}
#define LBAR() do { asm volatile("s_waitcnt lgkmcnt(0)" ::: "memory"); __builtin_amdgcn_s_barrier(); asm volatile("" ::: "memory"); } while (0)
__device__ __forceinline__ void gstore8_nowait(void* p, v2u v) { asm volatile("global_store_dwordx2 %0, %1, off\n\ts_nop 1" :: "v"(p), "v"(v) : "memory"); }
__device__ __forceinline__ v4u gload16_asm(const void* p) { v4u r; asm volatile("global_load_dwordx4 %0, %1, off" : "=v"(r) : "v"(p)); return r; }
__device__ __forceinline__ float gload4_asm(const void* p) { float r; asm volatile("global_load_dword %0, %1, off" : "=v"(r) : "v"(p)); return r; }
__device__ __forceinline__ void gstore4_nowait(void* p, float v) { asm volatile("global_store_dword %0, %1, off\n\ts_nop 1" :: "v"(p), "v"(v)); }
__device__ __forceinline__ float frcp(float x) { return __builtin_amdgcn_rcpf(x); }
__device__ __forceinline__ float sigmoidf_(float x) { return frcp(1.0f + __expf(-x)); }
__device__ __forceinline__ float siluf_(float x) { return x * frcp(1.0f + __expf(-x)); }

#define XB_TMO      128
#define XB_XCNT(j)  (256  + 64 * (j))
#define XB_XSUB(j)  (1280 + 64 * (j))
#define XB_XGEN(j)  (2304 + 64 * (j))
#define XB_TOP      3328
#define XB_TOPGEN   3392
#define XCD_BAR_WORDS 3456
#define XB_SPIN_CAP (1u << 24)

__device__ __forceinline__ unsigned xb_ld(unsigned* p)              { return __hip_atomic_load(p, __ATOMIC_RELAXED, __HIP_MEMORY_SCOPE_AGENT); }
__device__ __forceinline__ unsigned xb_add(unsigned* p, unsigned v) { return __hip_atomic_fetch_add(p, v, __ATOMIC_RELAXED, __HIP_MEMORY_SCOPE_AGENT); }
__device__ __forceinline__ unsigned xb_xcc_id() { return (unsigned)__builtin_amdgcn_s_getreg((3 << 11) | 20) & 0xFu; }
#define XB_SPIN(cond, bar) do { unsigned _sp = 0; while (cond) { __builtin_amdgcn_s_sleep(1); \
    if ((++_sp & 255u) == 0u) { if (xb_ld(&(bar)[XB_TMO])) break; if (_sp > XB_SPIN_CAP) { atomicAdd(&(bar)[XB_TMO], 1u); break; } } } } while (0)

struct XcdBarrier {
    unsigned* bar; unsigned x;
    volatile LAS unsigned* st;
};

__device__ __forceinline__ XcdBarrier xcd_barrier_post(unsigned* bar, volatile LAS unsigned* st) {
    XcdBarrier b; b.bar = bar; b.x = xb_xcc_id(); b.st = st;
    if (threadIdx.x == 0) (void)xb_add(&bar[XB_XCNT(b.x)], 1u);
    return b;
}
__device__ __forceinline__ void xcd_barrier_complete(unsigned* bar, unsigned x, unsigned& nloc, unsigned& nx) {
    const unsigned G = gridDim.x * gridDim.y * gridDim.z;
    unsigned sum, cnt, mine, sp = 0u;
    for (;;) {
        sum = 0u; cnt = 0u; mine = 0u;
#pragma unroll
        for (unsigned j = 0; j < 16; ++j) { const unsigned c = xb_ld(&bar[XB_XCNT(j)]); sum += c; cnt += (c > 0u) ? 1u : 0u; mine = (j == x) ? c : mine; }
        if (sum == G) break;
        __builtin_amdgcn_s_sleep(1);
        if ((++sp & 255u) == 0u) { if (xb_ld(&bar[XB_TMO])) break; if (sp > XB_SPIN_CAP) { atomicAdd(&bar[XB_TMO], 1u); break; } }
    }
    nloc = mine > 0u ? mine : 1u; nx = cnt > 0u ? cnt : 1u;
}

__device__ __forceinline__ void xcd_barrier(const XcdBarrier& b) {
    asm volatile("s_waitcnt vmcnt(0)" ::: "memory");
    __syncthreads();
    if (threadIdx.x == 0) {
        unsigned* bar = b.bar;
        __builtin_amdgcn_s_waitcnt(0);
        unsigned nloc = b.st[0], nx = b.st[1];
        if (nloc == 0u) { xcd_barrier_complete(bar, b.x, nloc, nx); b.st[0] = nloc; b.st[1] = nx; }
        const unsigned old = xb_add(&bar[XB_XSUB(b.x)], 1u);
        const unsigned gen = old / nloc;
        if (old + 1u == (gen + 1u) * nloc) {
            __builtin_amdgcn_fence(__ATOMIC_RELEASE, "agent");
            asm volatile("s_waitcnt vmcnt(0)" ::: "memory");
            const unsigned og = xb_add(&bar[XB_TOP], 1u);
            const unsigned tg = og / nx;
            if (og + 1u == (tg + 1u) * nx) xb_add(&bar[XB_TOPGEN], 1u);
            else XB_SPIN(xb_ld(&bar[XB_TOPGEN]) == tg, bar);
            __builtin_amdgcn_fence(__ATOMIC_ACQUIRE, "agent");
            xb_add(&bar[XB_XGEN(b.x)], 1u);
            asm volatile("s_waitcnt vmcnt(0)" ::: "memory");
        } else {
            XB_SPIN(xb_ld(&bar[XB_XGEN(b.x)]) == gen, bar);
            __builtin_amdgcn_fence(__ATOMIC_ACQUIRE, "agent");
            asm volatile("s_waitcnt vmcnt(0)" ::: "memory");
        }
    }
    __syncthreads();
}
struct Frame {
    LAS unsigned char* lds;
    int tid, lane, wave, vcu, G;
    const float* x; float* out;
    const float *rel_bias, *lower_bounds, *pre0, *post0, *w_in0, *w_out0, *a_mu, *a_w0, *a_w2, *a_a0, *a_a2, *a_k_k, *a_k_a, *a_r_k, *a_ln_w, *a_ln_b, *sinks, *pre1, *post1, *w_in1, *w_out1, *c_norm_w;
    bf16 *W0T, *WO0T, *W1T, *WO1T, *HA, *HB, *PROJ, *Y;
    float *bias_tab, *lb_tab;
};

__device__ __forceinline__ void p0_transpose_item(const float* W, int K, int N, bf16* WT, LAS float* scr, int item, int lane) {
    const int nblk = N / 32, kb = item / nblk, nb = item % nblk, k0 = 64 * kb, n0 = 32 * nb;
#pragma unroll 8
    for (int i = 0; i < 32; ++i) { const int kk = 2 * i + (lane >> 5); scr[kk * 33 + (lane & 31)] = W[(size_t)(k0 + kk) * N + n0 + (lane & 31)]; }
    asm volatile("s_waitcnt lgkmcnt(0)" ::: "memory");
    const int c = lane & 7;
#pragma unroll
    for (int j = 0; j < 4; ++j) { const int n = (lane >> 3) + 8 * j; const LAS float* s = scr + (8 * c) * 33 + n;
        v4u o; o.x = pk2(s[0 * 33], s[1 * 33]); o.y = pk2(s[2 * 33], s[3 * 33]); o.z = pk2(s[4 * 33], s[5 * 33]); o.w = pk2(s[6 * 33], s[7 * 33]);
        *(v4u*)(WT + (size_t)(n0 + n) * K + k0 + 8 * c) = o; }
    asm volatile("s_waitcnt lgkmcnt(0)" ::: "memory");
}
__device__ __forceinline__ void rms_row_to_bf16(const float* xrow, const float* w, bf16* orow, int lane) {
    const f32x4* xr = (const f32x4*)xrow + lane; const f32x4* wr = (const f32x4*)w + lane;
    f32x4 v[4]; float s = 0.f;
#pragma unroll
    for (int j = 0; j < 4; ++j) { v[j] = xr[64 * j]; s += (v[j].x * v[j].x + v[j].y * v[j].y) + (v[j].z * v[j].z + v[j].w * v[j].w); }
    const float rs = 1.0f / sqrtf(wave_sum(s) * (1.f / D) + 1e-6f);
    v2u* o8 = (v2u*)orow + lane;
#pragma unroll
    for (int j = 0; j < 4; ++j) { const f32x4 g = wr[64 * j]; v2u o; o.x = pk2(v[j].x * rs * g.x, v[j].y * rs * g.y); o.y = pk2(v[j].z * rs * g.z, v[j].w * rs * g.w); o8[64 * j] = o; }
}
__device__ __forceinline__ int t5_bucket(int d) {
    if (d < 16) return d;
    int b = 16;
    b += (d >= 19) + (d >= 21) + (d >= 24) + (d >= 27) + (d >= 31) + (d >= 35) + (d >= 40) + (d >= 46) + (d >= 52) + (d >= 59) + (d >= 67) + (d >= 77) + (d >= 87) + (d >= 99) + (d >= 113);
    return b;
}
__device__ __forceinline__ void ph_prologue(Frame& F, unsigned char* ws) {
    LAS float* scr = (LAS float*)(F.lds + F.wave * 16384);
    const int gw = F.vcu * NWAVES + F.wave, NGW = F.G * NWAVES;
    constexpr int I_0 = (D / 64) * (N0 / 32), I_O = (D / 64) * (D / 32), I_1 = (D / 64) * (N1 / 32);
    constexpr int NITEMS = I_0 + I_O + I_1 + I_O;
    for (int it = gw; it < NITEMS; it += NGW) {
        int r = it;
        if (r < I_0) { p0_transpose_item(F.w_in0, D, N0, F.W0T, scr, r, F.lane); continue; } r -= I_0;
        if (r < I_O) { p0_transpose_item(F.w_out0, D, D, F.WO0T, scr, r, F.lane); continue; } r -= I_O;
        if (r < I_1) { p0_transpose_item(F.w_in1, D, N1, F.W1T, scr, r, F.lane); continue; } r -= I_1;
        p0_transpose_item(F.w_out1, D, D, F.WO1T, scr, r, F.lane);
    }
    for (int i = gw * 64 + F.lane; i < (N0P - N0) * D / 8; i += NGW * 64) ((v4u*)(F.W0T + (size_t)N0 * D))[i] = (v4u){0u, 0u, 0u, 0u};
    {
        const int lane = F.lane; f32x4 g[4];
#pragma unroll
        for (int j = 0; j < 4; ++j) g[j] = ((const f32x4*)F.pre0 + lane)[64 * j];
        f32x4 a0[4], a1[4], b0[4], b1[4];
#define PRO_LD(v, mm) do { if ((mm) < M) { const f32x4* xr_ = (const f32x4*)(F.x + (size_t)(mm) * D) + lane; _Pragma("unroll") for (int j = 0; j < 4; ++j) v[j] = xr_[64 * j]; } } while (0)
#define PRO_PR(v, mm) do { if ((mm) < M) { float s_ = 0.f; _Pragma("unroll") for (int j = 0; j < 4; ++j) s_ += (v[j].x * v[j].x + v[j].y * v[j].y) + (v[j].z * v[j].z + v[j].w * v[j].w); \
            const float rs_ = 1.0f / sqrtf(wave_sum(s_) * (1.f / D) + 1e-6f); v2u* o8_ = (v2u*)(F.HA + (size_t)(mm) * D) + lane; \
            _Pragma("unroll") for (int j = 0; j < 4; ++j) { v2u o_; o_.x = pk2(v[j].x * rs_ * g[j].x, v[j].y * rs_ * g[j].y); o_.y = pk2(v[j].z * rs_ * g[j].z, v[j].w * rs_ * g[j].w); o8_[64 * j] = o_; } } } while (0)
        int m = gw; PRO_LD(a0, m); PRO_LD(a1, m + NGW);
#pragma unroll 1
        for (; m < M; m += 4 * NGW) {
            PRO_LD(b0, m + 2 * NGW); PRO_LD(b1, m + 3 * NGW);
            PRO_PR(a0, m); PRO_PR(a1, m + NGW);
            PRO_LD(a0, m + 4 * NGW); PRO_LD(a1, m + 5 * NGW);
            PRO_PR(b0, m + 2 * NGW); PRO_PR(b1, m + 3 * NGW);
        }
#undef PRO_LD
#undef PRO_PR
    }
    const int gt = blockIdx.x * NTHR + F.tid;
    if (gt < 1024) { const int h = gt >> 7, d = gt & 127; F.bias_tab[gt] = F.rel_bias[t5_bucket(d) * 8 + h];
        F.lb_tab[gt] = 1.0f / (1.0f + expf(F.lower_bounds[gt] - F.lower_bounds[1024 + gt])); }
    if (gt < 16384) { const int cc = gt >> 5, l = gt & 31; ((bf16*)(ws + WS_TAB + 8192))[gt] = (bf16)f2bf(F.a_w2[l * 512 + cc]); ((bf16*)(ws + WS_TAB + 8192 + 32768))[gt] = (bf16)f2bf(F.a_a2[l * 512 + cc]); }
}

__device__ __forceinline__ void ph_attention(Frame& F) {
    LAS bf16* Ks = (LAS bf16*)(F.lds);
    LAS bf16* Vt = (LAS bf16*)(F.lds + 36864);
    LAS float* Bt = (LAS float*)(F.lds + 36864 + 33280);
    const int tid = F.tid, lane = F.lane, wave = F.wave, r32 = lane & 31, hh = lane >> 5;
    const bf16* P = F.PROJ;
    const int row = tid >> 1, half = tid & 1;
    v4u kv[4], vv[4];
#define AT_LOADKV(u_) do { const int hkv_ = (u_) & 1, nb_ = ((u_) >> 1) & 63, b_ = (u_) >> 7; const long grow_ = (long)b_ * T + nb_ * 128 - 128 + row; \
        if ((nb_ > 0) || (row >= 128)) { const v4u* kp_ = (const v4u*)(P + grow_ * P0LD + C_KB + hkv_ * 64 + half * 32); const v4u* vp_ = (const v4u*)(P + grow_ * P0LD + C_VB + hkv_ * 64 + half * 32); \
            _Pragma("unroll") for (int i_ = 0; i_ < 4; ++i_) { kv[i_] = kp_[i_]; vv[i_] = vp_[i_]; } } \
        else { _Pragma("unroll") for (int i_ = 0; i_ < 4; ++i_) { kv[i_] = (v4u){0u, 0u, 0u, 0u}; vv[i_] = (v4u){0u, 0u, 0u, 0u}; } } } while (0)
    int u = blockIdx.x;
    if (u < 1024) AT_LOADKV(u);
    for (; u < 1024; u += F.G) {
        const int hkv = u & 1, nb = (u >> 1) & 63, b = u >> 7;
        bf16x8 qf0[4], qf1[4];
#define AT_QLOAD(ii_, qf_) do { const int item_ = wave * 2 + (ii_), g_ = item_ >> 2, qt_ = item_ & 3, hq_ = hkv * 4 + g_; \
            const bf16* qp_ = P + ((long)b * T + nb * 128 + qt_ * 32 + r32) * P0LD + C_QB + hq_ * 64 + hh * 8; \
            _Pragma("unroll") for (int s_ = 0; s_ < 4; ++s_) qf_[s_] = *(const bf16x8*)(qp_ + 16 * s_); } while (0)
        AT_QLOAD(0, qf0); AT_QLOAD(1, qf1);
        {
#pragma unroll
            for (int i = 0; i < 4; ++i) *(LAS v4u*)(Ks + row * 72 + half * 32 + 8 * i) = kv[i];
#pragma unroll
            for (int i = 0; i < 4; ++i)
#pragma unroll
                for (int e = 0; e < 4; ++e) { const unsigned w = vv[i][e]; const int d = half * 32 + 8 * i + 2 * e;
                    Vt[d * 260 + row] = (bf16)(w & 0xffffu); Vt[(d + 1) * 260 + row] = (bf16)(w >> 16); }
            for (int x = tid; x < 768; x += NTHR) { const int g = x / 192, e = x - g * 192 - 32; Bt[x] = (e >= 0 && e < 128) ? F.bias_tab[(hkv * 4 + g) * 128 + e] * 1.44269504f : 0.f; }
        }
        LBAR();
        if (u + F.G < 1024) AT_LOADKV(u + F.G);
#define AT_ITEM(ii, qf) do { \
            const int item = wave * 2 + ii, g = item >> 2, qt = item & 3, hq = hkv * 4 + g; \
            const long qrow = (long)b * T + nb * 128 + qt * 32 + r32; \
            v2u gwv[2][4]; \
            _Pragma("unroll") \
            for (int dt = 0; dt < 2; ++dt) \
            _Pragma("unroll") \
                for (int gq = 0; gq < 4; ++gq) gwv[dt][gq] = *(const v2u*)(P + qrow * P0LD + C_GB + hq * 64 + dt * 32 + 8 * gq + 4 * hh); \
            f32x16 sc[5]; \
            _Pragma("unroll") \
            for (int tt = 0; tt < 5; ++tt) { f32x16 acc = {0.f, 0.f, 0.f, 0.f, 0.f, 0.f, 0.f, 0.f, 0.f, 0.f, 0.f, 0.f, 0.f, 0.f, 0.f, 0.f}; \
            _Pragma("unroll") \
                for (int s = 0; s < 4; ++s) { const bf16x8 kf = *(const LAS bf16x8*)(Ks + ((qt + tt) * 32 + r32) * 72 + 16 * s + 8 * hh); \
                    acc = __builtin_amdgcn_mfma_f32_32x32x16_bf16(kf, qf[s], acc, 0, 0, 0); } \
                sc[tt] = acc; } \
              \
              \
            const int dl = r32 - 4 * hh; const LAS float* bp = Bt + g * 192 + (dl + 5); const float sink2 = F.sinks[hq] * 1.44269504f; \
            float mx = sink2; \
            _Pragma("unroll") \
            for (int tt = 0; tt < 5; ++tt) { \
                if ((nb == 0) && (qt + tt < 4)) { \
            _Pragma("unroll") \
                    for (int i = 0; i < 16; ++i) sc[tt][i] = -1e30f; } \
                else { \
            _Pragma("unroll") \
                    for (int i = 0; i < 16; ++i) { const int c = (i & 3) + 8 * (i >> 2); \
                        float s = sc[tt][i] * (0.125f * 1.44269504f) + bp[155 - 32 * tt - c]; \
                        if (tt == 0) s = (c > dl) ? s : -1e30f; \
                        if (tt == 4) s = (c <= dl) ? s : -1e30f; \
                        sc[tt][i] = s; mx = fmaxf(mx, s); } } } \
            mx = fmaxf(mx, __shfl_xor(mx, 32)); \
            float sum = 0.f; \
            _Pragma("unroll") \
            for (int tt = 0; tt < 5; ++tt) \
            _Pragma("unroll") \
                for (int i = 0; i < 16; ++i) { const float p = __builtin_amdgcn_exp2f(sc[tt][i] - mx); sc[tt][i] = p; sum += p; } \
            sum += __shfl_xor(sum, 32); \
            const float inv = frcp(sum + __builtin_amdgcn_exp2f(sink2 - mx)); \
            f32x16 o[2]; \
            _Pragma("unroll") \
            for (int dt = 0; dt < 2; ++dt) o[dt] = (f32x16){0.f, 0.f, 0.f, 0.f, 0.f, 0.f, 0.f, 0.f, 0.f, 0.f, 0.f, 0.f, 0.f, 0.f, 0.f, 0.f}; \
            _Pragma("unroll") \
            for (int tt = 0; tt < 5; ++tt) \
            _Pragma("unroll") \
                for (int s = 0; s < 2; ++s) { \
                    v4u pw; pw.x = pk2(sc[tt][8 * s + 0], sc[tt][8 * s + 1]); pw.y = pk2(sc[tt][8 * s + 2], sc[tt][8 * s + 3]); pw.z = pk2(sc[tt][8 * s + 4], sc[tt][8 * s + 5]); pw.w = pk2(sc[tt][8 * s + 6], sc[tt][8 * s + 7]); \
                    const bf16x8 pf = __builtin_bit_cast(bf16x8, pw); \
                    const int kb = (qt + tt) * 32 + 16 * s + 4 * hh; \
            _Pragma("unroll") \
                    for (int dt = 0; dt < 2; ++dt) { const LAS bf16* vp = Vt + (dt * 32 + r32) * 260 + kb; \
                        const v2u lo = *(const LAS v2u*)(vp), hi = *(const LAS v2u*)(vp + 8); \
                        v4u vw; vw.x = lo.x; vw.y = lo.y; vw.z = hi.x; vw.w = hi.y; \
                        o[dt] = __builtin_amdgcn_mfma_f32_32x32x16_bf16(__builtin_bit_cast(bf16x8, vw), pf, o[dt], 0, 0, 0); } } \
            _Pragma("unroll") \
            for (int dt = 0; dt < 2; ++dt) \
            _Pragma("unroll") \
                for (int gq = 0; gq < 4; ++gq) { const int d0 = dt * 32 + 8 * gq + 4 * hh; const v2u gv = gwv[dt][gq]; \
                    const float g0 = bflo(gv.x), g1 = bfhi(gv.x), g2 = bflo(gv.y), g3 = bfhi(gv.y); \
                    v2u ow; ow.x = pk2(o[dt][4 * gq + 0] * inv * siluf_(g0), o[dt][4 * gq + 1] * inv * siluf_(g1)); ow.y = pk2(o[dt][4 * gq + 2] * inv * siluf_(g2), o[dt][4 * gq + 3] * inv * siluf_(g3)); \
                    *(v2u*)(F.HB + qrow * D + 512 + hq * 64 + d0) = ow; } \
        } while (0)
#pragma unroll 1
        for (int ii = 0; ii < 2; ++ii) { bf16x8 qf[4];
#pragma unroll
            for (int s = 0; s < 4; ++s) qf[s] = ii ? qf1[s] : qf0[s];
            AT_ITEM(ii, qf); }
        LBAR();
    }
#undef AT_LOADKV
#undef AT_QLOAD
#undef AT_ITEM
}
constexpr int RW_R = 0, RW_W = 4096, RW_KM = 8192, RW_V = 12288, RW_KN = 16384, RW_KA = 20480, RW_G = 24576, RW_TW = 28672, RW_TA = 30720, RW_CT = 32768, RW_RED = 32832;
__device__ __forceinline__ void rwkv_prep(Frame& F, int b, int c, int h) {
    LAS float* L = (LAS float*)F.lds;
    const int tid = F.tid; const bf16* P = F.PROJ; const long rowbase = (long)b * T + c * 64;
#pragma unroll 1
    for (int i = 0; i < 8; ++i) { const int idx = tid + 512 * i, arr = idx >> 11, j = (idx >> 5) & 63, l = idx & 31, col = C_WL + 32 * arr + l;
        const long t = rowbase + j; const float cur = bf2f(P[t * P0LD + col]); const float prev = (c * 64 + j > 0) ? bf2f(P[(t - 1) * P0LD + col]) : 0.f;
        const float sh = cur + F.a_mu[col] * (prev - cur);
        if (arr == 0) L[RW_TW + j * 32 + l] = tanhf(sh); else L[RW_TA + j * 32 + l] = sh; }
    __syncthreads();
    const int ch = tid & 63, jg = tid >> 6, cg = h * 64 + ch;
    const float w0 = F.a_w0[cg], a0 = F.a_a0[cg], kkc = F.a_k_k[cg], kac = F.a_k_a[cg], rk = F.a_r_k[cg];
    const float mu_r = F.a_mu[C_R + cg], mu_k = F.a_mu[C_K + cg], mu_v = F.a_mu[C_V + cg], mu_g = F.a_mu[C_GA + cg];
    const int j0 = jg * 8;
    float pr = 0.f, pk = 0.f, pv = 0.f, pg = 0.f;
    if (c * 64 + j0 > 0) { const bf16* q = P + (rowbase + j0 - 1) * P0LD; pr = bf2f(q[C_R + cg]); pk = bf2f(q[C_K + cg]); pv = bf2f(q[C_V + cg]); pg = bf2f(q[C_GA + cg]); }
#pragma unroll 1
    for (int jj = 0; jj < 8; ++jj) { const int j = j0 + jj; const bf16* q = P + (rowbase + j) * P0LD;
        const float cr = bf2f(q[C_R + cg]), ck = bf2f(q[C_K + cg]), cv = bf2f(q[C_V + cg]), cgt = bf2f(q[C_GA + cg]);
        const float r = cr + mu_r * (pr - cr), k = ck + mu_k * (pk - ck), v = cv + mu_v * (pv - cv), g = cgt + mu_g * (pg - cgt);
        pr = cr; pk = ck; pv = cv; pg = cgt;
        float wpre = w0, apre = a0;
#pragma unroll 4
        for (int l = 0; l < 32; ++l) { wpre += L[RW_TW + j * 32 + l] * F.a_w2[l * 512 + cg]; apre += L[RW_TA + j * 32 + l] * F.a_a2[l * 512 + cg]; }
        const float z = -wpre; const float sp = fmaxf(z, 0.f) + log1pf(expf(-fabsf(z)));
        const float w = -sp - 0.5f; const float decay = expf(-expf(w));
        const float alpha = 1.0f / (1.0f + expf(-apre));
        const float kk = k * kkc; const float ss = wave_sum(kk * kk); const float kkn = kk / fmaxf(sqrtf(ss), 1e-12f);
        const float km = k * (1.0f + (alpha - 1.0f) * kac);
        const float ct = wave_sum(r * km * rk);
        L[RW_R + j * 64 + ch] = r; L[RW_W + j * 64 + ch] = decay; L[RW_KM + j * 64 + ch] = km; L[RW_V + j * 64 + ch] = v;
        L[RW_KN + j * 64 + ch] = kkn; L[RW_KA + j * 64 + ch] = kkn * alpha; L[RW_G + j * 64 + ch] = g;
        if (ch == 0) L[RW_CT + j] = ct; }
    __syncthreads();
}
__device__ __forceinline__ void ph_rwkv_naive(Frame& F) {
    if (blockIdx.x >= 64) return;
    LAS float* L = (LAS float*)F.lds;
    const int bh = blockIdx.x, b = bh >> 3, h = bh & 7, v = F.lane, kq = F.wave;
    float S[8];
#pragma unroll
    for (int i = 0; i < 8; ++i) S[i] = 0.f;
    const float lnw = F.a_ln_w[h * 64 + v], lnb = F.a_ln_b[h * 64 + v];
#pragma unroll 1
    for (int c = 0; c < T / 64; ++c) {
        rwkv_prep(F, b, c, h);
#pragma unroll 1
        for (int j = 0; j < 64; ++j) {
            const int par = j & 1;
            float p1 = 0.f;
#pragma unroll
            for (int i = 0; i < 8; ++i) p1 += S[i] * L[RW_KN + j * 64 + 8 * kq + i];
            L[RW_RED + (par * 2 + 0) * 512 + kq * 64 + v] = p1;
            __syncthreads();
            float sa = 0.f;
#pragma unroll
            for (int q = 0; q < 8; ++q) sa += L[RW_RED + (par * 2 + 0) * 512 + q * 64 + v];
            sa = -sa;
            const float vv = L[RW_V + j * 64 + v];
            float p2 = 0.f;
#pragma unroll
            for (int i = 0; i < 8; ++i) { const int k = 8 * kq + i; S[i] = S[i] * L[RW_W + j * 64 + k] + sa * L[RW_KA + j * 64 + k] + vv * L[RW_KM + j * 64 + k]; p2 += S[i] * L[RW_R + j * 64 + k]; }
            L[RW_RED + (par * 2 + 1) * 512 + kq * 64 + v] = p2;
            __syncthreads();
            if (kq == 0) {
                float y = 0.f;
#pragma unroll
                for (int q = 0; q < 8; ++q) y += L[RW_RED + (par * 2 + 1) * 512 + q * 64 + v];
                const float mean = wave_sum(y) * (1.f / 64.f); const float dd = y - mean; const float var = wave_sum(dd * dd) * (1.f / 64.f);
                float yn = dd * (1.0f / sqrtf(var + 64e-5f)) * lnw + lnb;
                yn += L[RW_CT + j] * vv;
                const float g = L[RW_G + j * 64 + v];
                F.HB[((size_t)b * T + c * 64 + j) * D + h * 64 + v] = (bf16)f2bf(yn * siluf_(g));
            }
        }
        __syncthreads();
    }
}

__device__ __forceinline__ void ph_hgrn_naive(Frame& F) {
    if (blockIdx.x >= 64) return;
    LAS float* L = (LAS float*)F.lds;
    const int bh = blockIdx.x, b = bh >> 3, h = bh & 7, tid = F.tid, v = tid & 127, kq = tid >> 7;
    const bf16* P = F.PROJ;
    float S[32];
#pragma unroll
    for (int i = 0; i < 32; ++i) S[i] = 0.f;
    const float lb = F.lb_tab[h * 128 + v];
    const float cw = F.c_norm_w[v];
#pragma unroll 1
    for (int tb = 0; tb < T / 32; ++tb) {
        const long rowbase = (long)b * T + tb * 32;
#pragma unroll 1
        for (int jj = 0; jj < 8; ++jj) { const int j = kq * 8 + jj; const bf16* q = P + (rowbase + j) * P1LD + h * 128 + v;
            const float qv = bf2f(q[0]), fv = bf2f(q[1024]), iv = bf2f(q[2048]), gv = bf2f(q[3072]);
            const float fg = lb + (1.0f - lb) * sigmoidf_(fv);
            L[j * 128 + v] = siluf_(qv); L[4096 + j * 128 + v] = fg; L[8192 + j * 128 + v] = 1.0f - fg; L[12288 + j * 128 + v] = iv; L[16384 + j * 128 + v] = gv; }
        __syncthreads();
#pragma unroll 1
        for (int j = 0; j < 32; ++j) {
            const float vv = L[12288 + j * 128 + v]; float p = 0.f;
#pragma unroll
            for (int i = 0; i < 32; ++i) { const int k = kq * 32 + i; S[i] = L[4096 + j * 128 + k] * S[i] + L[8192 + j * 128 + k] * vv; p += S[i] * L[j * 128 + k]; }
            L[24576 + (j & 1) * 512 + kq * 128 + v] = p;
            __syncthreads();
            if (kq == 0) L[20480 + j * 128 + v] = (L[24576 + (j & 1) * 512 + v] + L[24576 + (j & 1) * 512 + 128 + v]) + (L[24576 + (j & 1) * 512 + 256 + v] + L[24576 + (j & 1) * 512 + 384 + v]);
        }
        __syncthreads();
#pragma unroll 1
        for (int q = 0; q < 4; ++q) { const int j = F.wave + 8 * q; const int l = F.lane;
            const float o0 = L[20480 + j * 128 + l], o1 = L[20480 + j * 128 + 64 + l];
            const float rs = 1.0f / sqrtf(wave_sum(o0 * o0 + o1 * o1) * (1.f / 128.f) + 1e-6f);
            const float g0 = L[16384 + j * 128 + l], g1 = L[16384 + j * 128 + 64 + l];
            bf16* o = F.HB + (size_t)(rowbase + j) * D + h * 128;
            o[l] = (bf16)f2bf(o0 * rs * F.c_norm_w[l] * siluf_(g0)); o[64 + l] = (bf16)f2bf(o1 * rs * F.c_norm_w[64 + l] * siluf_(g1)); }
        __syncthreads();
    }
    (void)cw;
}

__device__ __forceinline__ void ph_resnorm0(Frame& F, const float* xin, bf16* YX, const float* wpost, const float* wpre, bf16* hn) {
    const int gw = F.vcu * NWAVES + F.wave, NGW = F.G * NWAVES, lane = F.lane;
    for (int m = gw; m < M; m += NGW) {
        v4u* yp = (v4u*)(YX + (size_t)m * D); const f32x4* xp = (const f32x4*)(xin + (size_t)m * D);
        float yv[16]; float s = 0.f;
#pragma unroll
        for (int j = 0; j < 2; ++j) { const v4u w = yp[lane + 64 * j];
#pragma unroll
            for (int e = 0; e < 4; ++e) { yv[8 * j + 2 * e] = bflo(w[e]); yv[8 * j + 2 * e + 1] = bfhi(w[e]); } }
#pragma unroll
        for (int e = 0; e < 16; ++e) s += yv[e] * yv[e];
        const float rs = __builtin_amdgcn_rsqf(wave_sum(s) * (1.f / D) + 1e-6f);
        float x1[16]; float s1 = 0.f;
#pragma unroll
        for (int j = 0; j < 2; ++j)
#pragma unroll
            for (int q = 0; q < 2; ++q) { const int c4 = 2 * (lane + 64 * j) + q; const f32x4 xv = xp[c4]; const f32x4 wv = ((const f32x4*)wpost)[c4];
#pragma unroll
                for (int e = 0; e < 4; ++e) { const float o = xv[e] + yv[8 * j + 4 * q + e] * rs * wv[e]; x1[8 * j + 4 * q + e] = o; s1 += o * o; } }
        const float rs1 = __builtin_amdgcn_rsqf(wave_sum(s1) * (1.f / D) + 1e-6f);
#pragma unroll
        for (int j = 0; j < 2; ++j) { const int c8 = lane + 64 * j; const f32x4 w0 = ((const f32x4*)wpre)[2 * c8], w1 = ((const f32x4*)wpre)[2 * c8 + 1];
            v4u xo; xo.x = pk2(x1[8 * j + 0], x1[8 * j + 1]); xo.y = pk2(x1[8 * j + 2], x1[8 * j + 3]); xo.z = pk2(x1[8 * j + 4], x1[8 * j + 5]); xo.w = pk2(x1[8 * j + 6], x1[8 * j + 7]);
            yp[c8] = xo;
            v4u o; o.x = pk2(x1[8 * j + 0] * rs1 * w0[0], x1[8 * j + 1] * rs1 * w0[1]); o.y = pk2(x1[8 * j + 2] * rs1 * w0[2], x1[8 * j + 3] * rs1 * w0[3]);
            o.z = pk2(x1[8 * j + 4] * rs1 * w1[0], x1[8 * j + 5] * rs1 * w1[1]); o.w = pk2(x1[8 * j + 6] * rs1 * w1[2], x1[8 * j + 7] * rs1 * w1[3]);
            ((v4u*)(hn + (size_t)m * D))[c8] = o; }
    }
}
__device__ __forceinline__ void ph_resnorm1(Frame& F, const bf16* X1, const bf16* Y, const float* wpost, float* out) {
    const int gw = F.vcu * NWAVES + F.wave, NGW = F.G * NWAVES, lane = F.lane;
    for (int m = gw; m < M; m += NGW) {
        const v4u* yp = (const v4u*)(Y + (size_t)m * D); const v4u* xp = (const v4u*)(X1 + (size_t)m * D); f32x4* op = (f32x4*)(out + (size_t)m * D);
        float yv[16], xv[16]; float s = 0.f;
#pragma unroll
        for (int j = 0; j < 2; ++j) { const v4u w = yp[lane + 64 * j], xw = xp[lane + 64 * j];
#pragma unroll
            for (int e = 0; e < 4; ++e) { yv[8 * j + 2 * e] = bflo(w[e]); yv[8 * j + 2 * e + 1] = bfhi(w[e]); xv[8 * j + 2 * e] = bflo(xw[e]); xv[8 * j + 2 * e + 1] = bfhi(xw[e]); } }
#pragma unroll
        for (int e = 0; e < 16; ++e) s += yv[e] * yv[e];
        const float rs = __builtin_amdgcn_rsqf(wave_sum(s) * (1.f / D) + 1e-6f);
#pragma unroll
        for (int j = 0; j < 2; ++j)
#pragma unroll
            for (int q = 0; q < 2; ++q) { const int c4 = 2 * (lane + 64 * j) + q; const f32x4 wv = ((const f32x4*)wpost)[c4]; f32x4 o;
#pragma unroll
                for (int e = 0; e < 4; ++e) o[e] = xv[8 * j + 4 * q + e] + yv[8 * j + 4 * q + e] * rs * wv[e];
                op[c4] = o; }
    }
}
typedef float f32x4v __attribute__((ext_vector_type(4)));
__device__ __forceinline__ f32x4v mm_tile(const LAS bf16* X, const LAS bf16* Y, int n0, int m0, int lane, f32x4v acc) {
    const int r = lane & 15, q = lane >> 4;
#pragma unroll
    for (int s = 0; s < 2; ++s) { const bf16x8 a = *(const LAS bf16x8*)(Y + (m0 + r) * 72 + 32 * s + 8 * q); const bf16x8 b = *(const LAS bf16x8*)(X + (n0 + r) * 72 + 32 * s + 8 * q);
        acc = __builtin_amdgcn_mfma_f32_16x16x32_bf16(a, b, acc, 0, 0, 0); }
    return acc;
}
__device__ __forceinline__ void st_tile(LAS bf16* dst, int n0, int m0, int lane, f32x4v a) { v2u w; w.x = pk2(a[0], a[1]); w.y = pk2(a[2], a[3]); *(LAS v2u*)(dst + (n0 + (lane & 15)) * 72 + m0 + 4 * (lane >> 4)) = w; }
__device__ __forceinline__ void st_tile_g(bf16* dst, int n0, int m0, int lane, f32x4v a) { v2u w; w.x = pk2(a[0], a[1]); w.y = pk2(a[2], a[3]); *(v2u*)(dst + (n0 + (lane & 15)) * 64 + m0 + 4 * (lane >> 4)) = w; }
__device__ __forceinline__ f32x4v blk16(const LAS float* X, const LAS float* Y, int lane, f32x4v acc) {
    const int r = lane & 15, q = lane >> 4;
#pragma unroll
    for (int s = 0; s < 4; ++s) acc = __builtin_amdgcn_mfma_f32_16x16x4f32(X[r * 68 + 4 * s + q], Y[(4 * s + q) * 68 + r], acc, 0, 0, 0);
    return acc;
}
constexpr int RA_AT = 0, RA_BH = 9216, RA_KH = 18432, RA_RT = 27648, RA_ATT = 36864, RA_VT = 46080, RA_BTT = 55296, RA_KTT = 64512, RA_AAK = 73728, RA_ARB = 82944, RA_ARK = 92160,
              RA_FM = 101376, RA_TF = 118784, RA_MISC = 136192;
constexpr int RA_WPRE = 73728, RA_APRE = 90112, RA_TWB = 106496, RA_TAB = 111616, RA_W2T = 116736, RA_A2T = 121856;
constexpr size_t WS_MPT = 32 * MiB, WS_NM = 96 * MiB, WS_QE = 800 * MiB, WS_Y0 = 864 * MiB, WS_S0 = 928 * MiB, WS_GCE = 992 * MiB, WS_CT = 994 * MiB, WS_W2T = WS_TAB + 8192, WS_A2T = WS_TAB + 8192 + 32768;

__device__ __forceinline__ float dpp_add(float v, const int ctrl_sel) {
    int r;
    if (ctrl_sel == 0) r = __builtin_amdgcn_update_dpp(0, __builtin_bit_cast(int, v), 0xB1, 0xf, 0xf, true);
    else if (ctrl_sel == 1) r = __builtin_amdgcn_update_dpp(0, __builtin_bit_cast(int, v), 0x4E, 0xf, 0xf, true);
    else if (ctrl_sel == 2) r = __builtin_amdgcn_update_dpp(0, __builtin_bit_cast(int, v), 0x141, 0xf, 0xf, true);
    else r = __builtin_amdgcn_update_dpp(0, __builtin_bit_cast(int, v), 0x140, 0xf, 0xf, true);
    return v + __builtin_bit_cast(float, r);
}
__device__ __forceinline__ float wave_sum_dpp(float v) {
    v = dpp_add(v, 0); v = dpp_add(v, 1); v = dpp_add(v, 2); v = dpp_add(v, 3);
    const int iv = __builtin_bit_cast(int, v);
    const float r0 = __builtin_bit_cast(float, __builtin_amdgcn_readlane(iv, 0)), r1 = __builtin_bit_cast(float, __builtin_amdgcn_readlane(iv, 16));
    const float r2 = __builtin_bit_cast(float, __builtin_amdgcn_readlane(iv, 32)), r3 = __builtin_bit_cast(float, __builtin_amdgcn_readlane(iv, 48));
    return (r0 + r1) + (r2 + r3);
}
__device__ __forceinline__ float swap32_sum(float a, float b) { asm volatile("s_nop 1\n\tv_permlane32_swap_b32 %0, %1" : "+v"(a), "+v"(b)); return a + b; }
__device__ __forceinline__ float swap16_sum(float a, float b) { asm volatile("s_nop 1\n\tv_permlane16_swap_b32 %0, %1" : "+v"(a), "+v"(b)); return a + b; }
constexpr int RA_RKV = 0;
struct RaPf { v4u rkv[4]; v4u lc, lp; v2u tw, ta; };
__device__ __forceinline__ void rwkv_pf_load(RaPf& pf, Frame& F, int b, int c, int h, unsigned char* ws) {
    const int tid = F.tid; const bf16* P = F.PROJ; const long rowbase = (long)b * T + c * 64;
#pragma unroll
    for (int k = 0; k < 4; ++k) { const int pc = tid + 512 * k; pf.rkv[k] = (v4u){0u, 0u, 0u, 0u};
        if (pc < 1560) { const int row = pc / 24, rem = pc - row * 24, arr = rem >> 3, p8 = rem & 7;
            if (row > 0 || c > 0) pf.rkv[k] = *(const v4u*)(P + (rowbase - 1 + row) * P0LD + arr * 512 + h * 64 + 8 * p8); } }
    { const int j = tid >> 3, p = tid & 7; pf.lc = *(const v4u*)(P + (rowbase + j) * P0LD + C_WL + 8 * p); pf.lp = (v4u){0u, 0u, 0u, 0u};
      if (c * 64 + j > 0) pf.lp = *(const v4u*)(P + (rowbase + j - 1) * P0LD + C_WL + 8 * p);
      const int l4 = 4 * (tid & 7);
      pf.tw = *(const v2u*)((const bf16*)(ws + WS_W2T) + (h * 64 + j) * 32 + l4); pf.ta = *(const v2u*)((const bf16*)(ws + WS_A2T) + (h * 64 + j) * 32 + l4); }
}
template <bool HAS_NEXT> __device__ __forceinline__ void rwkv_passA_item(Frame& F, int b, int c, int h, unsigned char* ws, RaPf& pf, int nb_, int nc_, int nh_) {
    LAS unsigned char* L = F.lds; const int tid = F.tid, lane = F.lane, wave = F.wave;
    const long rowbase = (long)b * T + c * 64; const int chd = (b * 128 + c) * 8 + h;
    LAS bf16* At = (LAS bf16*)(L + RA_AT); LAS bf16* Bh = (LAS bf16*)(L + RA_BH); LAS bf16* Kh = (LAS bf16*)(L + RA_KH); LAS bf16* Rt = (LAS bf16*)(L + RA_RT);
    LAS bf16* AtT = (LAS bf16*)(L + RA_ATT); LAS bf16* VT = (LAS bf16*)(L + RA_VT); LAS bf16* BtT = (LAS bf16*)(L + RA_BTT); LAS bf16* KtT = (LAS bf16*)(L + RA_KTT);
    LAS bf16* Aak = (LAS bf16*)(L + RA_AAK); LAS bf16* Arb = (LAS bf16*)(L + RA_ARB); LAS bf16* Ark = (LAS bf16*)(L + RA_ARK);
    LAS float* Fm = (LAS float*)(L + RA_FM); LAS float* Tf = (LAS float*)(L + RA_TF); LAS float* Misc = (LAS float*)(L + RA_MISC);
    LAS bf16* Tm = At; LAS bf16* XT = Bh; LAS bf16* WT = Kh; LAS bf16* U0T = Aak;
    LAS float* Wpre = (LAS float*)(L + RA_WPRE); LAS float* Apre = (LAS float*)(L + RA_APRE);
    LAS bf16* TWb = (LAS bf16*)(L + RA_TWB); LAS bf16* TAb = (LAS bf16*)(L + RA_TAB); LAS bf16* W2s = (LAS bf16*)(L + RA_W2T); LAS bf16* A2s = (LAS bf16*)(L + RA_A2T);
    LAS bf16* RKV = (LAS bf16*)(L + RA_RKV);
    const f32x4v z4 = {0.f, 0.f, 0.f, 0.f};
#pragma unroll
    for (int k = 0; k < 4; ++k) { const int pc = tid + 512 * k; if (pc < 1560) { const int row = pc / 24, rem = pc - row * 24; *(LAS v4u*)(RKV + (row * 3 + (rem >> 3)) * 72 + 8 * (rem & 7)) = pf.rkv[k]; } }
    { const int j = tid >> 3, p = tid & 7, arr = p >> 2, l8 = 8 * (p & 3), l4 = 4 * p;
      *(LAS v2u*)(W2s + j * 40 + l4) = pf.tw; *(LAS v2u*)(A2s + j * 40 + l4) = pf.ta;
      const f32x4v m0 = *(const f32x4v*)(F.a_mu + C_WL + 8 * p), m1 = *(const f32x4v*)(F.a_mu + C_WL + 8 * p + 4);
      const float mu[8] = {m0[0], m0[1], m0[2], m0[3], m1[0], m1[1], m1[2], m1[3]}; float sh[8];
#pragma unroll
      for (int e = 0; e < 4; ++e) { const float c0 = bflo(pf.lc[e]), c1 = bfhi(pf.lc[e]), p0 = bflo(pf.lp[e]), p1 = bfhi(pf.lp[e]);
          sh[2 * e] = c0 + mu[2 * e] * (p0 - c0); sh[2 * e + 1] = c1 + mu[2 * e + 1] * (p1 - c1); }
      if (arr == 0) {
#pragma unroll
          for (int e = 0; e < 8; ++e) sh[e] = 1.0f - 2.0f * frcp(1.0f + __expf(2.0f * sh[e])); }
      v4u o; o.x = pk2(sh[0], sh[1]); o.y = pk2(sh[2], sh[3]); o.z = pk2(sh[4], sh[5]); o.w = pk2(sh[6], sh[7]);
      *(LAS v4u*)((arr ? TAb : TWb) + j * 40 + l8) = o; }
    LBAR();
    if (HAS_NEXT) rwkv_pf_load(pf, F, nb_, nc_, nh_, ws);
    { const int r = lane & 15, q = lane >> 4;
#pragma unroll
      for (int i = 0; i < 4; ++i) { const int tt = wave * 4 + i, arr = tt >> 4, n0 = ((tt >> 2) & 3) * 16, m0 = (tt & 3) * 16;
          const LAS bf16* X = arr ? TAb : TWb; const LAS bf16* Y = arr ? A2s : W2s;
          const bf16x8 a = *(const LAS bf16x8*)(Y + (m0 + r) * 40 + 8 * q); const bf16x8 bb = *(const LAS bf16x8*)(X + (n0 + r) * 40 + 8 * q);
          const f32x4v d = __builtin_amdgcn_mfma_f32_16x16x32_bf16(a, bb, z4, 0, 0, 0);
          *(LAS f32x4v*)((arr ? Apre : Wpre) + (n0 + r) * 64 + m0 + 4 * q) = d; } }
    LBAR();
    const int ch = lane, cg = h * 64 + ch, j0 = wave * 8;
    float rr[8], kn[8], ka[8], km[8], vv[8], lw[8], gg[8];
    { const float w0 = F.a_w0[cg], a0 = F.a_a0[cg], kkc = F.a_k_k[cg], kac = F.a_k_a[cg], rk = F.a_r_k[cg];
      const float mu_r = F.a_mu[C_R + cg], mu_k = F.a_mu[C_K + cg], mu_v = F.a_mu[C_V + cg];
      float pr = bf2f(RKV[(j0 * 3 + 0) * 72 + ch]), pk = bf2f(RKV[(j0 * 3 + 1) * 72 + ch]), pv = bf2f(RKV[(j0 * 3 + 2) * 72 + ch]);
      float run = 0.f; float xr[16];
#pragma unroll
      for (int jj = 0; jj < 8; ++jj) { const int j = j0 + jj;
          const float cr = bf2f(RKV[((j + 1) * 3 + 0) * 72 + ch]), ck = bf2f(RKV[((j + 1) * 3 + 1) * 72 + ch]), cv = bf2f(RKV[((j + 1) * 3 + 2) * 72 + ch]);
          const float r = cr + mu_r * (pr - cr), k = ck + mu_k * (pk - ck), v = cv + mu_v * (pv - cv); pr = cr; pk = ck; pv = cv;
          const float wpre = w0 + Wpre[j * 64 + ch], apre = a0 + Apre[j * 64 + ch];
          const float lwv = -0.6065306597126334f * frcp(1.0f + __expf(-wpre));
          const float alpha = frcp(1.0f + __expf(-apre));
          const float kk = k * kkc; const float kmv = k * (1.0f + (alpha - 1.0f) * kac);
          xr[jj] = kk * kk; xr[8 + jj] = r * kmv * rk; kn[jj] = kk; ka[jj] = alpha;
          run += lwv;
          rr[jj] = r; km[jj] = kmv; vv[jj] = v; lw[jj] = lwv; gg[jj] = run; }
      float y8[8], z4[4], y2[2], wsum;
#pragma unroll
      for (int i = 0; i < 8; ++i) y8[i] = swap32_sum(xr[i], xr[8 + i]);
#pragma unroll
      for (int i = 0; i < 4; ++i) z4[i] = swap16_sum(y8[i], y8[4 + i]);
      { const bool b3 = (lane & 8) != 0, b2 = (lane & 4) != 0;
#pragma unroll
        for (int i = 0; i < 2; ++i) { const float keep = b3 ? z4[2 + i] : z4[i], send = b3 ? z4[i] : z4[2 + i];
            y2[i] = keep + __builtin_bit_cast(float, __builtin_amdgcn_update_dpp(0, __builtin_bit_cast(int, send), 0x128, 0xf, 0xf, true)); }
        const float keep = b2 ? y2[1] : y2[0], send = b2 ? y2[0] : y2[1];
        wsum = keep + __shfl_xor(send, 4);
        wsum = dpp_add(wsum, 1); wsum = dpp_add(wsum, 0); }
      { LAS float* red = Misc + 512 + wave * 16; if ((lane & 3) == 0) red[(lane >> 2) & 15] = wsum;
        if ((lane & 3) == 0 && lane >= 32) ((float*)(ws + WS_CT))[(rowbase + j0 + ((lane >> 2) & 7)) * 8 + h] = wsum;
        const f32x4v s0 = *(const LAS f32x4v*)(red), s1 = *(const LAS f32x4v*)(red + 4); const float ssv[8] = {s0[0], s0[1], s0[2], s0[3], s1[0], s1[1], s1[2], s1[3]};
#pragma unroll
        for (int jj = 0; jj < 8; ++jj) { kn[jj] *= fminf(__builtin_amdgcn_rsqf(ssv[jj]), 1e12f); ka[jj] *= kn[jj]; } }
      Misc[wave * 64 + ch] = run; }
    LBAR();
    { float off = 0.f, tot = 0.f;
#pragma unroll
      for (int w = 0; w < 8; ++w) { const float p = Misc[w * 64 + ch]; tot += p; if (w < wave) off += p; }
      const float eC = __expf(tot);
      if (wave == 0) ((float*)(ws + WS_GCE))[chd * 64 + ch] = eC;
      unsigned at8[8], bh8[8], kh8[8], rt8[8], v8[8], bt8[8], kt8[8];
#pragma unroll
      for (int jj = 0; jj < 8; ++jj) { const float g = gg[jj] + off; const float e1 = __expf(g), e2 = __expf(-g), em = __expf(-lw[jj]);
          const float at = -kn[jj] * e1 * em, bh = ka[jj] * e2, kh = km[jj] * e2, rt = rr[jj] * e1;
          at8[jj] = f2bf(at); bh8[jj] = f2bf(bh); kh8[jj] = f2bf(kh); rt8[jj] = f2bf(rt); v8[jj] = f2bf(vv[jj]); bt8[jj] = f2bf(bh * eC); kt8[jj] = f2bf(kh * eC);
          const int j = j0 + jj;
          At[j * 72 + ch] = (bf16)at8[jj]; Bh[j * 72 + ch] = (bf16)bh8[jj]; Kh[j * 72 + ch] = (bf16)kh8[jj]; Rt[j * 72 + ch] = (bf16)rt8[jj]; }
      v4u o;
      o.x = at8[0] | (at8[1] << 16); o.y = at8[2] | (at8[3] << 16); o.z = at8[4] | (at8[5] << 16); o.w = at8[6] | (at8[7] << 16); *(LAS v4u*)(AtT + ch * 72 + j0) = o;
      o.x = v8[0] | (v8[1] << 16); o.y = v8[2] | (v8[3] << 16); o.z = v8[4] | (v8[5] << 16); o.w = v8[6] | (v8[7] << 16); *(LAS v4u*)(VT + ch * 72 + j0) = o;
      o.x = bt8[0] | (bt8[1] << 16); o.y = bt8[2] | (bt8[3] << 16); o.z = bt8[4] | (bt8[5] << 16); o.w = bt8[6] | (bt8[7] << 16); *(LAS v4u*)(BtT + ch * 72 + j0) = o;
      o.x = kt8[0] | (kt8[1] << 16); o.y = kt8[2] | (kt8[3] << 16); o.z = kt8[4] | (kt8[5] << 16); o.w = kt8[6] | (kt8[7] << 16); *(LAS v4u*)(KtT + ch * 72 + j0) = o; }
    LBAR();
    { const int n0 = (wave >> 1) * 16, r = lane & 15, q = lane >> 4, i = n0 + r;
#pragma unroll
      for (int mm = 0; mm < 2; ++mm) { const int m0 = (2 * (wave & 1) + mm) * 16;
          f32x4v ab = mm_tile(At, Bh, n0, m0, lane, z4), ak = mm_tile(At, Kh, n0, m0, lane, z4), rb = mm_tile(Rt, Bh, n0, m0, lane, z4), rkk = mm_tile(Rt, Kh, n0, m0, lane, z4);
#pragma unroll
          for (int e = 0; e < 4; ++e) { const int j = m0 + 4 * q + e; if (!(j < i)) { ab[e] = 0.f; ak[e] = 0.f; } if (!(j <= i)) { rb[e] = 0.f; rkk[e] = 0.f; } }
          *(LAS f32x4v*)(Fm + i * 68 + m0 + 4 * q) = ab; st_tile(Aak, n0, m0, lane, ak); st_tile(Arb, n0, m0, lane, rb); st_tile(Ark, n0, m0, lane, rkk); } }
    LBAR();
    if (wave < 4) {
        const int blk = wave, cc = lane & 15; const LAS float* Ab = Fm + (16 * blk) * 68 + 16 * blk;
        float sv[16]; f32x4v av[16][4];
#pragma unroll
        for (int i = 1; i < 16; ++i)
#pragma unroll
            for (int jq = 0; jq < 4; ++jq) if (4 * jq < i) av[i][jq] = *(const LAS f32x4v*)(Ab + i * 68 + 4 * jq);
#pragma unroll
        for (int i = 0; i < 16; ++i) sv[i] = (i == cc) ? 1.f : 0.f;
#pragma unroll
        for (int j = 0; j < 15; ++j) { const float tj = sv[j];
#pragma unroll
            for (int i = j + 1; i < 16; ++i) sv[i] += av[i][j >> 2][j & 3] * tj; }
        if (lane < 16) {
#pragma unroll
            for (int i = 0; i < 16; ++i) { Tf[(16 * blk + i) * 68 + 16 * blk + cc] = sv[i]; Tm[(16 * blk + i) * 72 + 16 * blk + cc] = (bf16)f2bf(sv[i]); } }
        asm volatile("s_waitcnt lgkmcnt(0)" ::: "memory");
#pragma unroll
        for (int bk = 0; bk < 3; ++bk) if (bk < blk) {
            const f32x4v d = blk16(Tf + (16 * blk) * 68 + 16 * blk, Fm + (16 * blk) * 68 + 16 * bk, lane, z4);
            const int r = lane & 15, q = lane >> 4;
#pragma unroll
            for (int e = 0; e < 4; ++e) Fm[(16 * blk + 4 * q + e) * 68 + 16 * bk + r] = d[e]; }
    } else {
        for (int tt = wave - 4; tt < 16; tt += 4) { const int n0 = (tt >> 2) * 16, m0 = (tt & 3) * 16; st_tile(XT, n0, m0, lane, mm_tile(VT, Aak, n0, m0, lane, z4)); }
        if (wave >= 5) { const int k0 = (wave - 5) * 2;
#pragma unroll
            for (int kk2 = 0; kk2 < 2; ++kk2) { const int k = k0 + kk2; const int bi = (k < 3) ? 0 : (k < 5 ? 1 : 2), bj = (k < 3) ? k + 1 : (k < 5 ? k - 1 : 3);
                st_tile(Tm, bi * 16, bj * 16, lane, z4); } }
    }
    LBAR();
#define RA_TOUT(bi, bj, d) do { const int r_ = lane & 15, q_ = lane >> 4; _Pragma("unroll") for (int e = 0; e < 4; ++e) { Tf[(16 * (bi) + 4 * q_ + e) * 68 + 16 * (bj) + r_] = d[e]; Tm[(16 * (bi) + 4 * q_ + e) * 72 + 16 * (bj) + r_] = (bf16)f2bf(d[e]); } } while (0)
#define RA_BLK(M_, bi, bj) ((M_) + (16 * (bi)) * 68 + 16 * (bj))
    if (wave < 3) { const int bi = wave + 1, bj = wave; const f32x4v d = blk16(RA_BLK(Fm, bi, bj), RA_BLK(Tf, bj, bj), lane, z4); RA_TOUT(bi, bj, d); }
    LBAR();
    if (wave < 2) { const int bi = wave + 2, bj = wave; f32x4v d = blk16(RA_BLK(Fm, bi, bj), RA_BLK(Tf, bj, bj), lane, z4); d = blk16(RA_BLK(Fm, bi, bj + 1), RA_BLK(Tf, bj + 1, bj), lane, d); RA_TOUT(bi, bj, d); }
    LBAR();
    if (wave == 0) { f32x4v d = blk16(RA_BLK(Fm, 3, 0), RA_BLK(Tf, 0, 0), lane, z4); d = blk16(RA_BLK(Fm, 3, 1), RA_BLK(Tf, 1, 0), lane, d); d = blk16(RA_BLK(Fm, 3, 2), RA_BLK(Tf, 2, 0), lane, d); RA_TOUT(3, 0, d); }
    LBAR();
#undef RA_TOUT
#undef RA_BLK
#pragma unroll
    for (int i = 0; i < 4; ++i) { const int tt = wave * 4 + i, arr = tt >> 4, n0 = ((tt >> 2) & 3) * 16, m0 = (tt & 3) * 16;
        st_tile(arr ? U0T : WT, n0, m0, lane, mm_tile(arr ? XT : AtT, Tm, n0, m0, lane, z4)); }
    LBAR();
    { bf16* gM = (bf16*)(ws + WS_MPT) + (size_t)chd * 4096; bf16* gN = (bf16*)(ws + WS_NM) + (size_t)chd * 4096; bf16* gQ = (bf16*)(ws + WS_QE) + (size_t)chd * 4096; bf16* gY = (bf16*)(ws + WS_Y0) + (size_t)chd * 4096;
      const int n0 = (wave >> 1) * 16;
#pragma unroll
      for (int mm = 0; mm < 2; ++mm) { const int m0 = (2 * (wave & 1) + mm) * 16;
          st_tile_g(gM, n0, m0, lane, mm_tile(BtT, WT, n0, m0, lane, z4));
          st_tile_g(gN, n0, m0, lane, mm_tile(VT, KtT, n0, m0, lane, mm_tile(U0T, BtT, n0, m0, lane, z4)));
          f32x4v qe = mm_tile(Arb, WT, n0, m0, lane, z4); { const v2u rw = *(const LAS v2u*)(Rt + (n0 + (lane & 15)) * 72 + m0 + 4 * (lane >> 4)); qe[0] += bflo(rw.x); qe[1] += bfhi(rw.x); qe[2] += bflo(rw.y); qe[3] += bfhi(rw.y); }
          st_tile_g(gQ, n0, m0, lane, qe);
          st_tile_g(gY, n0, m0, lane, mm_tile(Ark, VT, n0, m0, lane, mm_tile(Arb, U0T, n0, m0, lane, z4))); } }
    LBAR();
}
__device__ __forceinline__ void ra_item_of(int G, int it, int& b, int& c, int& h) {
    int id = it; if (G == 256) id = blockIdx.x * 32 + (it / 256);
    h = id & 7; const int bc = id >> 3; b = bc >> 7; c = bc & 127;
}
__device__ __forceinline__ void ph_rwkv_passA(Frame& F, unsigned char* ws) {
    const int NIT = NB * 128 * 8; int it = blockIdx.x; if (it >= NIT) return;
    int b, c, h; ra_item_of(F.G, it, b, c, h);
    RaPf pf; rwkv_pf_load(pf, F, b, c, h, ws);
#pragma unroll 1
    for (; it < NIT; it += F.G) {
        const int nit = it + F.G; int nb_ = b, nc_ = c, nh_ = h;
        if (nit < NIT) { ra_item_of(F.G, nit, nb_, nc_, nh_); rwkv_passA_item<true>(F, b, c, h, ws, pf, nb_, nc_, nh_); }
        else rwkv_passA_item<false>(F, b, c, h, ws, pf, nb_, nc_, nh_);
        b = nb_; c = nc_; h = nh_;
    }
}
constexpr int RB_SLOT = 11776, RB_NOFF = 9216, RB_GOFF = 11520, RB_R = 6, RB_NBATCH = 22;
struct RbThr { const unsigned char* p0; const unsigned char* p1; unsigned st0, st1; int d0, d1; bool has1; };
__device__ __forceinline__ void rb_piece(unsigned char* ws, int b, int h, int vq, int w, const unsigned char*& p, unsigned& st, int& d) {
    const size_t chd0 = (size_t)(b * 128 * 8 + h);
    if (w < 512) { p = (const unsigned char*)((const bf16*)(ws + WS_MPT) + chd0 * 4096) + 16 * w; st = 65536u; d = (w >> 3) * 144 + (w & 7) * 16; }
    else if (w < 640) { p = (const unsigned char*)((const bf16*)(ws + WS_NM) + chd0 * 4096 + (size_t)vq * 16 * 64) + 16 * (w - 512); st = 65536u; d = RB_NOFF + ((w - 512) >> 3) * 144 + ((w - 512) & 7) * 16; }
    else { p = (const unsigned char*)((const float*)(ws + WS_GCE) + chd0 * 64) + 16 * (w - 640); st = 2048u; d = RB_GOFF + 16 * (w - 640); }
}
__device__ __forceinline__ void rb_issue(v4u (&reg)[2 * RB_R], const RbThr& th, int batch) {
#pragma unroll
    for (int cs = 0; cs < RB_R; ++cs) { int c = batch * RB_R + cs; if (c > 127) c = 127;
        reg[2 * cs] = *(const v4u*)(th.p0 + (size_t)c * th.st0); reg[2 * cs + 1] = (v4u){0u, 0u, 0u, 0u}; if (th.has1) reg[2 * cs + 1] = *(const v4u*)(th.p1 + (size_t)c * th.st1); }
}
__device__ __forceinline__ void rb_commit(const v4u (&reg)[2 * RB_R], const RbThr& th, LAS unsigned char* ring, int half) {
#pragma unroll
    for (int cs = 0; cs < RB_R; ++cs) { LAS unsigned char* slot = ring + (half * RB_R + cs) * RB_SLOT; *(LAS v4u*)(slot + th.d0) = reg[2 * cs]; if (th.has1) *(LAS v4u*)(slot + th.d1) = reg[2 * cs + 1]; }
}
struct RbLds { v2u lo[4][2], hi[4][2], nn[4]; f32x4v ge[4]; };
__device__ __forceinline__ void rb_lds(RbLds& o, const LAS unsigned char* slot, int r, int q) {
#pragma unroll
    for (int mt = 0; mt < 4; ++mt) {
#pragma unroll
        for (int s2 = 0; s2 < 2; ++s2) { const LAS unsigned char* rowp = slot + (16 * mt + r) * 144 + (32 * s2 + 4 * q) * 2; o.lo[mt][s2] = *(const LAS v2u*)rowp; o.hi[mt][s2] = *(const LAS v2u*)(rowp + 32); }
        o.nn[mt] = *(const LAS v2u*)(slot + RB_NOFF + r * 144 + (16 * mt + 4 * q) * 2); o.ge[mt] = *(const LAS f32x4v*)(slot + RB_GOFF + (16 * mt + 4 * q) * 4); }
}
__device__ __forceinline__ void ph_rwkv_passB(Frame& F, unsigned char* ws) {
    const int lane = F.lane, r = lane & 15, q = lane >> 4, wave = F.wave; LAS unsigned char* ring = F.lds;
    for (int task0 = blockIdx.x; task0 < NB * 8 * 4; task0 += F.G) {
        int task = task0; if (F.G == 256) { const int xcd = task0 & 7, sl = task0 >> 3; task = (xcd * 8 + (sl >> 2)) * 4 + (sl & 3); }
        const int vq = task & 3, h = (task >> 2) & 7, b = task >> 5, v = vq * 16 + r; const int lt = (F.tid >= 64) ? F.tid - 64 : 0;
        f32x4v S[4];
#pragma unroll
        for (int mt = 0; mt < 4; ++mt) S[mt] = (f32x4v){0.f, 0.f, 0.f, 0.f};
        RbThr th; rb_piece(ws, b, h, vq, lt, th.p0, th.st0, th.d0); th.has1 = (lt + 448) < 656; rb_piece(ws, b, h, vq, th.has1 ? lt + 448 : lt, th.p1, th.st1, th.d1);
        if (wave != 0) {
            v4u ra[2 * RB_R];
            rb_issue(ra, th, 0); rb_commit(ra, th, ring, 0); rb_issue(ra, th, 1);
            LBAR();
#pragma unroll 1
            for (int k = 0; k < RB_NBATCH; ++k) { rb_commit(ra, th, ring, (k & 1) ^ 1); rb_issue(ra, th, k + 2); LBAR(); }
        } else {
            __builtin_amdgcn_s_waitcnt(0x0F70);
            LBAR();
#pragma unroll 1
            for (int k = 0; k < RB_NBATCH; ++k) { const LAS unsigned char* half = ring + ((k & 1) * RB_R) * RB_SLOT;
                RbLds cur; rb_lds(cur, half, r, q);
#pragma unroll
                for (int cs = 0; cs < RB_R; ++cs) { const int c = k * RB_R + cs;
                    RbLds nxt; if (cs + 1 < RB_R) rb_lds(nxt, half + (cs + 1) * RB_SLOT, r, q);
                    v2u sb[4];
#pragma unroll
                    for (int mt = 0; mt < 4; ++mt) { sb[mt].x = pk2(S[mt][0], S[mt][1]); sb[mt].y = pk2(S[mt][2], S[mt][3]); }
                    if (c < 128) { bf16* gS = (bf16*)(ws + WS_S0) + (size_t)((b * 128 + c) * 8 + h) * 4096;
#pragma unroll
                        for (int mt = 0; mt < 4; ++mt) gstore8_nowait(gS + v * 64 + 16 * mt + 4 * q, sb[mt]); }
                    bf16x8 bfr[2];
#pragma unroll
                    for (int s2 = 0; s2 < 2; ++s2) { v4u w; w.x = sb[2 * s2].x; w.y = sb[2 * s2].y; w.z = sb[2 * s2 + 1].x; w.w = sb[2 * s2 + 1].y; bfr[s2] = __builtin_bit_cast(bf16x8, w); }
#pragma unroll
                    for (int mt = 0; mt < 4; ++mt) { f32x4v d = {0.f, 0.f, 0.f, 0.f};
#pragma unroll
                        for (int s2 = 0; s2 < 2; ++s2) { v4u w; w.x = cur.lo[mt][s2].x; w.y = cur.lo[mt][s2].y; w.z = cur.hi[mt][s2].x; w.w = cur.hi[mt][s2].y;
                            d = __builtin_amdgcn_mfma_f32_16x16x32_bf16(__builtin_bit_cast(bf16x8, w), bfr[s2], d, 0, 0, 0); }
                        S[mt][0] = S[mt][0] * cur.ge[mt][0] + d[0] + bflo(cur.nn[mt].x); S[mt][1] = S[mt][1] * cur.ge[mt][1] + d[1] + bfhi(cur.nn[mt].x);
                        S[mt][2] = S[mt][2] * cur.ge[mt][2] + d[2] + bflo(cur.nn[mt].y); S[mt][3] = S[mt][3] * cur.ge[mt][3] + d[3] + bfhi(cur.nn[mt].y); }
                    if (cs + 1 < RB_R) cur = nxt; }
                LBAR();
            }
        }
    }
}
constexpr int RC_LD = 136, RC_BYTES = 65 * RC_LD * 2;
__device__ __forceinline__ void ph_rwkv_passC(Frame& F, unsigned char* ws) {
    const int lane = F.lane, r = lane & 15, q = lane >> 4; const bf16* P = F.PROJ;
    LAS bf16* VG = (LAS bf16*)(F.lds + F.wave * RC_BYTES);
    const int gwv = blockIdx.x * NWAVES + F.wave, NGW = F.G * NWAVES;
    for (int it = gwv; it < NB * 128 * 8; it += NGW) {
        int id = it; if (F.G == 256) id = blockIdx.x * 32 + (it / NGW) * 8 + F.wave;
        const int h = id & 7, bc = id >> 3, b = bc >> 7, c = bc & 127; const size_t chd = (size_t)id;
        const bf16* gQ = (const bf16*)(ws + WS_QE) + chd * 4096; const bf16* gY = (const bf16*)(ws + WS_Y0) + chd * 4096; const bf16* gS = (const bf16*)(ws + WS_S0) + chd * 4096;
        const long rowbase = (long)b * T + c * 64;
        v4u vp[9], gp[9];
#pragma unroll
        for (int k = 0; k < 9; ++k) { const int idx = lane + 64 * k; vp[k] = (v4u){0u, 0u, 0u, 0u}; gp[k] = (v4u){0u, 0u, 0u, 0u};
            if (idx < 520) { const int row = idx >> 3, p8 = idx & 7; if (row > 0 || c > 0) { const bf16* src = P + (rowbase - 1 + row) * P0LD + h * 64 + 8 * p8; vp[k] = *(const v4u*)(src + C_V); gp[k] = *(const v4u*)(src + C_GA); } } }
        bf16x8 sf[4][2];
#pragma unroll
        for (int mt = 0; mt < 4; ++mt)
#pragma unroll
            for (int s = 0; s < 2; ++s) sf[mt][s] = *(const bf16x8*)(gS + (16 * mt + r) * 64 + 32 * s + 8 * q);
        f32x4v lnw[4], lnb[4], muv[4], mug[4];
#pragma unroll
        for (int mt = 0; mt < 4; ++mt) { const int cg = h * 64 + 16 * mt + 4 * q; lnw[mt] = *(const f32x4v*)(F.a_ln_w + cg); lnb[mt] = *(const f32x4v*)(F.a_ln_b + cg);
            muv[mt] = *(const f32x4v*)(F.a_mu + C_V + cg); mug[mt] = *(const f32x4v*)(F.a_mu + C_GA + cg); }
#pragma unroll
        for (int k = 0; k < 9; ++k) { const int idx = lane + 64 * k; if (idx < 520) { const int row = idx >> 3, p8 = idx & 7; *(LAS v4u*)(VG + row * RC_LD + 8 * p8) = vp[k]; *(LAS v4u*)(VG + row * RC_LD + 64 + 8 * p8) = gp[k]; } }
#pragma unroll 1
        for (int nt = 0; nt < 4; ++nt) {
            const int i = 16 * nt + r; const long t = rowbase + i;
            bf16x8 qf[2];
#pragma unroll
            for (int s = 0; s < 2; ++s) qf[s] = *(const bf16x8*)(gQ + i * 64 + 32 * s + 8 * q);
            v2u y0w[4];
#pragma unroll
            for (int mt = 0; mt < 4; ++mt) y0w[mt] = *(const v2u*)(gY + i * 64 + 16 * mt + 4 * q);
            const float ct = ((const float*)(ws + WS_CT))[t * 8 + h];
            f32x4v y[4]; float sum = 0.f;
#pragma unroll
            for (int mt = 0; mt < 4; ++mt) { const v2u y0 = y0w[mt];
                f32x4v d = {bflo(y0.x), bfhi(y0.x), bflo(y0.y), bfhi(y0.y)};
#pragma unroll
                for (int s = 0; s < 2; ++s) d = __builtin_amdgcn_mfma_f32_16x16x32_bf16(sf[mt][s], qf[s], d, 0, 0, 0);
                y[mt] = d; sum += (d[0] + d[1]) + (d[2] + d[3]); }
            sum += __shfl_xor(sum, 16); sum += __shfl_xor(sum, 32);
            const float mean = sum * (1.f / 64.f); float sq = 0.f;
#pragma unroll
            for (int mt = 0; mt < 4; ++mt)
#pragma unroll
                for (int e = 0; e < 4; ++e) { const float dd = y[mt][e] - mean; y[mt][e] = dd; sq += dd * dd; }
            sq += __shfl_xor(sq, 16); sq += __shfl_xor(sq, 32);
            const float rstd = __builtin_amdgcn_rsqf(sq * (1.f / 64.f) + 64e-5f);
#pragma unroll
            for (int mt = 0; mt < 4; ++mt) { const int col = h * 64 + 16 * mt + 4 * q;
                const LAS bf16* lp = VG + i * RC_LD + 16 * mt + 4 * q;
                const v2u pv = *(const LAS v2u*)lp, pg = *(const LAS v2u*)(lp + 64), cv = *(const LAS v2u*)(lp + RC_LD), cgt = *(const LAS v2u*)(lp + RC_LD + 64);
                const float cvf[4] = {bflo(cv.x), bfhi(cv.x), bflo(cv.y), bfhi(cv.y)}, pvf[4] = {bflo(pv.x), bfhi(pv.x), bflo(pv.y), bfhi(pv.y)};
                const float cgf[4] = {bflo(cgt.x), bfhi(cgt.x), bflo(cgt.y), bfhi(cgt.y)}, pgf[4] = {bflo(pg.x), bfhi(pg.x), bflo(pg.y), bfhi(pg.y)};
                float o[4];
#pragma unroll
                for (int e = 0; e < 4; ++e) { const float vs = cvf[e] + muv[mt][e] * (pvf[e] - cvf[e]), gs = cgf[e] + mug[mt][e] * (pgf[e] - cgf[e]);
                    o[e] = (y[mt][e] * rstd * lnw[mt][e] + lnb[mt][e] + ct * vs) * siluf_(gs); }
                v2u ow; ow.x = pk2(o[0], o[1]); ow.y = pk2(o[2], o[3]);
                *(v2u*)(F.HB + (size_t)t * D + col) = ow; }
        }
    }
}
constexpr size_t WS_OB = 32 * MiB  , WS_GAM = 928 * MiB, WS_SSQ = 936 * MiB;
__device__ __forceinline__ void ph_hgrn_prep(Frame& F, unsigned char* ws) {
    const int gw = F.vcu * NWAVES + F.wave, NGW = F.G * NWAVES, lane = F.lane;
    bf16* P = F.PROJ; float* gam = (float*)(ws + WS_GAM);
    for (int task = gw; task < (M / 64) * 2; task += NGW) {
        const int bc = task >> 1, c0 = (task & 1) * 512 + 8 * lane;
        const f32x4 l0 = *(const f32x4*)(F.lb_tab + c0), l1 = *(const f32x4*)(F.lb_tab + c0 + 4); const float lb[8] = {l0[0], l0[1], l0[2], l0[3], l1[0], l1[1], l1[2], l1[3]};
        float run[8];
#pragma unroll
        for (int e = 0; e < 8; ++e) run[e] = 1.f;
        bf16* p = P + (size_t)bc * 64 * P1LD + c0;
#pragma unroll 4
        for (int j = 0; j < 64; ++j) { const v4u qw = *(const v4u*)(p + (size_t)j * P1LD), fw = *(const v4u*)(p + (size_t)j * P1LD + 1024);
            float qd[8], ki[8];
#pragma unroll
            for (int e = 0; e < 8; ++e) { const float qv = (e & 1) ? bfhi(qw[e >> 1]) : bflo(qw[e >> 1]), fv = (e & 1) ? bfhi(fw[e >> 1]) : bflo(fw[e >> 1]);
                const float a = __expf(fminf(-fv, 40.f)), bq_ = __expf(fminf(-qv, 40.f)); const float rab = frcp((1.0f + a) * (1.0f + bq_));
                const float sg = rab * (1.0f + bq_), sq = rab * (1.0f + a); run[e] *= (1.0f + lb[e] * a) * sg;
                qd[e] = qv * sq * run[e]; ki[e] = (1.0f - lb[e]) * a * sg * frcp(run[e]); }
            v4u qo, ko;
#pragma unroll
            for (int e = 0; e < 4; ++e) { qo[e] = pk2(qd[2 * e], qd[2 * e + 1]); ko[e] = pk2(ki[2 * e], ki[2 * e + 1]); }
            *(v4u*)(p + (size_t)j * P1LD) = qo; *(v4u*)(p + (size_t)j * P1LD + 1024) = ko; }
        f32x4 g0, g1;
#pragma unroll
        for (int e = 0; e < 4; ++e) { g0[e] = run[e]; g1[e] = run[4 + e]; }
        *(f32x4*)(gam + (size_t)bc * 1024 + c0) = g0; *(f32x4*)(gam + (size_t)bc * 1024 + c0 + 4) = g1;
    }
}
typedef short v4s __attribute__((ext_vector_type(4)));
__device__ __forceinline__ bf16x8 tr_frag(const LAS bf16* Mx, int ld, int j0, int c0, int lane) {
    const int q = lane >> 4, i = lane & 15; const LAS bf16* a = Mx + (j0 + 8 * q + (i >> 2)) * ld + c0 + 4 * (i & 3);
    const v4s lo = __builtin_amdgcn_ds_read_tr16_b64_v4i16((LAS v4s*)a), hi = __builtin_amdgcn_ds_read_tr16_b64_v4i16((LAS v4s*)(a + 4 * ld));
    return (bf16x8){lo[0], lo[1], lo[2], lo[3], hi[0], hi[1], hi[2], hi[3]};
}
__device__ __forceinline__ bf16x8 tr_frag_perm(const LAS bf16* Mx, int ld, int s2, int c0, int lane) {
    const int q = lane >> 4, i = lane & 15; const LAS bf16* a = Mx + (32 * s2 + 4 * q + (i >> 2)) * ld + c0 + 4 * (i & 3);
    const v4s lo = __builtin_amdgcn_ds_read_tr16_b64_v4i16((LAS v4s*)a), hi = __builtin_amdgcn_ds_read_tr16_b64_v4i16((LAS v4s*)(a + 16 * ld));
    return (bf16x8){lo[0], lo[1], lo[2], lo[3], hi[0], hi[1], hi[2], hi[3]};
}
constexpr int HG_QD = 0, HG_KI = 34816, HG_VS = 69632, HG_ST = 79872, HG_GAM = 97280;
__device__ __forceinline__ void ph_hgrn_chunk(Frame& F, unsigned char* ws) {
    LAS unsigned char* L = F.lds; const int tid = F.tid, lane = F.lane, wave = F.wave, r = lane & 15, q = lane >> 4;
    const bf16* P = F.PROJ; const float* gam = (const float*)(ws + WS_GAM); bf16* OB = (bf16*)(ws + WS_OB); float* SSQ = (float*)(ws + WS_SSQ);
    for (int task0 = blockIdx.x; task0 < NB * 8 * 4; task0 += F.G) {
        int task = task0; if (F.G == 256) { const int xcd = task0 & 7, sl = task0 >> 3; task = (xcd * 8 + (sl >> 2)) * 4 + (sl & 3); }
        const int vq = task & 3, h = (task >> 2) & 7, b = task >> 5, ib = wave >> 1, vt = wave & 1;
        f32x4v S[2]; S[0] = (f32x4v){0.f, 0.f, 0.f, 0.f}; S[1] = S[0];
        for (int u = tid; u < 8704 / 4; u += NTHR) ((LAS unsigned*)(L + HG_ST))[u] = 0u;
        const int prow0 = tid >> 4, pc = tid & 15, vrow = tid >> 2, vpc = tid & 3;
        v4u rqA[2], rkA[2], rvA = {0u, 0u, 0u, 0u}, rqB[2], rkB[2], rvB = {0u, 0u, 0u, 0u}; float rgA = 0.f, rgB = 0.f;
#define HG_LOAD(c_, rq, rk, rv, rg) do { const size_t rb_ = (size_t)b * T + (size_t)(c_) * 64; \
            _Pragma("unroll") for (int i_ = 0; i_ < 2; ++i_) { const bf16* s_ = P + (rb_ + prow0 + 32 * i_) * P1LD + h * 128 + 8 * pc; rq[i_] = *(const v4u*)s_; rk[i_] = *(const v4u*)(s_ + 1024); } \
            if (wave < 4) rv = *(const v4u*)(P + (rb_ + vrow) * P1LD + 2048 + h * 128 + vq * 32 + 8 * vpc); \
            if (wave < 2) rg = gam[((size_t)b * 128 + (c_)) * 1024 + h * 128 + tid]; } while (0)
#define HG_STAGE(bufi, rq, rk, rv, rg) do { LAS bf16* QDs_ = (LAS bf16*)(L + HG_QD + (bufi) * 17408); LAS bf16* KIs_ = (LAS bf16*)(L + HG_KI + (bufi) * 17408); \
            _Pragma("unroll") for (int i_ = 0; i_ < 2; ++i_) { *(LAS v4u*)(QDs_ + (prow0 + 32 * i_) * 136 + 8 * pc) = rq[i_]; *(LAS v4u*)(KIs_ + (prow0 + 32 * i_) * 136 + 8 * pc) = rk[i_]; } \
            if (wave < 4) *(LAS v4u*)((LAS bf16*)(L + HG_VS + (bufi) * 5120) + vrow * 40 + 8 * vpc) = rv; \
            if (wave < 2) ((LAS float*)(L + HG_GAM + (bufi) * 512))[tid] = rg; } while (0)
        HG_LOAD(0, rqA, rkA, rvA, rgA); HG_LOAD(1, rqB, rkB, rvB, rgB);
        HG_STAGE(0, rqA, rkA, rvA, rgA); HG_LOAD(2, rqA, rkA, rvA, rgA);
        LBAR();
#pragma unroll 1
        for (int c2 = 0; c2 < 128; c2 += 2) {
#pragma unroll
          for (int par = 0; par < 2; ++par) { const int c = c2 + par;
            if (c + 1 < 128) {
                if (par == 0) { HG_STAGE(1, rqB, rkB, rvB, rgB); if (c + 3 < 128) HG_LOAD(c + 3, rqB, rkB, rvB, rgB); }
                else { HG_STAGE(0, rqA, rkA, rvA, rgA); if (c + 3 < 128) HG_LOAD(c + 3, rqA, rkA, rvA, rgA); } }
            const LAS bf16* QD = (const LAS bf16*)(L + HG_QD + par * 17408); const LAS bf16* KI = (const LAS bf16*)(L + HG_KI + par * 17408); const LAS bf16* VS = (const LAS bf16*)(L + HG_VS + par * 5120);
            const LAS float* GAM = (const LAS float*)(L + HG_GAM + par * 512);
            const LAS bf16* STc = (const LAS bf16*)(L + HG_ST + par * 8704); LAS bf16* STn = (LAS bf16*)(L + HG_ST + (par ^ 1) * 8704);
            bf16x8 bq[4], kf[4][4], stf[4], vtf[2], ktf[2][2];
#pragma unroll
            for (int s = 0; s < 4; ++s) bq[s] = *(const LAS bf16x8*)(QD + (16 * ib + r) * 136 + 32 * s + 8 * q);
            vtf[0] = tr_frag_perm(VS, 40, 0, 16 * vt, lane); vtf[1] = tr_frag_perm(VS, 40, 1, 16 * vt, lane);
#pragma unroll
            for (int jt = 0; jt < 4; ++jt) if (jt <= ib) {
#pragma unroll
                for (int s = 0; s < 4; ++s) kf[jt][s] = *(const LAS bf16x8*)(KI + (16 * jt + r) * 136 + 32 * s + 8 * q); }
#pragma unroll
            for (int s = 0; s < 4; ++s) stf[s] = *(const LAS bf16x8*)(STc + (16 * vt + r) * 136 + 32 * s + 8 * q);
#pragma unroll
            for (int k2 = 0; k2 < 2; ++k2) { ktf[k2][0] = tr_frag_perm(KI, 136, 0, (2 * ib + k2) * 16, lane); ktf[k2][1] = tr_frag_perm(KI, 136, 1, (2 * ib + k2) * 16, lane); }
            const f32x4v g0 = *(const LAS f32x4v*)(GAM + (2 * ib) * 16 + 4 * q), g1 = *(const LAS f32x4v*)(GAM + (2 * ib + 1) * 16 + 4 * q);
            __builtin_amdgcn_sched_barrier(0);
            f32x4v sc[4];
#pragma unroll
            for (int jt = 0; jt < 4; ++jt) { f32x4v d = {0.f, 0.f, 0.f, 0.f};
                if (jt <= ib) {
#pragma unroll
                    for (int s = 0; s < 4; ++s) d = __builtin_amdgcn_mfma_f32_16x16x32_bf16(kf[jt][s], bq[s], d, 0, 0, 0);
                    if (jt == ib) {
#pragma unroll
                        for (int e = 0; e < 4; ++e) if (4 * q + e > r) d[e] = 0.f; } }
                sc[jt] = d; }
            f32x4v o = {0.f, 0.f, 0.f, 0.f};
#pragma unroll
            for (int s = 0; s < 4; ++s) o = __builtin_amdgcn_mfma_f32_16x16x32_bf16(stf[s], bq[s], o, 0, 0, 0);
#pragma unroll
            for (int k2 = 0; k2 < 2; ++k2) { f32x4v d = S[k2];
                d = __builtin_amdgcn_mfma_f32_16x16x32_bf16(ktf[k2][0], vtf[0], d, 0, 0, 0);
                d = __builtin_amdgcn_mfma_f32_16x16x32_bf16(ktf[k2][1], vtf[1], d, 0, 0, 0);
                d = d * (k2 ? g1 : g0); S[k2] = d;
                v2u w; w.x = pk2(d[0], d[1]); w.y = pk2(d[2], d[3]); *(LAS v2u*)(STn + (16 * vt + r) * 136 + (2 * ib + k2) * 16 + 4 * q) = w; }
#pragma unroll
            for (int s2 = 0; s2 < 2; ++s2) { v4u w; w.x = pk2(sc[2 * s2][0], sc[2 * s2][1]); w.y = pk2(sc[2 * s2][2], sc[2 * s2][3]); w.z = pk2(sc[2 * s2 + 1][0], sc[2 * s2 + 1][1]); w.w = pk2(sc[2 * s2 + 1][2], sc[2 * s2 + 1][3]);
                o = __builtin_amdgcn_mfma_f32_16x16x32_bf16(vtf[s2], __builtin_bit_cast(bf16x8, w), o, 0, 0, 0); }
            { const size_t t = (size_t)b * T + (size_t)c * 64 + 16 * ib + r;
              v2u w; w.x = pk2(o[0], o[1]); w.y = pk2(o[2], o[3]); *(v2u*)(OB + t * D + h * 128 + vq * 32 + 16 * vt + 4 * q) = w;
              float ss = (o[0] * o[0] + o[1] * o[1]) + (o[2] * o[2] + o[3] * o[3]); ss += __shfl_xor(ss, 16); ss += __shfl_xor(ss, 32);
              if (q == 0) SSQ[(t * 8 + h) * 8 + vq * 2 + vt] = ss; }
            LBAR();
          }
        }
#undef HG_LOAD
#undef HG_STAGE
    }
}
constexpr int FQ_QD = 0, FQ_KI = 34816, FQ_VS = 69632, FQ_ST = 104448, FQ_GAM = 139264, FQ_G = 140288;
constexpr int HG_NSEG = 4, HG_CPS = 128 / HG_NSEG;
constexpr size_t WS_SEND = 960 * MiB, WS_GSEG = 980 * MiB, WS_GV = 982 * MiB;
__device__ __forceinline__ void ph_hgrn_fat(Frame& F, unsigned char* ws) {
    LAS unsigned char* L = F.lds; const int tid = F.tid, lane = F.lane, wave = F.wave, r = lane & 15, q = lane >> 4;
    const bf16* P = F.PROJ; const float* gam = (const float*)(ws + WS_GAM); bf16* OB = (bf16*)(ws + WS_OB);
    for (int task = blockIdx.x; task < NB * 8 * HG_NSEG; task += F.G) {
        const int seg = task % HG_NSEG, bh = task / HG_NSEG, h = bh & 7, b = bh >> 3, ib = wave >> 1, vh = wave & 1, cbeg = seg * HG_CPS;
        f32x4v S[2][4];
#pragma unroll
        for (int k2 = 0; k2 < 2; ++k2)
#pragma unroll
            for (int vt = 0; vt < 4; ++vt) S[k2][vt] = (f32x4v){0.f, 0.f, 0.f, 0.f};
        float gprod = 1.f;
        for (int u = tid; u < 34816 / 4; u += NTHR) ((LAS unsigned*)(L + FQ_ST))[u] = 0u;
        const int prow0 = tid >> 4, pc = tid & 15;
        v4u rqA[2], rkA[2], rvA[2]; float rgA = 0.f;
#define HF_LOAD(c_, rq, rk, rv, rg) do { const size_t rb_ = (size_t)b * T + (size_t)(cbeg + (c_)) * 64; \
            _Pragma("unroll") for (int i_ = 0; i_ < 2; ++i_) { const bf16* s_ = P + (rb_ + prow0 + 32 * i_) * P1LD + h * 128 + 8 * pc; rq[i_] = *(const v4u*)s_; rk[i_] = *(const v4u*)(s_ + 1024); rv[i_] = *(const v4u*)(s_ + 2048); } \
            if (wave < 2) rg = gam[((size_t)b * 128 + cbeg + (c_)) * 1024 + h * 128 + tid]; } while (0)
#define HF_STAGE(bufi, rq, rk, rv, rg) do { LAS bf16* QDs_ = (LAS bf16*)(L + FQ_QD + (bufi) * 17408); LAS bf16* KIs_ = (LAS bf16*)(L + FQ_KI + (bufi) * 17408); LAS bf16* VSs_ = (LAS bf16*)(L + FQ_VS + (bufi) * 17408); \
            _Pragma("unroll") for (int i_ = 0; i_ < 2; ++i_) { const int o_ = (prow0 + 32 * i_) * 136 + 8 * pc; *(LAS v4u*)(QDs_ + o_) = rq[i_]; *(LAS v4u*)(KIs_ + o_) = rk[i_]; *(LAS v4u*)(VSs_ + o_) = rv[i_]; } \
            if (wave < 2) { ((LAS float*)(L + FQ_GAM + (bufi) * 512))[tid] = rg; gprod *= rg; } } while (0)
        HF_LOAD(0, rqA, rkA, rvA, rgA);
        HF_STAGE(0, rqA, rkA, rvA, rgA); HF_LOAD(1, rqA, rkA, rvA, rgA);
        LBAR();
        LAS bf16* ST = (LAS bf16*)(L + FQ_ST);
#pragma unroll 1
        for (int c2 = 0; c2 < HG_CPS; c2 += 2) {
#pragma unroll
          for (int par = 0; par < 2; ++par) { const int c = c2 + par;
            if (c + 1 < HG_CPS) {
                HF_STAGE(par ^ 1, rqA, rkA, rvA, rgA); if (c + 2 < HG_CPS) HF_LOAD(c + 2, rqA, rkA, rvA, rgA); }
            const LAS bf16* QD = (const LAS bf16*)(L + FQ_QD + par * 17408); const LAS bf16* KI = (const LAS bf16*)(L + FQ_KI + par * 17408); const LAS bf16* VS = (const LAS bf16*)(L + FQ_VS + par * 17408);
            const LAS float* GAM = (const LAS float*)(L + FQ_GAM + par * 512);
            bf16x8 bq[4], kf[2][4], stf[4][4], vtf[4][2];
#pragma unroll
            for (int s = 0; s < 4; ++s) bq[s] = *(const LAS bf16x8*)(QD + (16 * ib + r) * 136 + 32 * s + 8 * q);
            f32x4v sc[4];
#pragma unroll
            for (int jh = 0; jh < 2; ++jh) {
#pragma unroll
                for (int j2 = 0; j2 < 2; ++j2) if (2 * jh + j2 <= ib) {
#pragma unroll
                    for (int s = 0; s < 4; ++s) kf[j2][s] = *(const LAS bf16x8*)(KI + (16 * (2 * jh + j2) + r) * 136 + 32 * s + 8 * q); }
                __builtin_amdgcn_sched_barrier(0);
#pragma unroll
                for (int j2 = 0; j2 < 2; ++j2) { const int jt = 2 * jh + j2; f32x4v d = {0.f, 0.f, 0.f, 0.f};
                    if (jt <= ib) {
#pragma unroll
                        for (int s = 0; s < 4; ++s) d = __builtin_amdgcn_mfma_f32_16x16x32_bf16(kf[j2][s], bq[s], d, 0, 0, 0);
                        if (jt == ib) {
#pragma unroll
                            for (int e = 0; e < 4; ++e) if (4 * q + e > r) d[e] = 0.f; } }
                    sc[jt] = d; }
                __builtin_amdgcn_sched_barrier(0); }
            bf16x8 pw[2];
#pragma unroll
            for (int s2 = 0; s2 < 2; ++s2) { v4u w; w.x = pk2(sc[2 * s2][0], sc[2 * s2][1]); w.y = pk2(sc[2 * s2][2], sc[2 * s2][3]); w.z = pk2(sc[2 * s2 + 1][0], sc[2 * s2 + 1][1]); w.w = pk2(sc[2 * s2 + 1][2], sc[2 * s2 + 1][3]);
                pw[s2] = __builtin_bit_cast(bf16x8, w); }
            __builtin_amdgcn_sched_barrier(0);
#pragma unroll
            for (int vt = 0; vt < 4; ++vt)
#pragma unroll
                for (int s = 0; s < 4; ++s) stf[vt][s] = *(const LAS bf16x8*)(ST + (64 * vh + 16 * vt + r) * 136 + 32 * s + 8 * q);
            __builtin_amdgcn_sched_barrier(0);
            f32x4v o[4];
#pragma unroll
            for (int vt = 0; vt < 4; ++vt) { f32x4v d = {0.f, 0.f, 0.f, 0.f};
#pragma unroll
                for (int s = 0; s < 4; ++s) d = __builtin_amdgcn_mfma_f32_16x16x32_bf16(stf[vt][s], bq[s], d, 0, 0, 0);
                o[vt] = d; }
            __builtin_amdgcn_sched_barrier(0);
#pragma unroll
            for (int vt = 0; vt < 4; ++vt) { vtf[vt][0] = tr_frag_perm(VS, 136, 0, 64 * vh + 16 * vt, lane); vtf[vt][1] = tr_frag_perm(VS, 136, 1, 64 * vh + 16 * vt, lane); }
            __builtin_amdgcn_sched_barrier(0);
#pragma unroll
            for (int vt = 0; vt < 4; ++vt)
#pragma unroll
                for (int s2 = 0; s2 < 2; ++s2) o[vt] = __builtin_amdgcn_mfma_f32_16x16x32_bf16(vtf[vt][s2], pw[s2], o[vt], 0, 0, 0);
            LBAR();
            { bf16x8 ktf[2][2];
#pragma unroll
              for (int k2 = 0; k2 < 2; ++k2) { ktf[k2][0] = tr_frag_perm(KI, 136, 0, (2 * ib + k2) * 16, lane); ktf[k2][1] = tr_frag_perm(KI, 136, 1, (2 * ib + k2) * 16, lane); }
              const f32x4v g0 = *(const LAS f32x4v*)(GAM + (2 * ib) * 16 + 4 * q), g1 = *(const LAS f32x4v*)(GAM + (2 * ib + 1) * 16 + 4 * q);
#pragma unroll
              for (int vt = 0; vt < 4; ++vt) { const int v0 = 64 * vh + 16 * vt; const bf16x8 vf0 = tr_frag_perm(VS, 136, 0, v0, lane), vf1 = tr_frag_perm(VS, 136, 1, v0, lane);
#pragma unroll
                for (int k2 = 0; k2 < 2; ++k2) { f32x4v d = S[k2][vt];
                    d = __builtin_amdgcn_mfma_f32_16x16x32_bf16(ktf[k2][0], vf0, d, 0, 0, 0);
                    d = __builtin_amdgcn_mfma_f32_16x16x32_bf16(ktf[k2][1], vf1, d, 0, 0, 0);
                    d = d * (k2 ? g1 : g0); S[k2][vt] = d;
                    v2u w; w.x = pk2(d[0], d[1]); w.y = pk2(d[2], d[3]); *(LAS v2u*)(ST + (v0 + r) * 136 + (2 * ib + k2) * 16 + 4 * q) = w; } } }
            { LAS bf16* OT = (LAS bf16*)(L + FQ_QD + par * 17408);
#pragma unroll
              for (int vt = 0; vt < 4; ++vt) { const f32x4v d = o[vt]; v2u w; w.x = pk2(d[0], d[1]); w.y = pk2(d[2], d[3]); *(LAS v2u*)(OT + (16 * ib + r) * 136 + 64 * vh + 16 * vt + 4 * q) = w; }
              LBAR();
              const size_t rb = (size_t)b * T + (size_t)(cbeg + c) * 64;
#pragma unroll
              for (int i_ = 0; i_ < 2; ++i_) *(v4u*)(OB + (rb + prow0 + 32 * i_) * D + h * 128 + 8 * pc) = *(const LAS v4u*)(OT + (prow0 + 32 * i_) * 136 + 8 * pc); }
          }
        }
#undef HF_LOAD
#undef HF_STAGE
        { float* se = (float*)(ws + WS_SEND) + (size_t)task * 16384;
#pragma unroll
          for (int k2 = 0; k2 < 2; ++k2)
#pragma unroll
              for (int vt = 0; vt < 4; ++vt) *(f32x4v*)(se + (64 * vh + 16 * vt + r) * 128 + (2 * ib + k2) * 16 + 4 * q) = S[k2][vt];
          if (wave < 2) ((float*)(ws + WS_GSEG))[(size_t)task * 128 + tid] = gprod; }
    }
}
__device__ __forceinline__ void ph_hgrn_post2(Frame& F, unsigned char* ws) {
    LAS unsigned char* L = F.lds; const int tid = F.tid, lane = F.lane, wave = F.wave, r = lane & 15, q = lane >> 4, ib = wave >> 1, vh = wave & 1;
    const bf16* P = F.PROJ; const bf16* OB = (const bf16*)(ws + WS_OB); const float* gam = (const float*)(ws + WS_GAM);
    LAS bf16* SI = (LAS bf16*)L; LAS float* XS = (LAS float*)(L + 140288);
    f32x4v cw[4];
#pragma unroll
    for (int vt = 0; vt < 4; ++vt) cw[vt] = *(const f32x4v*)(F.c_norm_w + 64 * vh + 16 * vt + 4 * q);
    const int prow0 = tid >> 4, pc = tid & 15;
    for (int task = blockIdx.x; task < NB * 8 * HG_NSEG; task += F.G) {
        const int seg = task % HG_NSEG, bh = task / HG_NSEG, h = bh & 7, b = bh >> 3, cbeg = seg * HG_CPS;
        LBAR();
        for (int u = tid; u < 128 * 32; u += NTHR) { const int v = u >> 5, k4 = (u & 31) * 4; f32x4v acc = {0.f, 0.f, 0.f, 0.f};
            for (int s1 = 0; s1 < seg; ++s1) { const size_t tk = (size_t)(bh * HG_NSEG + s1);
                const f32x4v gm = *(const f32x4v*)((const float*)(ws + WS_GSEG) + tk * 128 + k4), se = *(const f32x4v*)((const float*)(ws + WS_SEND) + tk * 16384 + v * 128 + k4); acc = acc * gm + se; }
            v2u w; w.x = pk2(acc[0], acc[1]); w.y = pk2(acc[2], acc[3]); *(LAS v2u*)(SI + v * 136 + k4) = w; }
        v4u rqA[2], roA[2], rtA[2]; f32x4v ggA[2], gr0 = {1.f, 1.f, 1.f, 1.f}, gr1 = gr0;
#pragma unroll
        for (int i = 0; i < 2; ++i) rqA[i] = (v4u){0u, 0u, 0u, 0u};
#define P2_LOAD(c_, rq, ro, rt, gg) do { const size_t rb_ = (size_t)b * T + (size_t)(cbeg + (c_)) * 64; \
            _Pragma("unroll") for (int i_ = 0; i_ < 2; ++i_) { const size_t row_ = rb_ + prow0 + 32 * i_; if (seg > 0) rq[i_] = *(const v4u*)(P + row_ * P1LD + h * 128 + 8 * pc); \
                ro[i_] = *(const v4u*)(OB + row_ * D + h * 128 + 8 * pc); rt[i_] = *(const v4u*)(P + row_ * P1LD + 3072 + h * 128 + 8 * pc); } \
            if (seg > 0) { const float* g_ = gam + ((size_t)b * 128 + cbeg + (c_)) * 1024 + h * 128 + 8 * pc; gg[0] = *(const f32x4v*)g_; gg[1] = *(const f32x4v*)(g_ + 4); } } while (0)
#define P2_STAGE(bufi, rq, ro, rt, gg) do { \
            _Pragma("unroll") for (int i_ = 0; i_ < 2; ++i_) { const int o_ = (prow0 + 32 * i_) * 136 + 8 * pc; v4u w_ = rq[i_]; \
                if (seg > 0) { w_.x = pk2(bflo(w_.x) * gr0[0], bfhi(w_.x) * gr0[1]); w_.y = pk2(bflo(w_.y) * gr0[2], bfhi(w_.y) * gr0[3]); w_.z = pk2(bflo(w_.z) * gr1[0], bfhi(w_.z) * gr1[1]); w_.w = pk2(bflo(w_.w) * gr1[2], bfhi(w_.w) * gr1[3]); } \
                *(LAS v4u*)((LAS bf16*)(L + 34816 + (bufi) * 17408) + o_) = w_; \
                *(LAS v4u*)((LAS bf16*)(L + 69632 + (bufi) * 17408) + o_) = ro[i_]; *(LAS v4u*)((LAS bf16*)(L + 104448 + (bufi) * 17408) + o_) = rt[i_]; } \
            if (seg > 0) { gr0 = gr0 * gg[0]; gr1 = gr1 * gg[1]; } } while (0)
        P2_LOAD(0, rqA, roA, rtA, ggA);
        P2_STAGE(0, rqA, roA, rtA, ggA); P2_LOAD(1, rqA, roA, rtA, ggA);
        LBAR();
#pragma unroll 1
        for (int c2 = 0; c2 < HG_CPS; c2 += 2) {
#pragma unroll
          for (int par = 0; par < 2; ++par) { const int c = c2 + par;
            if (c + 1 < HG_CPS) { P2_STAGE(par ^ 1, rqA, roA, rtA, ggA); if (c + 2 < HG_CPS) P2_LOAD(c + 2, rqA, roA, rtA, ggA); }
            const LAS bf16* TQ = (const LAS bf16*)(L + 34816 + par * 17408); LAS bf16* TO = (LAS bf16*)(L + 69632 + par * 17408); const LAS bf16* TG = (const LAS bf16*)(L + 104448 + par * 17408);
            v2u ovr[4]; bf16x8 bq_[4], sif[4][4];
#pragma unroll
            for (int vt = 0; vt < 4; ++vt) ovr[vt] = *(const LAS v2u*)(TO + (16 * ib + r) * 136 + 64 * vh + 16 * vt + 4 * q);
            if (seg > 0) {
#pragma unroll
                for (int s = 0; s < 4; ++s) bq_[s] = *(const LAS bf16x8*)(TQ + (16 * ib + r) * 136 + 32 * s + 8 * q);
#pragma unroll
                for (int vt = 0; vt < 4; ++vt)
#pragma unroll
                    for (int s = 0; s < 4; ++s) sif[vt][s] = *(const LAS bf16x8*)(SI + (64 * vh + 16 * vt + r) * 136 + 32 * s + 8 * q); }
            __builtin_amdgcn_sched_barrier(0);
            f32x4v o_[4];
#pragma unroll
            for (int vt = 0; vt < 4; ++vt) o_[vt] = (f32x4v){bflo(ovr[vt].x), bfhi(ovr[vt].x), bflo(ovr[vt].y), bfhi(ovr[vt].y)};
            if (seg > 0) {
#pragma unroll
                for (int vt = 0; vt < 4; ++vt) { f32x4v d_ = o_[vt];
#pragma unroll
                    for (int s = 0; s < 4; ++s) d_ = __builtin_amdgcn_mfma_f32_16x16x32_bf16(sif[vt][s], bq_[s], d_, 0, 0, 0);
                    o_[vt] = d_; } }
            float ss_ = 0.f;
#pragma unroll
            for (int vt = 0; vt < 4; ++vt) ss_ += (o_[vt][0] * o_[vt][0] + o_[vt][1] * o_[vt][1]) + (o_[vt][2] * o_[vt][2] + o_[vt][3] * o_[vt][3]);
            ss_ += __shfl_xor(ss_, 16); ss_ += __shfl_xor(ss_, 32);
            if (q == 0) XS[par * 128 + ib * 32 + vh * 16 + r] = ss_;
            LBAR();
            const float rs_ = __builtin_amdgcn_rsqf((XS[par * 128 + ib * 32 + r] + XS[par * 128 + ib * 32 + 16 + r]) * (1.f / 128.f) + 1e-6f);
#pragma unroll
            for (int vt = 0; vt < 4; ++vt) { const int off_ = (16 * ib + r) * 136 + 64 * vh + 16 * vt + 4 * q; const v2u tv = *(const LAS v2u*)(TG + off_);
                const float g0_ = bflo(tv.x), g1_ = bfhi(tv.x), g2_ = bflo(tv.y), g3_ = bfhi(tv.y); v2u w_;
                w_.x = pk2(o_[vt][0] * rs_ * cw[vt][0] * siluf_(g0_), o_[vt][1] * rs_ * cw[vt][1] * siluf_(g1_)); w_.y = pk2(o_[vt][2] * rs_ * cw[vt][2] * siluf_(g2_), o_[vt][3] * rs_ * cw[vt][3] * siluf_(g3_));
                *(LAS v2u*)(TO + off_) = w_; }
            LBAR();
            { const size_t rb_ = (size_t)b * T + (size_t)(cbeg + c) * 64;
#pragma unroll
              for (int i_ = 0; i_ < 2; ++i_) *(v4u*)(F.HB + (rb_ + prow0 + 32 * i_) * D + h * 128 + 8 * pc) = *(const LAS v4u*)(TO + (prow0 + 32 * i_) * 136 + 8 * pc); }
          }
        }
#undef P2_LOAD
#undef P2_STAGE
    }
}
__device__ __forceinline__ void ph_hgrn_post(Frame& F, unsigned char* ws) {
    const int gw = F.vcu * NWAVES + F.wave, NGW = F.G * NWAVES, lane = F.lane;
    const bf16* OB = (const bf16*)(ws + WS_OB); const float* SSQ = (const float*)(ws + WS_SSQ); const bf16* P = F.PROJ;
    const int hd = lane >> 3, c0 = 16 * lane;
    f32x4v cw[4];
#pragma unroll
    for (int i = 0; i < 4; ++i) cw[i] = *(const f32x4v*)(F.c_norm_w + (c0 & 127) + 4 * i);
    v4u a0[6], a1[6], b0[6], b1[6];
#define POST_LD(v, mm) do { if ((mm) < M) { const v4u* s_ = (const v4u*)(SSQ + ((size_t)(mm) * 8 + hd) * 8); v[0] = s_[0]; v[1] = s_[1]; \
        const v4u* o_ = (const v4u*)(OB + (size_t)(mm) * D + c0); v[2] = o_[0]; v[3] = o_[1]; const v4u* g_ = (const v4u*)(P + (size_t)(mm) * P1LD + 3072 + c0); v[4] = g_[0]; v[5] = g_[1]; } } while (0)
#define POST_PR(v, mm) do { if ((mm) < M) { const f32x4v s0_ = __builtin_bit_cast(f32x4v, v[0]), s1_ = __builtin_bit_cast(f32x4v, v[1]); \
        const float rs_ = __builtin_amdgcn_rsqf(((s0_[0] + s0_[1]) + (s0_[2] + s0_[3]) + (s1_[0] + s1_[1]) + (s1_[2] + s1_[3])) * (1.f / 128.f) + 1e-6f); \
        _Pragma("unroll") for (int i = 0; i < 2; ++i) { const v4u ow_ = v[2 + i], gw_ = v[4 + i]; v4u res_; \
            _Pragma("unroll") for (int e = 0; e < 4; ++e) { const float w0_ = cw[2 * i + (e >> 1)][2 * (e & 1)], w1_ = cw[2 * i + (e >> 1)][2 * (e & 1) + 1]; \
                res_[e] = pk2(bflo(ow_[e]) * rs_ * w0_ * siluf_(bflo(gw_[e])), bfhi(ow_[e]) * rs_ * w1_ * siluf_(bfhi(gw_[e]))); } \
            *(v4u*)(F.HB + (size_t)(mm) * D + c0 + 8 * i) = res_; } } } while (0)
    int m = gw; POST_LD(a0, m); POST_LD(a1, m + NGW);
#pragma unroll 1
    for (; m < M; m += 4 * NGW) {
        POST_LD(b0, m + 2 * NGW); POST_LD(b1, m + 3 * NGW);
        POST_PR(a0, m); POST_PR(a1, m + NGW);
        POST_LD(a0, m + 4 * NGW); POST_LD(a1, m + 5 * NGW);
        POST_PR(b0, m + 2 * NGW); POST_PR(b1, m + 3 * NGW);
    }
#undef POST_LD
#undef POST_PR
}
#ifndef MK_PER_PHASE
#define MK_PER_PHASE 0
#endif
#ifndef RWKV_NAIVE
#define RWKV_NAIVE 0
#endif
#ifndef HGRN_NAIVE
#define HGRN_NAIVE 0
#endif
constexpr int N_PHASES = 13;
struct Args { const float* in[23]; float* out; unsigned char* ws; int ph_lo, ph_hi; };
__global__ void __launch_bounds__(NTHR, 2) fwd_kernel(Args args) {
    extern __shared__ __attribute__((aligned(16))) unsigned char lds[];
    Frame F;
    F.lds = (LAS unsigned char*)lds;
    F.tid = threadIdx.x; F.lane = F.tid & 63; F.wave = __builtin_amdgcn_readfirstlane(F.tid >> 6);
    F.G = gridDim.x; { const int bx = blockIdx.x; F.vcu = (F.G % 8 == 0) ? (bx % 8) * (F.G / 8) + bx / 8 : bx; }
    unsigned char* ws = args.ws;
    F.x = args.in[0]; F.rel_bias = args.in[1]; F.lower_bounds = args.in[2]; F.pre0 = args.in[3]; F.post0 = args.in[4]; F.w_in0 = args.in[5]; F.w_out0 = args.in[6];
    F.a_mu = args.in[7]; F.a_w0 = args.in[8]; F.a_w2 = args.in[9]; F.a_a0 = args.in[10]; F.a_a2 = args.in[11]; F.a_k_k = args.in[12]; F.a_k_a = args.in[13]; F.a_r_k = args.in[14];
    F.a_ln_w = args.in[15]; F.a_ln_b = args.in[16]; F.sinks = args.in[17]; F.pre1 = args.in[18]; F.post1 = args.in[19]; F.w_in1 = args.in[20]; F.w_out1 = args.in[21]; F.c_norm_w = args.in[22];
    F.out = args.out;
    F.W0T = (bf16*)(ws + WS_W0T); F.WO0T = (bf16*)(ws + WS_WO0T); F.W1T = (bf16*)(ws + WS_W1T); F.WO1T = (bf16*)(ws + WS_WO1T);
    F.HA = (bf16*)(ws + WS_HA); F.HB = (bf16*)(ws + WS_HB); F.PROJ = (bf16*)(ws + WS_PROJ); F.Y = (bf16*)(ws + WS_Y);
    F.bias_tab = (float*)(ws + WS_TAB); F.lb_tab = (float*)(ws + WS_TAB + 4096);
    for (int u = F.tid; u < (LDS_BYTES - LDSCTL_OFF) / 4; u += NTHR) ((LAS unsigned*)(F.lds + LDSCTL_OFF))[u] = 0u;
    __syncthreads();
    const int lo = args.ph_lo, hi = args.ph_hi;
    XcdBarrier bar; bar.bar = (unsigned*)(ws + WS_CTL) + CW_BAR; bar.x = 0; bar.st = nullptr;
    if (hi - lo > 1) bar = xcd_barrier_post((unsigned*)(ws + WS_CTL) + CW_BAR, (volatile LAS unsigned*)(F.lds + MISC_OFF) + 8);
#define IN(k) (lo <= (k) && (k) < hi)
#define SEAM(k) do { if (IN(k) && IN((k) + 1)) xcd_barrier(bar); } while (0)
    if (IN(0)) { ph_prologue(F, ws); } SEAM(0);
    if (IN(1)) { pg8::Gemm g{F.HA, F.W0T, M, N0P, D}; pg8::StaticOrder S; S.init(M, N0P, F.G, (int)blockIdx.x); pg8::EpiBf16 E{F.PROJ, P0LD};
        pg8::gemm_phase<pg8::EpiBf16, pg8::StaticOrder, true, true>(F.lds, g, S, E); } SEAM(1);
#if RWKV_NAIVE
    if (IN(2)) { ph_attention(F); __syncthreads(); ph_rwkv_naive(F); } SEAM(2);
    SEAM(3);
    SEAM(4);
#else
    if (IN(2)) { ph_attention(F); __syncthreads(); ph_rwkv_passA(F, ws); } SEAM(2);
    if (IN(3)) { ph_rwkv_passB(F, ws); } SEAM(3);
    if (IN(4)) { ph_rwkv_passC(F, ws); } SEAM(4);
#endif
    if (IN(5)) { pg8::Gemm g{F.HB, F.WO0T, M, D, D}; pg8::StaticOrder S; S.init(M, D, F.G, (int)blockIdx.x); pg8::EpiBf16 E{F.Y, D};
        pg8::gemm_phase<pg8::EpiBf16, pg8::StaticOrder, true, true>(F.lds, g, S, E); } SEAM(5);
    if (IN(6)) { ph_resnorm0(F, F.x, F.Y, F.post0, F.pre1, F.HA); } SEAM(6);
    if (IN(7)) { pg8::Gemm g{F.HA, F.W1T, M, N1, D}; pg8::StaticOrder S; S.init(M, N1, F.G, (int)blockIdx.x); pg8::EpiBf16 E{F.PROJ, P1LD};
        pg8::gemm_phase<pg8::EpiBf16, pg8::StaticOrder, true, true>(F.lds, g, S, E); } SEAM(7);
#if HGRN_NAIVE
    if (IN(8)) { ph_hgrn_naive(F); } SEAM(8);
    SEAM(9);
    SEAM(10);
#else
    if (IN(8)) { ph_hgrn_prep(F, ws); } SEAM(8);
    if (IN(9)) { ph_hgrn_fat(F, ws); } SEAM(9);
    if (IN(10)) { ph_hgrn_post2(F, ws); } SEAM(10);
#endif
    if (IN(11)) { pg8::Gemm g{F.HB, F.WO1T, M, D, D}; pg8::StaticOrder S; S.init(M, D, F.G, (int)blockIdx.x); pg8::EpiBf16 E{F.HA, D};
        pg8::gemm_phase<pg8::EpiBf16, pg8::StaticOrder, true, true>(F.lds, g, S, E); } SEAM(11);
    if (IN(12)) { ph_resnorm1(F, F.Y, F.HA, F.post1, F.out); }
#undef IN
#undef SEAM
}

extern "C" void kernel_launch(void* const* d_in, const int* in_sizes, int n_in, void* d_out, int out_size, void* d_ws, size_t ws_size, hipStream_t stream) {
    static int grid = 0;
    if (grid == 0) {
        if (n_in != 23 || in_sizes[0] != M * D || out_size != M * D || ws_size < WS_END) { fprintf(stderr, "kernel_launch: unexpected shapes (n_in %d, in0 %d, out %d, ws %zu); nothing launched\n", n_in, n_in > 0 ? in_sizes[0] : -1, out_size, ws_size); grid = -1; return; }
        int dev = 0, cus = 0, per_cu = 0;
        if (hipGetDevice(&dev) != hipSuccess || hipDeviceGetAttribute(&cus, hipDeviceAttributeMultiprocessorCount, dev) != hipSuccess) { grid = -1; return; }
        if (hipFuncSetAttribute((const void*)fwd_kernel, hipFuncAttributeMaxDynamicSharedMemorySize, LDS_BYTES) != hipSuccess) { fprintf(stderr, "kernel_launch: hipFuncSetAttribute failed\n"); grid = -1; return; }
        if (hipOccupancyMaxActiveBlocksPerMultiprocessor(&per_cu, (const void*)fwd_kernel, NTHR, LDS_BYTES) != hipSuccess || per_cu < 1) { fprintf(stderr, "kernel_launch: occupancy query says %d blocks per CU\n", per_cu); (void)hipGetLastError(); grid = -1; return; }
        grid = cus;
    }
    if (grid < 0) return;
    (void)hipMemsetAsync((char*)d_ws + WS_CTL, 0, CTL_ZERO_BYTES, stream);
    Args a{};
    for (int i = 0; i < 23; ++i) a.in[i] = (const float*)d_in[i];
    a.out = (float*)d_out; a.ws = (unsigned char*)d_ws;
#if MK_PER_PHASE
    for (int p = 0; p < N_PHASES; ++p) { a.ph_lo = p; a.ph_hi = p + 1; hipLaunchKernelGGL(fwd_kernel, dim3(grid), dim3(NTHR), LDS_BYTES, stream, a); }
#else
    a.ph_lo = 0; a.ph_hi = N_PHASES; hipLaunchKernelGGL(fwd_kernel, dim3(grid), dim3(NTHR), LDS_BYTES, stream, a);
#endif
}
```

```cpp
#include <hip/hip_runtime.h>
#include <cstdio>
#include <cstdint>
namespace pg8 {
#define PG8_LAS __attribute__((address_space(3)))
typedef unsigned short bf16_t;
typedef short bf16x8 __attribute__((ext_vector_type(8)));
typedef float f32x4 __attribute__((ext_vector_type(4)));
typedef unsigned u32x4 __attribute__((ext_vector_type(4)));
constexpr int BM = 256, BK = 64, HALF = 128, HTB = HALF * BK * 2  , STAGE_BYTES = 8 * HTB, NXCD = 8, WGM = 8;

__host__ __device__ __forceinline__ int lds_byte(int r, int c) { const int st = (r >> 4) * 2 + (c >> 5), rr = r & 15, cc = c & 31, ob = rr * 64 + cc * 2; return st * 1024 + (ob ^ (((ob >> 9) & 1) << 5)); }
__host__ __device__ __forceinline__ void stage_rc(int b, int& R, int& C) { const int st = b / 1024, sb = b % 1024, swz = sb ^ (((sb >> 9) & 1) << 5); R = (st >> 1) * 16 + swz / 64; C = (st & 1) * 32 + (swz % 64) / 2; }
__host__ __device__ __forceinline__ int perm32(int rho) { const int n = rho >> 4, i = rho & 15; return 8 * (i >> 2) + 4 * n + (i & 3); }

struct Unit { int pm, pn; };
struct Gemm { const bf16_t* A; const bf16_t* Bt; int M, N, K; };

struct StaticOrder {
    int nM, nN, nwg, G, c;
    __host__ __device__ void init(int M, int N, int G_, int c_) { nM = M / BM; nN = N / BM; nwg = nM * nN; G = G_; c = c_; }
    __host__ __device__ bool next(int i, Unit& u) const {
        const long L = (long)i * G + c; if (L >= nwg) return false;
        int wgid = (int)L; { const int q = nwg / NXCD, r = nwg % NXCD, xcd = wgid % NXCD, off = wgid / NXCD; wgid = (xcd < r ? xcd * (q + 1) : r * (q + 1) + (xcd - r) * q) + off; }
        const int nig = WGM * nN, gid = wgid / nig, fm = gid * WGM, gsz = (nM - fm) < WGM ? (nM - fm) : WGM;
        u.pm = fm + ((wgid % nig) % gsz); u.pn = (wgid % nig) / gsz; return true;
    }
    __device__ __forceinline__ void a_ready(const Unit&) const {}
    __device__ __forceinline__ void done(const Unit&) const {}
};

__device__ __forceinline__ unsigned cvt_pk_bf16(float lo, float hi) { unsigned r; asm volatile("v_cvt_pk_bf16_f32 %0, %1, %2" : "=v"(r) : "v"(lo), "v"(hi)); return r; }
struct EpiBf16 {
    static constexpr bool PERM = true, AFTER_DRAIN = false;
    bf16_t* O; int ldc;
    __device__ __forceinline__ void operator()(const f32x4 (&acc)[2][2][4][2], const Unit& u, int wr, int wc, int fr, int fq) const {
        const int row0 = u.pm * BM + wr * 64 + fr; const int col0 = u.pn * BM + wc * 32 + 8 * fq;
#pragma unroll
        for (int ai = 0; ai < 2; ++ai)
#pragma unroll
            for (int m = 0; m < 4; ++m) { bf16_t* rowp = O + (size_t)(row0 + ai * HALF + m * 16) * ldc + col0;
#pragma unroll
                for (int bj = 0; bj < 2; ++bj) { const f32x4 v0 = acc[ai][bj][m][0], v1 = acc[ai][bj][m][1];
                    u32x4 w; w.x = cvt_pk_bf16(v0[0], v0[1]); w.y = cvt_pk_bf16(v0[2], v0[3]); w.z = cvt_pk_bf16(v1[0], v1[1]); w.w = cvt_pk_bf16(v1[2], v1[3]);
                    *(u32x4*)(rowp + bj * HALF) = w; } }
    }
};

template <class Epi, class Sched, bool ALIGN_EPI = false, bool SP2 = false>
__device__ __forceinline__ void gemm_phase(PG8_LAS unsigned char* lds, const Gemm g, const Sched& S, const Epi& E) {
    const int tid = threadIdx.x, wid = __builtin_amdgcn_readfirstlane(tid >> 6), lane = tid & 63, wr = wid >> 2, wc = wid & 3, fr = lane & 15, fq = lane >> 4;
    const int K = g.K, nt = K / BK;
    unsigned voffA[2], voffB[2];
#pragma unroll
    for (int i = 0; i < 2; ++i) { int R, C; stage_rc(tid * 16 + i * 8192, R, C); const int Rb = Epi::PERM ? ((R & ~31) + perm32(R & 31)) : R;
        voffA[i] = (unsigned)(R * K + C) * 2u; voffB[i] = (unsigned)(Rb * K + C) * 2u; }
    const size_t kstep = (size_t)(BK * 2);
    const size_t hstep = (size_t)HALF * K * 2;
    const size_t tstep = 2 * hstep;
    const unsigned ldsw = (unsigned)wid * 1024u;
    const int aoff = lds_byte(wr * 64 + fr, fq * 8), boff = lds_byte(wc * 32 + fr, fq * 8);
#define PG8_SA(b, h) (((b) * 2 + (h)) * HTB)
#define PG8_SB(b, h) ((4 + (b) * 2 + (h)) * HTB)
#define PG8_STAGE(bufoff, gbase, voff) do { _Pragma("unroll") for (int _i = 0; _i < 2; ++_i) \
        __builtin_amdgcn_global_load_lds((const unsigned*)((const char*)(gbase) + (voff)[_i]), (PG8_LAS unsigned*)(lds + (bufoff) + ldsw + _i * 8192), 16, 0, 0); } while (0)
#define PG8_LDA(dst, b, h) do { _Pragma("unroll") for (int m = 0; m < 4; ++m) _Pragma("unroll") for (int k = 0; k < 2; ++k) dst[m][k] = *(const PG8_LAS bf16x8*)(lds + PG8_SA(b, h) + aoff + m * 2048 + k * 1024); } while (0)
#define PG8_LDB(dst, b, h) do { _Pragma("unroll") for (int n = 0; n < 2; ++n) _Pragma("unroll") for (int k = 0; k < 2; ++k) dst[n][k] = *(const PG8_LAS bf16x8*)(lds + PG8_SB(b, h) + boff + n * 2048 + k * 1024); } while (0)
#define PG8_MMA(ai, bj, At, Bt) do { __builtin_amdgcn_s_setprio(1); _Pragma("unroll") for (int m = 0; m < 4; ++m) _Pragma("unroll") for (int n = 0; n < 2; ++n) _Pragma("unroll") for (int k = 0; k < 2; ++k) \
        acc[ai][bj][m][n] = __builtin_amdgcn_mfma_f32_16x16x32_bf16(Bt[n][k], At[m][k], acc[ai][bj][m][n], 0, 0, 0); __builtin_amdgcn_s_setprio(0); } while (0)
#define PG8_WAIT_V(n) asm volatile("s_waitcnt vmcnt(" #n ")" ::: "memory")
#define PG8_WAIT_L(n) asm volatile("s_waitcnt lgkmcnt(" #n ")" ::: "memory")
#define PG8_BAR __builtin_amdgcn_s_barrier()
#define PG8_SCHED __builtin_amdgcn_sched_barrier(0)
    Unit cur, nxt; int ui = 0;
    if (!S.next(0, cur)) return;
    f32x4 acc[2][2][4][2];
#pragma unroll
    for (int a = 0; a < 2; ++a)
#pragma unroll
        for (int b = 0; b < 2; ++b)
#pragma unroll
            for (int m = 0; m < 4; ++m)
#pragma unroll
                for (int n = 0; n < 2; ++n) acc[a][b][m][n] = (f32x4){0.f, 0.f, 0.f, 0.f};
    bf16x8 At[4][2], B0[2][2], B1[2][2];
    const char* cA = (const char*)g.A + (size_t)cur.pm * tstep; const char* cB = (const char*)g.Bt + (size_t)cur.pn * tstep;
    S.a_ready(cur);
    if constexpr (SP2) {
        PG8_STAGE(PG8_SB(0, 0), cB, voffB); PG8_STAGE(PG8_SB(0, 1), cB + hstep, voffB); PG8_STAGE(PG8_SA(0, 0), cA, voffA); PG8_STAGE(PG8_SA(0, 1), cA + hstep, voffA);
        if (wr == 1) PG8_BAR;
        PG8_WAIT_V(2); PG8_BAR;
        PG8_STAGE(PG8_SB(1, 0), cB + kstep, voffB); PG8_STAGE(PG8_SA(1, 0), cA + kstep, voffA); PG8_STAGE(PG8_SB(1, 1), cB + hstep + kstep, voffB);
        PG8_WAIT_V(6); PG8_BAR;
    } else {
        PG8_STAGE(PG8_SB(0, 0), cB, voffB); PG8_STAGE(PG8_SA(0, 0), cA, voffA); PG8_STAGE(PG8_SB(0, 1), cB + hstep, voffB); PG8_STAGE(PG8_SA(0, 1), cA + hstep, voffA);
        if (wr == 1) PG8_BAR;
        PG8_WAIT_V(4); PG8_BAR;
        PG8_STAGE(PG8_SB(1, 0), cB + kstep, voffB); PG8_STAGE(PG8_SA(1, 0), cA + kstep, voffA); PG8_STAGE(PG8_SB(1, 1), cB + hstep + kstep, voffB);
        PG8_WAIT_V(6); PG8_BAR;
    }
    for (;;) {
        const bool has_next = S.next(ui + 1, nxt);
        const char* nA = has_next ? (const char*)g.A + (size_t)nxt.pm * tstep : cA; const char* nB = has_next ? (const char*)g.Bt + (size_t)nxt.pn * tstep : cB;
        for (int t = 0; t < nt; t += 2) {
            const bool last = (t == nt - 2);
            const char* a1 = cA + (size_t)(t + 1) * kstep;
            const char* a2 = last ? nA : cA + (size_t)(t + 2) * kstep; const char* b2 = last ? nB : cB + (size_t)(t + 2) * kstep;
            const char* a3 = a2 + kstep; const char* b3 = b2 + kstep;
            if (last && has_next) S.a_ready(nxt);
            if constexpr (SP2) {
            PG8_LDB(B0, 0, 0); PG8_LDB(B1, 0, 1); PG8_SCHED; PG8_LDA(At, 0, 0); PG8_STAGE(PG8_SA(1, 1), a1 + hstep, voffA);
            PG8_WAIT_V(8); PG8_WAIT_L(0); PG8_BAR; PG8_MMA(0, 0, At, B0); PG8_MMA(0, 1, At, B1); PG8_BAR; PG8_SCHED;
            PG8_LDA(At, 0, 1); PG8_STAGE(PG8_SB(0, 0), b2, voffB); PG8_STAGE(PG8_SB(0, 1), b2 + hstep, voffB); PG8_STAGE(PG8_SA(0, 0), a2, voffA);
            PG8_WAIT_V(8); PG8_WAIT_L(0); PG8_BAR; PG8_MMA(1, 0, At, B0); PG8_MMA(1, 1, At, B1); PG8_BAR; PG8_SCHED;
            PG8_LDB(B0, 1, 0); PG8_LDB(B1, 1, 1); PG8_SCHED; PG8_LDA(At, 1, 0); PG8_STAGE(PG8_SA(0, 1), a2 + hstep, voffA);
            PG8_WAIT_V(8); PG8_WAIT_L(0); PG8_BAR; PG8_MMA(0, 0, At, B0); PG8_MMA(0, 1, At, B1); PG8_BAR; PG8_SCHED;
            PG8_LDA(At, 1, 1); PG8_STAGE(PG8_SB(1, 0), b3, voffB); PG8_STAGE(PG8_SB(1, 1), b3 + hstep, voffB); PG8_STAGE(PG8_SA(1, 0), a3, voffA);
            PG8_WAIT_V(8); PG8_WAIT_L(0); PG8_BAR; PG8_MMA(1, 0, At, B0); PG8_MMA(1, 1, At, B1); PG8_BAR; PG8_SCHED;
            } else {
            PG8_LDB(B0, 0, 0); PG8_SCHED; PG8_LDA(At, 0, 0); PG8_STAGE(PG8_SA(1, 1), a1 + hstep, voffA);
            PG8_WAIT_L(8); PG8_BAR; PG8_WAIT_L(0); PG8_MMA(0, 0, At, B0); PG8_BAR; PG8_SCHED;
            PG8_LDB(B1, 0, 1); PG8_STAGE(PG8_SB(0, 0), b2, voffB);
            PG8_BAR; PG8_WAIT_L(0); PG8_MMA(0, 1, At, B1); PG8_BAR;
            PG8_LDA(At, 0, 1); PG8_STAGE(PG8_SA(0, 0), a2, voffA);
            PG8_BAR; PG8_WAIT_L(0); PG8_MMA(1, 0, At, B0); PG8_BAR; PG8_SCHED;
            PG8_STAGE(PG8_SB(0, 1), b2 + hstep, voffB);
            PG8_WAIT_V(6); PG8_BAR; PG8_MMA(1, 1, At, B1); PG8_BAR;
            PG8_LDB(B0, 1, 0); PG8_SCHED; PG8_LDA(At, 1, 0); PG8_STAGE(PG8_SA(0, 1), a2 + hstep, voffA);
            PG8_WAIT_L(8); PG8_BAR; PG8_WAIT_L(0); PG8_MMA(0, 0, At, B0); PG8_BAR; PG8_SCHED;
            PG8_LDB(B1, 1, 1); PG8_STAGE(PG8_SB(1, 0), b3, voffB);
            PG8_BAR; PG8_WAIT_L(0); PG8_MMA(0, 1, At, B1); PG8_BAR;
            PG8_LDA(At, 1, 1); PG8_STAGE(PG8_SA(1, 0), a3, voffA);
            PG8_BAR; PG8_WAIT_L(0); PG8_MMA(1, 0, At, B0); PG8_BAR; PG8_SCHED;
            PG8_STAGE(PG8_SB(1, 1), b3 + hstep, voffB);
            PG8_WAIT_V(6); PG8_BAR; PG8_MMA(1, 1, At, B1); PG8_BAR;
            }
        }
        if constexpr (ALIGN_EPI) { if (wr == 0) PG8_BAR; }
        if constexpr (!Epi::AFTER_DRAIN) { E(acc, cur, wr, wc, fr, fq); S.done(cur); }
        if (!has_next) break;
#pragma unroll
        for (int a = 0; a < 2; ++a)
#pragma unroll
            for (int b = 0; b < 2; ++b)
#pragma unroll
                for (int m = 0; m < 4; ++m)
#pragma unroll
                    for (int n = 0; n < 2; ++n) acc[a][b][m][n] = (f32x4){0.f, 0.f, 0.f, 0.f};
        cur = nxt; cA = nA; cB = nB; ++ui;
        if constexpr (ALIGN_EPI) { if (wr == 1) PG8_BAR; }
    }
    PG8_WAIT_V(0);
    if constexpr (!ALIGN_EPI) { if (wr == 0) PG8_BAR; }
    PG8_BAR;
    if constexpr (Epi::AFTER_DRAIN) { E.fused(acc, cur, wr, wc, fr, fq, lds, wid, lane); S.done(cur); }
#undef PG8_SA
#undef PG8_SB
#undef PG8_STAGE
#undef PG8_LDA
#undef PG8_LDB
#undef PG8_MMA
#undef PG8_WAIT_V
#undef PG8_WAIT_L
#undef PG8_BAR
#undef PG8_SCHED
}
}
constexpr int NWAVES = 8, NTHR = 512;
constexpr int NB = 8, T = 8192, D = 1024, M = NB * T;
constexpr int N0 = 3392, N0P = 3584, N1 = 4096;
constexpr int C_R = 0, C_K = 512, C_V = 1024, C_WL = 1536, C_AL = 1568, C_GA = 1600, C_QB = 2112, C_KB = 2624, C_VB = 2752, C_GB = 2880;
constexpr int P0LD = N0P, P1LD = N1;
constexpr size_t MiB = 1u << 20;
constexpr size_t WS_CTL = 0, CTL_ZERO_BYTES = 65536;
constexpr size_t WS_W0T = 2 * MiB, WS_WO0T = 10 * MiB, WS_W1T = 12 * MiB, WS_WO1T = 20 * MiB, WS_TAB = 23 * MiB;
constexpr size_t WS_HA = 32 * MiB, WS_HB = 160 * MiB, WS_PROJ = 288 * MiB, WS_Y = 800 * MiB, WS_END = 996 * MiB;
constexpr int CW_BAR = 4096;
constexpr int LDS_BYTES = 147456, LDSCTL_OFF = 143360, MISC_OFF = LDSCTL_OFF + 320;

#define GAS __attribute__((address_space(1)))
#define LAS __attribute__((address_space(3)))
typedef unsigned short bf16;
typedef unsigned v4u __attribute__((ext_vector_type(4)));
typedef unsigned v2u __attribute__((ext_vector_type(2)));
typedef float f32x4 __attribute__((ext_vector_type(4)));
typedef float f32x16 __attribute__((ext_vector_type(16)));
typedef short bf16x8 __attribute__((ext_vector_type(8)));
typedef GAS unsigned gu32;
#define RLX_AGENT __ATOMIC_RELAXED, __HIP_MEMORY_SCOPE_AGENT
typedef float f32x2_t __attribute__((ext_vector_type(2))); typedef __bf16 bf16x2_t __attribute__((ext_vector_type(2)));
__device__ __forceinline__ unsigned pk2(float lo, float hi) { const f32x2_t v = {lo, hi}; const bf16x2_t b = __builtin_convertvector(v, bf16x2_t); return __builtin_bit_cast(unsigned, b); }
__device__ __forceinline__ unsigned f2bf(float f) { return pk2(f, 0.f) & 0xffffu; }
__device__ __forceinline__ float bf2f(unsigned v) { return __uint_as_float(v << 16); }
__device__ __forceinline__ float bflo(unsigned w) { return __uint_as_float(w << 16); }
__device__ __forceinline__ float bfhi(unsigned w) { return __uint_as_float(w & 0xffff0000u); }
__device__ __forceinline__ float wave_sum(float v) {
#pragma unroll
    for (int o = 1; o < 64; o <<= 1) v += __shfl_xor(v, o);
    return v;
}
#define LBAR() do { asm volatile("s_waitcnt lgkmcnt(0)" ::: "memory"); __builtin_amdgcn_s_barrier(); asm volatile("" ::: "memory"); } while (0)
__device__ __forceinline__ void gstore8_nowait(void* p, v2u v) { asm volatile("global_store_dwordx2 %0, %1, off\n\ts_nop 1" :: "v"(p), "v"(v) : "memory"); }
__device__ __forceinline__ v4u gload16_asm(const void* p) { v4u r; asm volatile("global_load_dwordx4 %0, %1, off" : "=v"(r) : "v"(p)); return r; }
__device__ __forceinline__ float gload4_asm(const void* p) { float r; asm volatile("global_load_dword %0, %1, off" : "=v"(r) : "v"(p)); return r; }
__device__ __forceinline__ void gstore4_nowait(void* p, float v) { asm volatile("global_store_dword %0, %1, off\n\ts_nop 1" :: "v"(p), "v"(v)); }
__device__ __forceinline__ float frcp(float x) { return __builtin_amdgcn_rcpf(x); }
__device__ __forceinline__ float sigmoidf_(float x) { return frcp(1.0f + __expf(-x)); }
__device__ __forceinline__ float siluf_(float x) { return x * frcp(1.0f + __expf(-x)); }

#define XB_TMO      128
#define XB_XCNT(j)  (256  + 64 * (j))
#define XB_XSUB(j)  (1280 + 64 * (j))
#define XB_XGEN(j)  (2304 + 64 * (j))
#define XB_TOP      3328
#define XB_TOPGEN   3392
#define XCD_BAR_WORDS 3456
#define XB_SPIN_CAP (1u << 24)

__device__ __forceinline__ unsigned xb_ld(unsigned* p)              { return __hip_atomic_load(p, __ATOMIC_RELAXED, __HIP_MEMORY_SCOPE_AGENT); }
__device__ __forceinline__ unsigned xb_add(unsigned* p, unsigned v) { return __hip_atomic_fetch_add(p, v, __ATOMIC_RELAXED, __HIP_MEMORY_SCOPE_AGENT); }
__device__ __forceinline__ unsigned xb_xcc_id() { return (unsigned)__builtin_amdgcn_s_getreg((3 << 11) | 20) & 0xFu; }
#define XB_SPIN(cond, bar) do { unsigned _sp = 0; while (cond) { __builtin_amdgcn_s_sleep(1); \
    if ((++_sp & 255u) == 0u) { if (xb_ld(&(bar)[XB_TMO])) break; if (_sp > XB_SPIN_CAP) { atomicAdd(&(bar)[XB_TMO], 1u); break; } } } } while (0)

struct XcdBarrier {
    unsigned* bar; unsigned x;
    volatile LAS unsigned* st;
};

__device__ __forceinline__ XcdBarrier xcd_barrier_post(unsigned* bar, volatile LAS unsigned* st) {
    XcdBarrier b; b.bar = bar; b.x = xb_xcc_id(); b.st = st;
    if (threadIdx.x == 0) (void)xb_add(&bar[XB_XCNT(b.x)], 1u);
    return b;
}
__device__ __forceinline__ void xcd_barrier_complete(unsigned* bar, unsigned x, unsigned& nloc, unsigned& nx) {
    const unsigned G = gridDim.x * gridDim.y * gridDim.z;
    unsigned sum, cnt, mine, sp = 0u;
    for (;;) {
        sum = 0u; cnt = 0u; mine = 0u;
#pragma unroll
        for (unsigned j = 0; j < 16; ++j) { const unsigned c = xb_ld(&bar[XB_XCNT(j)]); sum += c; cnt += (c > 0u) ? 1u : 0u; mine = (j == x) ? c : mine; }
        if (sum == G) break;
        __builtin_amdgcn_s_sleep(1);
        if ((++sp & 255u) == 0u) { if (xb_ld(&bar[XB_TMO])) break; if (sp > XB_SPIN_CAP) { atomicAdd(&bar[XB_TMO], 1u); break; } }
    }
    nloc = mine > 0u ? mine : 1u; nx = cnt > 0u ? cnt : 1u;
}

__device__ __forceinline__ void xcd_barrier(const XcdBarrier& b) {
    asm volatile("s_waitcnt vmcnt(0)" ::: "memory");
    __syncthreads();
    if (threadIdx.x == 0) {
        unsigned* bar = b.bar;
        __builtin_amdgcn_s_waitcnt(0);
        unsigned nloc = b.st[0], nx = b.st[1];
        if (nloc == 0u) { xcd_barrier_complete(bar, b.x, nloc, nx); b.st[0] = nloc; b.st[1] = nx; }
        const unsigned old = xb_add(&bar[XB_XSUB(b.x)], 1u);
        const unsigned gen = old / nloc;
        if (old + 1u == (gen + 1u) * nloc) {
            __builtin_amdgcn_fence(__ATOMIC_RELEASE, "agent");
            asm volatile("s_waitcnt vmcnt(0)" ::: "memory");
            const unsigned og = xb_add(&bar[XB_TOP], 1u);
            const unsigned tg = og / nx;
            if (og + 1u == (tg + 1u) * nx) xb_add(&bar[XB_TOPGEN], 1u);
            else XB_SPIN(xb_ld(&bar[XB_TOPGEN]) == tg, bar);
            __builtin_amdgcn_fence(__ATOMIC_ACQUIRE, "agent");
            xb_add(&bar[XB_XGEN(b.x)], 1u);
            asm volatile("s_waitcnt vmcnt(0)" ::: "memory");
        } else {
            XB_SPIN(xb_ld(&bar[XB_XGEN(b.x)]) == gen, bar);
            __builtin_amdgcn_fence(__ATOMIC_ACQUIRE, "agent");
            asm volatile("s_waitcnt vmcnt(0)" ::: "memory");
        }
    }
    __syncthreads();
}
struct Frame {
    LAS unsigned char* lds;
    int tid, lane, wave, vcu, G;
    const float* x; float* out;
    const float *rel_bias, *lower_bounds, *pre0, *post0, *w_in0, *w_out0, *a_mu, *a_w0, *a_w2, *a_a0, *a_a2, *a_k_k, *a_k_a, *a_r_k, *a_ln_w, *a_ln_b, *sinks, *pre1, *post1, *w_in1, *w_out1, *c_norm_w;
    bf16 *W0T, *WO0T, *W1T, *WO1T, *HA, *HB, *PROJ, *Y;
    float *bias_tab, *lb_tab;
};

__device__ __forceinline__ void p0_transpose_item(const float* W, int K, int N, bf16* WT, LAS float* scr, int item, int lane) {
    const int nblk = N / 32, kb = item / nblk, nb = item % nblk, k0 = 64 * kb, n0 = 32 * nb;
#pragma unroll 8
    for (int i = 0; i < 32; ++i) { const int kk = 2 * i + (lane >> 5); scr[kk * 33 + (lane & 31)] = W[(size_t)(k0 + kk) * N + n0 + (lane & 31)]; }
    asm volatile("s_waitcnt lgkmcnt(0)" ::: "memory");
    const int c = lane & 7;
#pragma unroll
    for (int j = 0; j < 4; ++j) { const int n = (lane >> 3) + 8 * j; const LAS float* s = scr + (8 * c) * 33 + n;
        v4u o; o.x = pk2(s[0 * 33], s[1 * 33]); o.y = pk2(s[2 * 33], s[3 * 33]); o.z = pk2(s[4 * 33], s[5 * 33]); o.w = pk2(s[6 * 33], s[7 * 33]);
        *(v4u*)(WT + (size_t)(n0 + n) * K + k0 + 8 * c) = o; }
    asm volatile("s_waitcnt lgkmcnt(0)" ::: "memory");
}
__device__ __forceinline__ void rms_row_to_bf16(const float* xrow, const float* w, bf16* orow, int lane) {
    const f32x4* xr = (const f32x4*)xrow + lane; const f32x4* wr = (const f32x4*)w + lane;
    f32x4 v[4]; float s = 0.f;
#pragma unroll
    for (int j = 0; j < 4; ++j) { v[j] = xr[64 * j]; s += (v[j].x * v[j].x + v[j].y * v[j].y) + (v[j].z * v[j].z + v[j].w * v[j].w); }
    const float rs = 1.0f / sqrtf(wave_sum(s) * (1.f / D) + 1e-6f);
    v2u* o8 = (v2u*)orow + lane;
#pragma unroll
    for (int j = 0; j < 4; ++j) { const f32x4 g = wr[64 * j]; v2u o; o.x = pk2(v[j].x * rs * g.x, v[j].y * rs * g.y); o.y = pk2(v[j].z * rs * g.z, v[j].w * rs * g.w); o8[64 * j] = o; }
}
__device__ __forceinline__ int t5_bucket(int d) {
    if (d < 16) return d;
    int b = 16;
    b += (d >= 19) + (d >= 21) + (d >= 24) + (d >= 27) + (d >= 31) + (d >= 35) + (d >= 40) + (d >= 46) + (d >= 52) + (d >= 59) + (d >= 67) + (d >= 77) + (d >= 87) + (d >= 99) + (d >= 113);
    return b;
}
__device__ __forceinline__ void ph_prologue(Frame& F, unsigned char* ws) {
    LAS float* scr = (LAS float*)(F.lds + F.wave * 16384);
    const int gw = F.vcu * NWAVES + F.wave, NGW = F.G * NWAVES;
    constexpr int I_0 = (D / 64) * (N0 / 32), I_O = (D / 64) * (D / 32), I_1 = (D / 64) * (N1 / 32);
    constexpr int NITEMS = I_0 + I_O + I_1 + I_O;
    for (int it = gw; it < NITEMS; it += NGW) {
        int r = it;
        if (r < I_0) { p0_transpose_item(F.w_in0, D, N0, F.W0T, scr, r, F.lane); continue; } r -= I_0;
        if (r < I_O) { p0_transpose_item(F.w_out0, D, D, F.WO0T, scr, r, F.lane); continue; } r -= I_O;
        if (r < I_1) { p0_transpose_item(F.w_in1, D, N1, F.W1T, scr, r, F.lane); continue; } r -= I_1;
        p0_transpose_item(F.w_out1, D, D, F.WO1T, scr, r, F.lane);
    }
    for (int i = gw * 64 + F.lane; i < (N0P - N0) * D / 8; i += NGW * 64) ((v4u*)(F.W0T + (size_t)N0 * D))[i] = (v4u){0u, 0u, 0u, 0u};
    {
        const int lane = F.lane; f32x4 g[4];
#pragma unroll
        for (int j = 0; j < 4; ++j) g[j] = ((const f32x4*)F.pre0 + lane)[64 * j];
        f32x4 a0[4], a1[4], b0[4], b1[4];
#define PRO_LD(v, mm) do { if ((mm) < M) { const f32x4* xr_ = (const f32x4*)(F.x + (size_t)(mm) * D) + lane; _Pragma("unroll") for (int j = 0; j < 4; ++j) v[j] = xr_[64 * j]; } } while (0)
#define PRO_PR(v, mm) do { if ((mm) < M) { float s_ = 0.f; _Pragma("unroll") for (int j = 0; j < 4; ++j) s_ += (v[j].x * v[j].x + v[j].y * v[j].y) + (v[j].z * v[j].z + v[j].w * v[j].w); \
            const float rs_ = 1.0f / sqrtf(wave_sum(s_) * (1.f / D) + 1e-6f); v2u* o8_ = (v2u*)(F.HA + (size_t)(mm) * D) + lane; \
            _Pragma("unroll") for (int j = 0; j < 4; ++j) { v2u o_; o_.x = pk2(v[j].x * rs_ * g[j].x, v[j].y * rs_ * g[j].y); o_.y = pk2(v[j].z * rs_ * g[j].z, v[j].w * rs_ * g[j].w); o8_[64 * j] = o_; } } } while (0)
        int m = gw; PRO_LD(a0, m); PRO_LD(a1, m + NGW);
#pragma unroll 1
        for (; m < M; m += 4 * NGW) {
            PRO_LD(b0, m + 2 * NGW); PRO_LD(b1, m + 3 * NGW);
            PRO_PR(a0, m); PRO_PR(a1, m + NGW);
            PRO_LD(a0, m + 4 * NGW); PRO_LD(a1, m + 5 * NGW);
            PRO_PR(b0, m + 2 * NGW); PRO_PR(b1, m + 3 * NGW);
        }
#undef PRO_LD
#undef PRO_PR
    }
    const int gt = blockIdx.x * NTHR + F.tid;
    if (gt < 1024) { const int h = gt >> 7, d = gt & 127; F.bias_tab[gt] = F.rel_bias[t5_bucket(d) * 8 + h];
        F.lb_tab[gt] = 1.0f / (1.0f + expf(F.lower_bounds[gt] - F.lower_bounds[1024 + gt])); }
    if (gt < 16384) { const int cc = gt >> 5, l = gt & 31; ((bf16*)(ws + WS_TAB + 8192))[gt] = (bf16)f2bf(F.a_w2[l * 512 + cc]); ((bf16*)(ws + WS_TAB + 8192 + 32768))[gt] = (bf16)f2bf(F.a_a2[l * 512 + cc]); }
}

__device__ __forceinline__ void ph_attention(Frame& F) {
    LAS bf16* Ks = (LAS bf16*)(F.lds);
    LAS bf16* Vt = (LAS bf16*)(F.lds + 36864);
    LAS float* Bt = (LAS float*)(F.lds + 36864 + 33280);
    const int tid = F.tid, lane = F.lane, wave = F.wave, r32 = lane & 31, hh = lane >> 5;
    const bf16* P = F.PROJ;
    const int row = tid >> 1, half = tid & 1;
    v4u kv[4], vv[4];
#define AT_LOADKV(u_) do { const int hkv_ = (u_) & 1, nb_ = ((u_) >> 1) & 63, b_ = (u_) >> 7; const long grow_ = (long)b_ * T + nb_ * 128 - 128 + row; \
        if ((nb_ > 0) || (row >= 128)) { const v4u* kp_ = (const v4u*)(P + grow_ * P0LD + C_KB + hkv_ * 64 + half * 32); const v4u* vp_ = (const v4u*)(P + grow_ * P0LD + C_VB + hkv_ * 64 + half * 32); \
            _Pragma("unroll") for (int i_ = 0; i_ < 4; ++i_) { kv[i_] = kp_[i_]; vv[i_] = vp_[i_]; } } \
        else { _Pragma("unroll") for (int i_ = 0; i_ < 4; ++i_) { kv[i_] = (v4u){0u, 0u, 0u, 0u}; vv[i_] = (v4u){0u, 0u, 0u, 0u}; } } } while (0)
    int u = blockIdx.x;
    if (u < 1024) AT_LOADKV(u);
    for (; u < 1024; u += F.G) {
        const int hkv = u & 1, nb = (u >> 1) & 63, b = u >> 7;
        bf16x8 qf0[4], qf1[4];
#define AT_QLOAD(ii_, qf_) do { const int item_ = wave * 2 + (ii_), g_ = item_ >> 2, qt_ = item_ & 3, hq_ = hkv * 4 + g_; \
            const bf16* qp_ = P + ((long)b * T + nb * 128 + qt_ * 32 + r32) * P0LD + C_QB + hq_ * 64 + hh * 8; \
            _Pragma("unroll") for (int s_ = 0; s_ < 4; ++s_) qf_[s_] = *(const bf16x8*)(qp_ + 16 * s_); } while (0)
        AT_QLOAD(0, qf0); AT_QLOAD(1, qf1);
        {
#pragma unroll
            for (int i = 0; i < 4; ++i) *(LAS v4u*)(Ks + row * 72 + half * 32 + 8 * i) = kv[i];
#pragma unroll
            for (int i = 0; i < 4; ++i)
#pragma unroll
                for (int e = 0; e < 4; ++e) { const unsigned w = vv[i][e]; const int d = half * 32 + 8 * i + 2 * e;
                    Vt[d * 260 + row] = (bf16)(w & 0xffffu); Vt[(d + 1) * 260 + row] = (bf16)(w >> 16); }
            for (int x = tid; x < 768; x += NTHR) { const int g = x / 192, e = x - g * 192 - 32; Bt[x] = (e >= 0 && e < 128) ? F.bias_tab[(hkv * 4 + g) * 128 + e] * 1.44269504f : 0.f; }
        }
        LBAR();
        if (u + F.G < 1024) AT_LOADKV(u + F.G);
#define AT_ITEM(ii, qf) do { \
            const int item = wave * 2 + ii, g = item >> 2, qt = item & 3, hq = hkv * 4 + g; \
            const long qrow = (long)b * T + nb * 128 + qt * 32 + r32; \
            v2u gwv[2][4]; \
            _Pragma("unroll") \
            for (int dt = 0; dt < 2; ++dt) \
            _Pragma("unroll") \
                for (int gq = 0; gq < 4; ++gq) gwv[dt][gq] = *(const v2u*)(P + qrow * P0LD + C_GB + hq * 64 + dt * 32 + 8 * gq + 4 * hh); \
            f32x16 sc[5]; \
            _Pragma("unroll") \
            for (int tt = 0; tt < 5; ++tt) { f32x16 acc = {0.f, 0.f, 0.f, 0.f, 0.f, 0.f, 0.f, 0.f, 0.f, 0.f, 0.f, 0.f, 0.f, 0.f, 0.f, 0.f}; \
            _Pragma("unroll") \
                for (int s = 0; s < 4; ++s) { const bf16x8 kf = *(const LAS bf16x8*)(Ks + ((qt + tt) * 32 + r32) * 72 + 16 * s + 8 * hh); \
                    acc = __builtin_amdgcn_mfma_f32_32x32x16_bf16(kf, qf[s], acc, 0, 0, 0); } \
                sc[tt] = acc; } \
              \
              \
            const int dl = r32 - 4 * hh; const LAS float* bp = Bt + g * 192 + (dl + 5); const float sink2 = F.sinks[hq] * 1.44269504f; \
            float mx = sink2; \
            _Pragma("unroll") \
            for (int tt = 0; tt < 5; ++tt) { \
                if ((nb == 0) && (qt + tt < 4)) { \
            _Pragma("unroll") \
                    for (int i = 0; i < 16; ++i) sc[tt][i] = -1e30f; } \
                else { \
            _Pragma("unroll") \
                    for (int i = 0; i < 16; ++i) { const int c = (i & 3) + 8 * (i >> 2); \
                        float s = sc[tt][i] * (0.125f * 1.44269504f) + bp[155 - 32 * tt - c]; \
                        if (tt == 0) s = (c > dl) ? s : -1e30f; \
                        if (tt == 4) s = (c <= dl) ? s : -1e30f; \
                        sc[tt][i] = s; mx = fmaxf(mx, s); } } } \
            mx = fmaxf(mx, __shfl_xor(mx, 32)); \
            float sum = 0.f; \
            _Pragma("unroll") \
            for (int tt = 0; tt < 5; ++tt) \
            _Pragma("unroll") \
                for (int i = 0; i < 16; ++i) { const float p = __builtin_amdgcn_exp2f(sc[tt][i] - mx); sc[tt][i] = p; sum += p; } \
            sum += __shfl_xor(sum, 32); \
            const float inv = frcp(sum + __builtin_amdgcn_exp2f(sink2 - mx)); \
            f32x16 o[2]; \
            _Pragma("unroll") \
            for (int dt = 0; dt < 2; ++dt) o[dt] = (f32x16){0.f, 0.f, 0.f, 0.f, 0.f, 0.f, 0.f, 0.f, 0.f, 0.f, 0.f, 0.f, 0.f, 0.f, 0.f, 0.f}; \
            _Pragma("unroll") \
            for (int tt = 0; tt < 5; ++tt) \
            _Pragma("unroll") \
                for (int s = 0; s < 2; ++s) { \
                    v4u pw; pw.x = pk2(sc[tt][8 * s + 0], sc[tt][8 * s + 1]); pw.y = pk2(sc[tt][8 * s + 2], sc[tt][8 * s + 3]); pw.z = pk2(sc[tt][8 * s + 4], sc[tt][8 * s + 5]); pw.w = pk2(sc[tt][8 * s + 6], sc[tt][8 * s + 7]); \
                    const bf16x8 pf = __builtin_bit_cast(bf16x8, pw); \
                    const int kb = (qt + tt) * 32 + 16 * s + 4 * hh; \
            _Pragma("unroll") \
                    for (int dt = 0; dt < 2; ++dt) { const LAS bf16* vp = Vt + (dt * 32 + r32) * 260 + kb; \
                        const v2u lo = *(const LAS v2u*)(vp), hi = *(const LAS v2u*)(vp + 8); \
                        v4u vw; vw.x = lo.x; vw.y = lo.y; vw.z = hi.x; vw.w = hi.y; \
                        o[dt] = __builtin_amdgcn_mfma_f32_32x32x16_bf16(__builtin_bit_cast(bf16x8, vw), pf, o[dt], 0, 0, 0); } } \
            _Pragma("unroll") \
            for (int dt = 0; dt < 2; ++dt) \
            _Pragma("unroll") \
                for (int gq = 0; gq < 4; ++gq) { const int d0 = dt * 32 + 8 * gq + 4 * hh; const v2u gv = gwv[dt][gq]; \
                    const float g0 = bflo(gv.x), g1 = bfhi(gv.x), g2 = bflo(gv.y), g3 = bfhi(gv.y); \
                    v2u ow; ow.x = pk2(o[dt][4 * gq + 0] * inv * siluf_(g0), o[dt][4 * gq + 1] * inv * siluf_(g1)); ow.y = pk2(o[dt][4 * gq + 2] * inv * siluf_(g2), o[dt][4 * gq + 3] * inv * siluf_(g3)); \
                    *(v2u*)(F.HB + qrow * D + 512 + hq * 64 + d0) = ow; } \
        } while (0)
#pragma unroll 1
        for (int ii = 0; ii < 2; ++ii) { bf16x8 qf[4];
#pragma unroll
            for (int s = 0; s < 4; ++s) qf[s] = ii ? qf1[s] : qf0[s];
            AT_ITEM(ii, qf); }
        LBAR();
    }
#undef AT_LOADKV
#undef AT_QLOAD
#undef AT_ITEM
}
constexpr int RW_R = 0, RW_W = 4096, RW_KM = 8192, RW_V = 12288, RW_KN = 16384, RW_KA = 20480, RW_G = 24576, RW_TW = 28672, RW_TA = 30720, RW_CT = 32768, RW_RED = 32832;
__device__ __forceinline__ void rwkv_prep(Frame& F, int b, int c, int h) {
    LAS float* L = (LAS float*)F.lds;
    const int tid = F.tid; const bf16* P = F.PROJ; const long rowbase = (long)b * T + c * 64;
#pragma unroll 1
    for (int i = 0; i < 8; ++i) { const int idx = tid + 512 * i, arr = idx >> 11, j = (idx >> 5) & 63, l = idx & 31, col = C_WL + 32 * arr + l;
        const long t = rowbase + j; const float cur = bf2f(P[t * P0LD + col]); const float prev = (c * 64 + j > 0) ? bf2f(P[(t - 1) * P0LD + col]) : 0.f;
        const float sh = cur + F.a_mu[col] * (prev - cur);
        if (arr == 0) L[RW_TW + j * 32 + l] = tanhf(sh); else L[RW_TA + j * 32 + l] = sh; }
    __syncthreads();
    const int ch = tid & 63, jg = tid >> 6, cg = h * 64 + ch;
    const float w0 = F.a_w0[cg], a0 = F.a_a0[cg], kkc = F.a_k_k[cg], kac = F.a_k_a[cg], rk = F.a_r_k[cg];
    const float mu_r = F.a_mu[C_R + cg], mu_k = F.a_mu[C_K + cg], mu_v = F.a_mu[C_V + cg], mu_g = F.a_mu[C_GA + cg];
    const int j0 = jg * 8;
    float pr = 0.f, pk = 0.f, pv = 0.f, pg = 0.f;
    if (c * 64 + j0 > 0) { const bf16* q = P + (rowbase + j0 - 1) * P0LD; pr = bf2f(q[C_R + cg]); pk = bf2f(q[C_K + cg]); pv = bf2f(q[C_V + cg]); pg = bf2f(q[C_GA + cg]); }
#pragma unroll 1
    for (int jj = 0; jj < 8; ++jj) { const int j = j0 + jj; const bf16* q = P + (rowbase + j) * P0LD;
        const float cr = bf2f(q[C_R + cg]), ck = bf2f(q[C_K + cg]), cv = bf2f(q[C_V + cg]), cgt = bf2f(q[C_GA + cg]);
        const float r = cr + mu_r * (pr - cr), k = ck + mu_k * (pk - ck), v = cv + mu_v * (pv - cv), g = cgt + mu_g * (pg - cgt);
        pr = cr; pk = ck; pv = cv; pg = cgt;
        float wpre = w0, apre = a0;
#pragma unroll 4
        for (int l = 0; l < 32; ++l) { wpre += L[RW_TW + j * 32 + l] * F.a_w2[l * 512 + cg]; apre += L[RW_TA + j * 32 + l] * F.a_a2[l * 512 + cg]; }
        const float z = -wpre; const float sp = fmaxf(z, 0.f) + log1pf(expf(-fabsf(z)));
        const float w = -sp - 0.5f; const float decay = expf(-expf(w));
        const float alpha = 1.0f / (1.0f + expf(-apre));
        const float kk = k * kkc; const float ss = wave_sum(kk * kk); const float kkn = kk / fmaxf(sqrtf(ss), 1e-12f);
        const float km = k * (1.0f + (alpha - 1.0f) * kac);
        const float ct = wave_sum(r * km * rk);
        L[RW_R + j * 64 + ch] = r; L[RW_W + j * 64 + ch] = decay; L[RW_KM + j * 64 + ch] = km; L[RW_V + j * 64 + ch] = v;
        L[RW_KN + j * 64 + ch] = kkn; L[RW_KA + j * 64 + ch] = kkn * alpha; L[RW_G + j * 64 + ch] = g;
        if (ch == 0) L[RW_CT + j] = ct; }
    __syncthreads();
}
__device__ __forceinline__ void ph_rwkv_naive(Frame& F) {
    if (blockIdx.x >= 64) return;
    LAS float* L = (LAS float*)F.lds;
    const int bh = blockIdx.x, b = bh >> 3, h = bh & 7, v = F.lane, kq = F.wave;
    float S[8];
#pragma unroll
    for (int i = 0; i < 8; ++i) S[i] = 0.f;
    const float lnw = F.a_ln_w[h * 64 + v], lnb = F.a_ln_b[h * 64 + v];
#pragma unroll 1
    for (int c = 0; c < T / 64; ++c) {
        rwkv_prep(F, b, c, h);
#pragma unroll 1
        for (int j = 0; j < 64; ++j) {
            const int par = j & 1;
            float p1 = 0.f;
#pragma unroll
            for (int i = 0; i < 8; ++i) p1 += S[i] * L[RW_KN + j * 64 + 8 * kq + i];
            L[RW_RED + (par * 2 + 0) * 512 + kq * 64 + v] = p1;
            __syncthreads();
            float sa = 0.f;
#pragma unroll
            for (int q = 0; q < 8; ++q) sa += L[RW_RED + (par * 2 + 0) * 512 + q * 64 + v];
            sa = -sa;
            const float vv = L[RW_V + j * 64 + v];
            float p2 = 0.f;
#pragma unroll
            for (int i = 0; i < 8; ++i) { const int k = 8 * kq + i; S[i] = S[i] * L[RW_W + j * 64 + k] + sa * L[RW_KA + j * 64 + k] + vv * L[RW_KM + j * 64 + k]; p2 += S[i] * L[RW_R + j * 64 + k]; }
            L[RW_RED + (par * 2 + 1) * 512 + kq * 64 + v] = p2;
            __syncthreads();
            if (kq == 0) {
                float y = 0.f;
#pragma unroll
                for (int q = 0; q < 8; ++q) y += L[RW_RED + (par * 2 + 1) * 512 + q * 64 + v];
                const float mean = wave_sum(y) * (1.f / 64.f); const float dd = y - mean; const float var = wave_sum(dd * dd) * (1.f / 64.f);
                float yn = dd * (1.0f / sqrtf(var + 64e-5f)) * lnw + lnb;
                yn += L[RW_CT + j] * vv;
                const float g = L[RW_G + j * 64 + v];
                F.HB[((size_t)b * T + c * 64 + j) * D + h * 64 + v] = (bf16)f2bf(yn * siluf_(g));
            }
        }
        __syncthreads();
    }
}

__device__ __forceinline__ void ph_hgrn_naive(Frame& F) {
    if (blockIdx.x >= 64) return;
    LAS float* L = (LAS float*)F.lds;
    const int bh = blockIdx.x, b = bh >> 3, h = bh & 7, tid = F.tid, v = tid & 127, kq = tid >> 7;
    const bf16* P = F.PROJ;
    float S[32];
#pragma unroll
    for (int i = 0; i < 32; ++i) S[i] = 0.f;
    const float lb = F.lb_tab[h * 128 + v];
    const float cw = F.c_norm_w[v];
#pragma unroll 1
    for (int tb = 0; tb < T / 32; ++tb) {
        const long rowbase = (long)b * T + tb * 32;
#pragma unroll 1
        for (int jj = 0; jj < 8; ++jj) { const int j = kq * 8 + jj; const bf16* q = P + (rowbase + j) * P1LD + h * 128 + v;
            const float qv = bf2f(q[0]), fv = bf2f(q[1024]), iv = bf2f(q[2048]), gv = bf2f(q[3072]);
            const float fg = lb + (1.0f - lb) * sigmoidf_(fv);
            L[j * 128 + v] = siluf_(qv); L[4096 + j * 128 + v] = fg; L[8192 + j * 128 + v] = 1.0f - fg; L[12288 + j * 128 + v] = iv; L[16384 + j * 128 + v] = gv; }
        __syncthreads();
#pragma unroll 1
        for (int j = 0; j < 32; ++j) {
            const float vv = L[12288 + j * 128 + v]; float p = 0.f;
#pragma unroll
            for (int i = 0; i < 32; ++i) { const int k = kq * 32 + i; S[i] = L[4096 + j * 128 + k] * S[i] + L[8192 + j * 128 + k] * vv; p += S[i] * L[j * 128 + k]; }
            L[24576 + (j & 1) * 512 + kq * 128 + v] = p;
            __syncthreads();
            if (kq == 0) L[20480 + j * 128 + v] = (L[24576 + (j & 1) * 512 + v] + L[24576 + (j & 1) * 512 + 128 + v]) + (L[24576 + (j & 1) * 512 + 256 + v] + L[24576 + (j & 1) * 512 + 384 + v]);
        }
        __syncthreads();
#pragma unroll 1
        for (int q = 0; q < 4; ++q) { const int j = F.wave + 8 * q; const int l = F.lane;
            const float o0 = L[20480 + j * 128 + l], o1 = L[20480 + j * 128 + 64 + l];
            const float rs = 1.0f / sqrtf(wave_sum(o0 * o0 + o1 * o1) * (1.f / 128.f) + 1e-6f);
            const float g0 = L[16384 + j * 128 + l], g1 = L[16384 + j * 128 + 64 + l];
            bf16* o = F.HB + (size_t)(rowbase + j) * D + h * 128;
            o[l] = (bf16)f2bf(o0 * rs * F.c_norm_w[l] * siluf_(g0)); o[64 + l] = (bf16)f2bf(o1 * rs * F.c_norm_w[64 + l] * siluf_(g1)); }
        __syncthreads();
    }
    (void)cw;
}

__device__ __forceinline__ void ph_resnorm0(Frame& F, const float* xin, bf16* YX, const float* wpost, const float* wpre, bf16* hn) {
    const int gw = F.vcu * NWAVES + F.wave, NGW = F.G * NWAVES, lane = F.lane;
    for (int m = gw; m < M; m += NGW) {
        v4u* yp = (v4u*)(YX + (size_t)m * D); const f32x4* xp = (const f32x4*)(xin + (size_t)m * D);
        float yv[16]; float s = 0.f;
#pragma unroll
        for (int j = 0; j < 2; ++j) { const v4u w = yp[lane + 64 * j];
#pragma unroll
            for (int e = 0; e < 4; ++e) { yv[8 * j + 2 * e] = bflo(w[e]); yv[8 * j + 2 * e + 1] = bfhi(w[e]); } }
#pragma unroll
        for (int e = 0; e < 16; ++e) s += yv[e] * yv[e];
        const float rs = __builtin_amdgcn_rsqf(wave_sum(s) * (1.f / D) + 1e-6f);
        float x1[16]; float s1 = 0.f;
#pragma unroll
        for (int j = 0; j < 2; ++j)
#pragma unroll
            for (int q = 0; q < 2; ++q) { const int c4 = 2 * (lane + 64 * j) + q; const f32x4 xv = xp[c4]; const f32x4 wv = ((const f32x4*)wpost)[c4];
#pragma unroll
                for (int e = 0; e < 4; ++e) { const float o = xv[e] + yv[8 * j + 4 * q + e] * rs * wv[e]; x1[8 * j + 4 * q + e] = o; s1 += o * o; } }
        const float rs1 = __builtin_amdgcn_rsqf(wave_sum(s1) * (1.f / D) + 1e-6f);
#pragma unroll
        for (int j = 0; j < 2; ++j) { const int c8 = lane + 64 * j; const f32x4 w0 = ((const f32x4*)wpre)[2 * c8], w1 = ((const f32x4*)wpre)[2 * c8 + 1];
            v4u xo; xo.x = pk2(x1[8 * j + 0], x1[8 * j + 1]); xo.y = pk2(x1[8 * j + 2], x1[8 * j + 3]); xo.z = pk2(x1[8 * j + 4], x1[8 * j + 5]); xo.w = pk2(x1[8 * j + 6], x1[8 * j + 7]);
            yp[c8] = xo;
            v4u o; o.x = pk2(x1[8 * j + 0] * rs1 * w0[0], x1[8 * j + 1] * rs1 * w0[1]); o.y = pk2(x1[8 * j + 2] * rs1 * w0[2], x1[8 * j + 3] * rs1 * w0[3]);
            o.z = pk2(x1[8 * j + 4] * rs1 * w1[0], x1[8 * j + 5] * rs1 * w1[1]); o.w = pk2(x1[8 * j + 6] * rs1 * w1[2], x1[8 * j + 7] * rs1 * w1[3]);
            ((v4u*)(hn + (size_t)m * D))[c8] = o; }
    }
}
__device__ __forceinline__ void ph_resnorm1(Frame& F, const bf16* X1, const bf16* Y, const float* wpost, float* out) {
    const int gw = F.vcu * NWAVES + F.wave, NGW = F.G * NWAVES, lane = F.lane;
    for (int m = gw; m < M; m += NGW) {
        const v4u* yp = (const v4u*)(Y + (size_t)m * D); const v4u* xp = (const v4u*)(X1 + (size_t)m * D); f32x4* op = (f32x4*)(out + (size_t)m * D);
        float yv[16], xv[16]; float s = 0.f;
#pragma unroll
        for (int j = 0; j < 2; ++j) { const v4u w = yp[lane + 64 * j], xw = xp[lane + 64 * j];
#pragma unroll
            for (int e = 0; e < 4; ++e) { yv[8 * j + 2 * e] = bflo(w[e]); yv[8 * j + 2 * e + 1] = bfhi(w[e]); xv[8 * j + 2 * e] = bflo(xw[e]); xv[8 * j + 2 * e + 1] = bfhi(xw[e]); } }
#pragma unroll
        for (int e = 0; e < 16; ++e) s += yv[e] * yv[e];
        const float rs = __builtin_amdgcn_rsqf(wave_sum(s) * (1.f / D) + 1e-6f);
#pragma unroll
        for (int j = 0; j < 2; ++j)
#pragma unroll
            for (int q = 0; q < 2; ++q) { const int c4 = 2 * (lane + 64 * j) + q; const f32x4 wv = ((const f32x4*)wpost)[c4]; f32x4 o;
#pragma unroll
                for (int e = 0; e < 4; ++e) o[e] = xv[8 * j + 4 * q + e] + yv[8 * j + 4 * q + e] * rs * wv[e];
                op[c4] = o; }
    }
}
typedef float f32x4v __attribute__((ext_vector_type(4)));
__device__ __forceinline__ f32x4v mm_tile(const LAS bf16* X, const LAS bf16* Y, int n0, int m0, int lane, f32x4v acc) {
    const int r = lane & 15, q = lane >> 4;
#pragma unroll
    for (int s = 0; s < 2; ++s) { const bf16x8 a = *(const LAS bf16x8*)(Y + (m0 + r) * 72 + 32 * s + 8 * q); const bf16x8 b = *(const LAS bf16x8*)(X + (n0 + r) * 72 + 32 * s + 8 * q);
        acc = __builtin_amdgcn_mfma_f32_16x16x32_bf16(a, b, acc, 0, 0, 0); }
    return acc;
}
__device__ __forceinline__ void st_tile(LAS bf16* dst, int n0, int m0, int lane, f32x4v a) { v2u w; w.x = pk2(a[0], a[1]); w.y = pk2(a[2], a[3]); *(LAS v2u*)(dst + (n0 + (lane & 15)) * 72 + m0 + 4 * (lane >> 4)) = w; }
__device__ __forceinline__ void st_tile_g(bf16* dst, int n0, int m0, int lane, f32x4v a) { v2u w; w.x = pk2(a[0], a[1]); w.y = pk2(a[2], a[3]); *(v2u*)(dst + (n0 + (lane & 15)) * 64 + m0 + 4 * (lane >> 4)) = w; }
__device__ __forceinline__ f32x4v blk16(const LAS float* X, const LAS float* Y, int lane, f32x4v acc) {
    const int r = lane & 15, q = lane >> 4;
#pragma unroll
    for (int s = 0; s < 4; ++s) acc = __builtin_amdgcn_mfma_f32_16x16x4f32(X[r * 68 + 4 * s + q], Y[(4 * s + q) * 68 + r], acc, 0, 0, 0);
    return acc;
}
constexpr int RA_AT = 0, RA_BH = 9216, RA_KH = 18432, RA_RT = 27648, RA_ATT = 36864, RA_VT = 46080, RA_BTT = 55296, RA_KTT = 64512, RA_AAK = 73728, RA_ARB = 82944, RA_ARK = 92160,
              RA_FM = 101376, RA_TF = 118784, RA_MISC = 136192;
constexpr int RA_WPRE = 73728, RA_APRE = 90112, RA_TWB = 106496, RA_TAB = 111616, RA_W2T = 116736, RA_A2T = 121856;
constexpr size_t WS_MPT = 32 * MiB, WS_NM = 96 * MiB, WS_QE = 800 * MiB, WS_Y0 = 864 * MiB, WS_S0 = 928 * MiB, WS_GCE = 992 * MiB, WS_CT = 994 * MiB, WS_W2T = WS_TAB + 8192, WS_A2T = WS_TAB + 8192 + 32768;

__device__ __forceinline__ float dpp_add(float v, const int ctrl_sel) {
    int r;
    if (ctrl_sel == 0) r = __builtin_amdgcn_update_dpp(0, __builtin_bit_cast(int, v), 0xB1, 0xf, 0xf, true);
    else if (ctrl_sel == 1) r = __builtin_amdgcn_update_dpp(0, __builtin_bit_cast(int, v), 0x4E, 0xf, 0xf, true);
    else if (ctrl_sel == 2) r = __builtin_amdgcn_update_dpp(0, __builtin_bit_cast(int, v), 0x141, 0xf, 0xf, true);
    else r = __builtin_amdgcn_update_dpp(0, __builtin_bit_cast(int, v), 0x140, 0xf, 0xf, true);
    return v + __builtin_bit_cast(float, r);
}
__device__ __forceinline__ float wave_sum_dpp(float v) {
    v = dpp_add(v, 0); v = dpp_add(v, 1); v = dpp_add(v, 2); v = dpp_add(v, 3);
    const int iv = __builtin_bit_cast(int, v);
    const float r0 = __builtin_bit_cast(float, __builtin_amdgcn_readlane(iv, 0)), r1 = __builtin_bit_cast(float, __builtin_amdgcn_readlane(iv, 16));
    const float r2 = __builtin_bit_cast(float, __builtin_amdgcn_readlane(iv, 32)), r3 = __builtin_bit_cast(float, __builtin_amdgcn_readlane(iv, 48));
    return (r0 + r1) + (r2 + r3);
}
__device__ __forceinline__ float swap32_sum(float a, float b) { asm volatile("s_nop 1\n\tv_permlane32_swap_b32 %0, %1" : "+v"(a), "+v"(b)); return a + b; }
__device__ __forceinline__ float swap16_sum(float a, float b) { asm volatile("s_nop 1\n\tv_permlane16_swap_b32 %0, %1" : "+v"(a), "+v"(b)); return a + b; }
constexpr int RA_RKV = 0;
struct RaPf { v4u rkv[4]; v4u lc, lp; v2u tw, ta; };
__device__ __forceinline__ void rwkv_pf_load(RaPf& pf, Frame& F, int b, int c, int h, unsigned char* ws) {
    const int tid = F.tid; const bf16* P = F.PROJ; const long rowbase = (long)b * T + c * 64;
#pragma unroll
    for (int k = 0; k < 4; ++k) { const int pc = tid + 512 * k; pf.rkv[k] = (v4u){0u, 0u, 0u, 0u};
        if (pc < 1560) { const int row = pc / 24, rem = pc - row * 24, arr = rem >> 3, p8 = rem & 7;
            if (row > 0 || c > 0) pf.rkv[k] = *(const v4u*)(P + (rowbase - 1 + row) * P0LD + arr * 512 + h * 64 + 8 * p8); } }
    { const int j = tid >> 3, p = tid & 7; pf.lc = *(const v4u*)(P + (rowbase + j) * P0LD + C_WL + 8 * p); pf.lp = (v4u){0u, 0u, 0u, 0u};
      if (c * 64 + j > 0) pf.lp = *(const v4u*)(P + (rowbase + j - 1) * P0LD + C_WL + 8 * p);
      const int l4 = 4 * (tid & 7);
      pf.tw = *(const v2u*)((const bf16*)(ws + WS_W2T) + (h * 64 + j) * 32 + l4); pf.ta = *(const v2u*)((const bf16*)(ws + WS_A2T) + (h * 64 + j) * 32 + l4); }
}
template <bool HAS_NEXT> __device__ __forceinline__ void rwkv_passA_item(Frame& F, int b, int c, int h, unsigned char* ws, RaPf& pf, int nb_, int nc_, int nh_) {
    LAS unsigned char* L = F.lds; const int tid = F.tid, lane = F.lane, wave = F.wave;
    const long rowbase = (long)b * T + c * 64; const int chd = (b * 128 + c) * 8 + h;
    LAS bf16* At = (LAS bf16*)(L + RA_AT); LAS bf16* Bh = (LAS bf16*)(L + RA_BH); LAS bf16* Kh = (LAS bf16*)(L + RA_KH); LAS bf16* Rt = (LAS bf16*)(L + RA_RT);
    LAS bf16* AtT = (LAS bf16*)(L + RA_ATT); LAS bf16* VT = (LAS bf16*)(L + RA_VT); LAS bf16* BtT = (LAS bf16*)(L + RA_BTT); LAS bf16* KtT = (LAS bf16*)(L + RA_KTT);
    LAS bf16* Aak = (LAS bf16*)(L + RA_AAK); LAS bf16* Arb = (LAS bf16*)(L + RA_ARB); LAS bf16* Ark = (LAS bf16*)(L + RA_ARK);
    LAS float* Fm = (LAS float*)(L + RA_FM); LAS float* Tf = (LAS float*)(L + RA_TF); LAS float* Misc = (LAS float*)(L + RA_MISC);
    LAS bf16* Tm = At; LAS bf16* XT = Bh; LAS bf16* WT = Kh; LAS bf16* U0T = Aak;
    LAS float* Wpre = (LAS float*)(L + RA_WPRE); LAS float* Apre = (LAS float*)(L + RA_APRE);
    LAS bf16* TWb = (LAS bf16*)(L + RA_TWB); LAS bf16* TAb = (LAS bf16*)(L + RA_TAB); LAS bf16* W2s = (LAS bf16*)(L + RA_W2T); LAS bf16* A2s = (LAS bf16*)(L + RA_A2T);
    LAS bf16* RKV = (LAS bf16*)(L + RA_RKV);
    const f32x4v z4 = {0.f, 0.f, 0.f, 0.f};
#pragma unroll
    for (int k = 0; k < 4; ++k) { const int pc = tid + 512 * k; if (pc < 1560) { const int row = pc / 24, rem = pc - row * 24; *(LAS v4u*)(RKV + (row * 3 + (rem >> 3)) * 72 + 8 * (rem & 7)) = pf.rkv[k]; } }
    { const int j = tid >> 3, p = tid & 7, arr = p >> 2, l8 = 8 * (p & 3), l4 = 4 * p;
      *(LAS v2u*)(W2s + j * 40 + l4) = pf.tw; *(LAS v2u*)(A2s + j * 40 + l4) = pf.ta;
      const f32x4v m0 = *(const f32x4v*)(F.a_mu + C_WL + 8 * p), m1 = *(const f32x4v*)(F.a_mu + C_WL + 8 * p + 4);
      const float mu[8] = {m0[0], m0[1], m0[2], m0[3], m1[0], m1[1], m1[2], m1[3]}; float sh[8];
#pragma unroll
      for (int e = 0; e < 4; ++e) { const float c0 = bflo(pf.lc[e]), c1 = bfhi(pf.lc[e]), p0 = bflo(pf.lp[e]), p1 = bfhi(pf.lp[e]);
          sh[2 * e] = c0 + mu[2 * e] * (p0 - c0); sh[2 * e + 1] = c1 + mu[2 * e + 1] * (p1 - c1); }
      if (arr == 0) {
#pragma unroll
          for (int e = 0; e < 8; ++e) sh[e] = 1.0f - 2.0f * frcp(1.0f + __expf(2.0f * sh[e])); }
      v4u o; o.x = pk2(sh[0], sh[1]); o.y = pk2(sh[2], sh[3]); o.z = pk2(sh[4], sh[5]); o.w = pk2(sh[6], sh[7]);
      *(LAS v4u*)((arr ? TAb : TWb) + j * 40 + l8) = o; }
    LBAR();
    if (HAS_NEXT) rwkv_pf_load(pf, F, nb_, nc_, nh_, ws);
    { const int r = lane & 15, q = lane >> 4;
#pragma unroll
      for (int i = 0; i < 4; ++i) { const int tt = wave * 4 + i, arr = tt >> 4, n0 = ((tt >> 2) & 3) * 16, m0 = (tt & 3) * 16;
          const LAS bf16* X = arr ? TAb : TWb; const LAS bf16* Y = arr ? A2s : W2s;
          const bf16x8 a = *(const LAS bf16x8*)(Y + (m0 + r) * 40 + 8 * q); const bf16x8 bb = *(const LAS bf16x8*)(X + (n0 + r) * 40 + 8 * q);
          const f32x4v d = __builtin_amdgcn_mfma_f32_16x16x32_bf16(a, bb, z4, 0, 0, 0);
          *(LAS f32x4v*)((arr ? Apre : Wpre) + (n0 + r) * 64 + m0 + 4 * q) = d; } }
    LBAR();
    const int ch = lane, cg = h * 64 + ch, j0 = wave * 8;
    float rr[8], kn[8], ka[8], km[8], vv[8], lw[8], gg[8];
    { const float w0 = F.a_w0[cg], a0 = F.a_a0[cg], kkc = F.a_k_k[cg], kac = F.a_k_a[cg], rk = F.a_r_k[cg];
      const float mu_r = F.a_mu[C_R + cg], mu_k = F.a_mu[C_K + cg], mu_v = F.a_mu[C_V + cg];
      float pr = bf2f(RKV[(j0 * 3 + 0) * 72 + ch]), pk = bf2f(RKV[(j0 * 3 + 1) * 72 + ch]), pv = bf2f(RKV[(j0 * 3 + 2) * 72 + ch]);
      float run = 0.f; float xr[16];
#pragma unroll
      for (int jj = 0; jj < 8; ++jj) { const int j = j0 + jj;
          const float cr = bf2f(RKV[((j + 1) * 3 + 0) * 72 + ch]), ck = bf2f(RKV[((j + 1) * 3 + 1) * 72 + ch]), cv = bf2f(RKV[((j + 1) * 3 + 2) * 72 + ch]);
          const float r = cr + mu_r * (pr - cr), k = ck + mu_k * (pk - ck), v = cv + mu_v * (pv - cv); pr = cr; pk = ck; pv = cv;
          const float wpre = w0 + Wpre[j * 64 + ch], apre = a0 + Apre[j * 64 + ch];
          const float lwv = -0.6065306597126334f * frcp(1.0f + __expf(-wpre));
          const float alpha = frcp(1.0f + __expf(-apre));
          const float kk = k * kkc; const float kmv = k * (1.0f + (alpha - 1.0f) * kac);
          xr[jj] = kk * kk; xr[8 + jj] = r * kmv * rk; kn[jj] = kk; ka[jj] = alpha;
          run += lwv;
          rr[jj] = r; km[jj] = kmv; vv[jj] = v; lw[jj] = lwv; gg[jj] = run; }
      float y8[8], z4[4], y2[2], wsum;
#pragma unroll
      for (int i = 0; i < 8; ++i) y8[i] = swap32_sum(xr[i], xr[8 + i]);
#pragma unroll
      for (int i = 0; i < 4; ++i) z4[i] = swap16_sum(y8[i], y8[4 + i]);
      { const bool b3 = (lane & 8) != 0, b2 = (lane & 4) != 0;
#pragma unroll
        for (int i = 0; i < 2; ++i) { const float keep = b3 ? z4[2 + i] : z4[i], send = b3 ? z4[i] : z4[2 + i];
            y2[i] = keep + __builtin_bit_cast(float, __builtin_amdgcn_update_dpp(0, __builtin_bit_cast(int, send), 0x128, 0xf, 0xf, true)); }
        const float keep = b2 ? y2[1] : y2[0], send = b2 ? y2[0] : y2[1];
        wsum = keep + __shfl_xor(send, 4);
        wsum = dpp_add(wsum, 1); wsum = dpp_add(wsum, 0); }
      { LAS float* red = Misc + 512 + wave * 16; if ((lane & 3) == 0) red[(lane >> 2) & 15] = wsum;
        if ((lane & 3) == 0 && lane >= 32) ((float*)(ws + WS_CT))[(rowbase + j0 + ((lane >> 2) & 7)) * 8 + h] = wsum;
        const f32x4v s0 = *(const LAS f32x4v*)(red), s1 = *(const LAS f32x4v*)(red + 4); const float ssv[8] = {s0[0], s0[1], s0[2], s0[3], s1[0], s1[1], s1[2], s1[3]};
#pragma unroll
        for (int jj = 0; jj < 8; ++jj) { kn[jj] *= fminf(__builtin_amdgcn_rsqf(ssv[jj]), 1e12f); ka[jj] *= kn[jj]; } }
      Misc[wave * 64 + ch] = run; }
    LBAR();
    { float off = 0.f, tot = 0.f;
#pragma unroll
      for (int w = 0; w < 8; ++w) { const float p = Misc[w * 64 + ch]; tot += p; if (w < wave) off += p; }
      const float eC = __expf(tot);
      if (wave == 0) ((float*)(ws + WS_GCE))[chd * 64 + ch] = eC;
      unsigned at8[8], bh8[8], kh8[8], rt8[8], v8[8], bt8[8], kt8[8];
#pragma unroll
      for (int jj = 0; jj < 8; ++jj) { const float g = gg[jj] + off; const float e1 = __expf(g), e2 = __expf(-g), em = __expf(-lw[jj]);
          const float at = -kn[jj] * e1 * em, bh = ka[jj] * e2, kh = km[jj] * e2, rt = rr[jj] * e1;
          at8[jj] = f2bf(at); bh8[jj] = f2bf(bh); kh8[jj] = f2bf(kh); rt8[jj] = f2bf(rt); v8[jj] = f2bf(vv[jj]); bt8[jj] = f2bf(bh * eC); kt8[jj] = f2bf(kh * eC);
          const int j = j0 + jj;
          At[j * 72 + ch] = (bf16)at8[jj]; Bh[j * 72 + ch] = (bf16)bh8[jj]; Kh[j * 72 + ch] = (bf16)kh8[jj]; Rt[j * 72 + ch] = (bf16)rt8[jj]; }
      v4u o;
      o.x = at8[0] | (at8[1] << 16); o.y = at8[2] | (at8[3] << 16); o.z = at8[4] | (at8[5] << 16); o.w = at8[6] | (at8[7] << 16); *(LAS v4u*)(AtT + ch * 72 + j0) = o;
      o.x = v8[0] | (v8[1] << 16); o.y = v8[2] | (v8[3] << 16); o.z = v8[4] | (v8[5] << 16); o.w = v8[6] | (v8[7] << 16); *(LAS v4u*)(VT + ch * 72 + j0) = o;
      o.x = bt8[0] | (bt8[1] << 16); o.y = bt8[2] | (bt8[3] << 16); o.z = bt8[4] | (bt8[5] << 16); o.w = bt8[6] | (bt8[7] << 16); *(LAS v4u*)(BtT + ch * 72 + j0) = o;
      o.x = kt8[0] | (kt8[1] << 16); o.y = kt8[2] | (kt8[3] << 16); o.z = kt8[4] | (kt8[5] << 16); o.w = kt8[6] | (kt8[7] << 16); *(LAS v4u*)(KtT + ch * 72 + j0) = o; }
    LBAR();
    { const int n0 = (wave >> 1) * 16, r = lane & 15, q = lane >> 4, i = n0 + r;
#pragma unroll
      for (int mm = 0; mm < 2; ++mm) { const int m0 = (2 * (wave & 1) + mm) * 16;
          f32x4v ab = mm_tile(At, Bh, n0, m0, lane, z4), ak = mm_tile(At, Kh, n0, m0, lane, z4), rb = mm_tile(Rt, Bh, n0, m0, lane, z4), rkk = mm_tile(Rt, Kh, n0, m0, lane, z4);
#pragma unroll
          for (int e = 0; e < 4; ++e) { const int j = m0 + 4 * q + e; if (!(j < i)) { ab[e] = 0.f; ak[e] = 0.f; } if (!(j <= i)) { rb[e] = 0.f; rkk[e] = 0.f; } }
          *(LAS f32x4v*)(Fm + i * 68 + m0 + 4 * q) = ab; st_tile(Aak, n0, m0, lane, ak); st_tile(Arb, n0, m0, lane, rb); st_tile(Ark, n0, m0, lane, rkk); } }
    LBAR();
    if (wave < 4) {
        const int blk = wave, cc = lane & 15; const LAS float* Ab = Fm + (16 * blk) * 68 + 16 * blk;
        float sv[16]; f32x4v av[16][4];
#pragma unroll
        for (int i = 1; i < 16; ++i)
#pragma unroll
            for (int jq = 0; jq < 4; ++jq) if (4 * jq < i) av[i][jq] = *(const LAS f32x4v*)(Ab + i * 68 + 4 * jq);
#pragma unroll
        for (int i = 0; i < 16; ++i) sv[i] = (i == cc) ? 1.f : 0.f;
#pragma unroll
        for (int j = 0; j < 15; ++j) { const float tj = sv[j];
#pragma unroll
            for (int i = j + 1; i < 16; ++i) sv[i] += av[i][j >> 2][j & 3] * tj; }
        if (lane < 16) {
#pragma unroll
            for (int i = 0; i < 16; ++i) { Tf[(16 * blk + i) * 68 + 16 * blk + cc] = sv[i]; Tm[(16 * blk + i) * 72 + 16 * blk + cc] = (bf16)f2bf(sv[i]); } }
        asm volatile("s_waitcnt lgkmcnt(0)" ::: "memory");
#pragma unroll
        for (int bk = 0; bk < 3; ++bk) if (bk < blk) {
            const f32x4v d = blk16(Tf + (16 * blk) * 68 + 16 * blk, Fm + (16 * blk) * 68 + 16 * bk, lane, z4);
            const int r = lane & 15, q = lane >> 4;
#pragma unroll
            for (int e = 0; e < 4; ++e) Fm[(16 * blk + 4 * q + e) * 68 + 16 * bk + r] = d[e]; }
    } else {
        for (int tt = wave - 4; tt < 16; tt += 4) { const int n0 = (tt >> 2) * 16, m0 = (tt & 3) * 16; st_tile(XT, n0, m0, lane, mm_tile(VT, Aak, n0, m0, lane, z4)); }
        if (wave >= 5) { const int k0 = (wave - 5) * 2;
#pragma unroll
            for (int kk2 = 0; kk2 < 2; ++kk2) { const int k = k0 + kk2; const int bi = (k < 3) ? 0 : (k < 5 ? 1 : 2), bj = (k < 3) ? k + 1 : (k < 5 ? k - 1 : 3);
                st_tile(Tm, bi * 16, bj * 16, lane, z4); } }
    }
    LBAR();
#define RA_TOUT(bi, bj, d) do { const int r_ = lane & 15, q_ = lane >> 4; _Pragma("unroll") for (int e = 0; e < 4; ++e) { Tf[(16 * (bi) + 4 * q_ + e) * 68 + 16 * (bj) + r_] = d[e]; Tm[(16 * (bi) + 4 * q_ + e) * 72 + 16 * (bj) + r_] = (bf16)f2bf(d[e]); } } while (0)
#define RA_BLK(M_, bi, bj) ((M_) + (16 * (bi)) * 68 + 16 * (bj))
    if (wave < 3) { const int bi = wave + 1, bj = wave; const f32x4v d = blk16(RA_BLK(Fm, bi, bj), RA_BLK(Tf, bj, bj), lane, z4); RA_TOUT(bi, bj, d); }
    LBAR();
    if (wave < 2) { const int bi = wave + 2, bj = wave; f32x4v d = blk16(RA_BLK(Fm, bi, bj), RA_BLK(Tf, bj, bj), lane, z4); d = blk16(RA_BLK(Fm, bi, bj + 1), RA_BLK(Tf, bj + 1, bj), lane, d); RA_TOUT(bi, bj, d); }
    LBAR();
    if (wave == 0) { f32x4v d = blk16(RA_BLK(Fm, 3, 0), RA_BLK(Tf, 0, 0), lane, z4); d = blk16(RA_BLK(Fm, 3, 1), RA_BLK(Tf, 1, 0), lane, d); d = blk16(RA_BLK(Fm, 3, 2), RA_BLK(Tf, 2, 0), lane, d); RA_TOUT(3, 0, d); }
    LBAR();
#undef RA_TOUT
#undef RA_BLK
#pragma unroll
    for (int i = 0; i < 4; ++i) { const int tt = wave * 4 + i, arr = tt >> 4, n0 = ((tt >> 2) & 3) * 16, m0 = (tt & 3) * 16;
        st_tile(arr ? U0T : WT, n0, m0, lane, mm_tile(arr ? XT : AtT, Tm, n0, m0, lane, z4)); }
    LBAR();
    { bf16* gM = (bf16*)(ws + WS_MPT) + (size_t)chd * 4096; bf16* gN = (bf16*)(ws + WS_NM) + (size_t)chd * 4096; bf16* gQ = (bf16*)(ws + WS_QE) + (size_t)chd * 4096; bf16* gY = (bf16*)(ws + WS_Y0) + (size_t)chd * 4096;
      const int n0 = (wave >> 1) * 16;
#pragma unroll
      for (int mm = 0; mm < 2; ++mm) { const int m0 = (2 * (wave & 1) + mm) * 16;
          st_tile_g(gM, n0, m0, lane, mm_tile(BtT, WT, n0, m0, lane, z4));
          st_tile_g(gN, n0, m0, lane, mm_tile(VT, KtT, n0, m0, lane, mm_tile(U0T, BtT, n0, m0, lane, z4)));
          f32x4v qe = mm_tile(Arb, WT, n0, m0, lane, z4); { const v2u rw = *(const LAS v2u*)(Rt + (n0 + (lane & 15)) * 72 + m0 + 4 * (lane >> 4)); qe[0] += bflo(rw.x); qe[1] += bfhi(rw.x); qe[2] += bflo(rw.y); qe[3] += bfhi(rw.y); }
          st_tile_g(gQ, n0, m0, lane, qe);
          st_tile_g(gY, n0, m0, lane, mm_tile(Ark, VT, n0, m0, lane, mm_tile(Arb, U0T, n0, m0, lane, z4))); } }
    LBAR();
}
__device__ __forceinline__ void ra_item_of(int G, int it, int& b, int& c, int& h) {
    int id = it; if (G == 256) id = blockIdx.x * 32 + (it / 256);
    h = id & 7; const int bc = id >> 3; b = bc >> 7; c = bc & 127;
}
__device__ __forceinline__ void ph_rwkv_passA(Frame& F, unsigned char* ws) {
    const int NIT = NB * 128 * 8; int it = blockIdx.x; if (it >= NIT) return;
    int b, c, h; ra_item_of(F.G, it, b, c, h);
    RaPf pf; rwkv_pf_load(pf, F, b, c, h, ws);
#pragma unroll 1
    for (; it < NIT; it += F.G) {
        const int nit = it + F.G; int nb_ = b, nc_ = c, nh_ = h;
        if (nit < NIT) { ra_item_of(F.G, nit, nb_, nc_, nh_); rwkv_passA_item<true>(F, b, c, h, ws, pf, nb_, nc_, nh_); }
        else rwkv_passA_item<false>(F, b, c, h, ws, pf, nb_, nc_, nh_);
        b = nb_; c = nc_; h = nh_;
    }
}
constexpr int RB_SLOT = 11776, RB_NOFF = 9216, RB_GOFF = 11520, RB_R = 6, RB_NBATCH = 22;
struct RbThr { const unsigned char* p0; const unsigned char* p1; unsigned st0, st1; int d0, d1; bool has1; };
__device__ __forceinline__ void rb_piece(unsigned char* ws, int b, int h, int vq, int w, const unsigned char*& p, unsigned& st, int& d) {
    const size_t chd0 = (size_t)(b * 128 * 8 + h);
    if (w < 512) { p = (const unsigned char*)((const bf16*)(ws + WS_MPT) + chd0 * 4096) + 16 * w; st = 65536u; d = (w >> 3) * 144 + (w & 7) * 16; }
    else if (w < 640) { p = (const unsigned char*)((const bf16*)(ws + WS_NM) + chd0 * 4096 + (size_t)vq * 16 * 64) + 16 * (w - 512); st = 65536u; d = RB_NOFF + ((w - 512) >> 3) * 144 + ((w - 512) & 7) * 16; }
    else { p = (const unsigned char*)((const float*)(ws + WS_GCE) + chd0 * 64) + 16 * (w - 640); st = 2048u; d = RB_GOFF + 16 * (w - 640); }
}
__device__ __forceinline__ void rb_issue(v4u (&reg)[2 * RB_R], const RbThr& th, int batch) {
#pragma unroll
    for (int cs = 0; cs < RB_R; ++cs) { int c = batch * RB_R + cs; if (c > 127) c = 127;
        reg[2 * cs] = *(const v4u*)(th.p0 + (size_t)c * th.st0); reg[2 * cs + 1] = (v4u){0u, 0u, 0u, 0u}; if (th.has1) reg[2 * cs + 1] = *(const v4u*)(th.p1 + (size_t)c * th.st1); }
}
__device__ __forceinline__ void rb_commit(const v4u (&reg)[2 * RB_R], const RbThr& th, LAS unsigned char* ring, int half) {
#pragma unroll
    for (int cs = 0; cs < RB_R; ++cs) { LAS unsigned char* slot = ring + (half * RB_R + cs) * RB_SLOT; *(LAS v4u*)(slot + th.d0) = reg[2 * cs]; if (th.has1) *(LAS v4u*)(slot + th.d1) = reg[2 * cs + 1]; }
}
struct RbLds { v2u lo[4][2], hi[4][2], nn[4]; f32x4v ge[4]; };
__device__ __forceinline__ void rb_lds(RbLds& o, const LAS unsigned char* slot, int r, int q) {
#pragma unroll
    for (int mt = 0; mt < 4; ++mt) {
#pragma unroll
        for (int s2 = 0; s2 < 2; ++s2) { const LAS unsigned char* rowp = slot + (16 * mt + r) * 144 + (32 * s2 + 4 * q) * 2; o.lo[mt][s2] = *(const LAS v2u*)rowp; o.hi[mt][s2] = *(const LAS v2u*)(rowp + 32); }
        o.nn[mt] = *(const LAS v2u*)(slot + RB_NOFF + r * 144 + (16 * mt + 4 * q) * 2); o.ge[mt] = *(const LAS f32x4v*)(slot + RB_GOFF + (16 * mt + 4 * q) * 4); }
}
__device__ __forceinline__ void ph_rwkv_passB(Frame& F, unsigned char* ws) {
    const int lane = F.lane, r = lane & 15, q = lane >> 4, wave = F.wave; LAS unsigned char* ring = F.lds;
    for (int task0 = blockIdx.x; task0 < NB * 8 * 4; task0 += F.G) {
        int task = task0; if (F.G == 256) { const int xcd = task0 & 7, sl = task0 >> 3; task = (xcd * 8 + (sl >> 2)) * 4 + (sl & 3); }
        const int vq = task & 3, h = (task >> 2) & 7, b = task >> 5, v = vq * 16 + r; const int lt = (F.tid >= 64) ? F.tid - 64 : 0;
        f32x4v S[4];
#pragma unroll
        for (int mt = 0; mt < 4; ++mt) S[mt] = (f32x4v){0.f, 0.f, 0.f, 0.f};
        RbThr th; rb_piece(ws, b, h, vq, lt, th.p0, th.st0, th.d0); th.has1 = (lt + 448) < 656; rb_piece(ws, b, h, vq, th.has1 ? lt + 448 : lt, th.p1, th.st1, th.d1);
        if (wave != 0) {
            v4u ra[2 * RB_R];
            rb_issue(ra, th, 0); rb_commit(ra, th, ring, 0); rb_issue(ra, th, 1);
            LBAR();
#pragma unroll 1
            for (int k = 0; k < RB_NBATCH; ++k) { rb_commit(ra, th, ring, (k & 1) ^ 1); rb_issue(ra, th, k + 2); LBAR(); }
        } else {
            __builtin_amdgcn_s_waitcnt(0x0F70);
            LBAR();
#pragma unroll 1
            for (int k = 0; k < RB_NBATCH; ++k) { const LAS unsigned char* half = ring + ((k & 1) * RB_R) * RB_SLOT;
                RbLds cur; rb_lds(cur, half, r, q);
#pragma unroll
                for (int cs = 0; cs < RB_R; ++cs) { const int c = k * RB_R + cs;
                    RbLds nxt; if (cs + 1 < RB_R) rb_lds(nxt, half + (cs + 1) * RB_SLOT, r, q);
                    v2u sb[4];
#pragma unroll
                    for (int mt = 0; mt < 4; ++mt) { sb[mt].x = pk2(S[mt][0], S[mt][1]); sb[mt].y = pk2(S[mt][2], S[mt][3]); }
                    if (c < 128) { bf16* gS = (bf16*)(ws + WS_S0) + (size_t)((b * 128 + c) * 8 + h) * 4096;
#pragma unroll
                        for (int mt = 0; mt < 4; ++mt) gstore8_nowait(gS + v * 64 + 16 * mt + 4 * q, sb[mt]); }
                    bf16x8 bfr[2];
#pragma unroll
                    for (int s2 = 0; s2 < 2; ++s2) { v4u w; w.x = sb[2 * s2].x; w.y = sb[2 * s2].y; w.z = sb[2 * s2 + 1].x; w.w = sb[2 * s2 + 1].y; bfr[s2] = __builtin_bit_cast(bf16x8, w); }
#pragma unroll
                    for (int mt = 0; mt < 4; ++mt) { f32x4v d = {0.f, 0.f, 0.f, 0.f};
#pragma unroll
                        for (int s2 = 0; s2 < 2; ++s2) { v4u w; w.x = cur.lo[mt][s2].x; w.y = cur.lo[mt][s2].y; w.z = cur.hi[mt][s2].x; w.w = cur.hi[mt][s2].y;
                            d = __builtin_amdgcn_mfma_f32_16x16x32_bf16(__builtin_bit_cast(bf16x8, w), bfr[s2], d, 0, 0, 0); }
                        S[mt][0] = S[mt][0] * cur.ge[mt][0] + d[0] + bflo(cur.nn[mt].x); S[mt][1] = S[mt][1] * cur.ge[mt][1] + d[1] + bfhi(cur.nn[mt].x);
                        S[mt][2] = S[mt][2] * cur.ge[mt][2] + d[2] + bflo(cur.nn[mt].y); S[mt][3] = S[mt][3] * cur.ge[mt][3] + d[3] + bfhi(cur.nn[mt].y); }
                    if (cs + 1 < RB_R) cur = nxt; }
                LBAR();
            }
        }
    }
}
constexpr int RC_LD = 136, RC_BYTES = 65 * RC_LD * 2;
__device__ __forceinline__ void ph_rwkv_passC(Frame& F, unsigned char* ws) {
    const int lane = F.lane, r = lane & 15, q = lane >> 4; const bf16* P = F.PROJ;
    LAS bf16* VG = (LAS bf16*)(F.lds + F.wave * RC_BYTES);
    const int gwv = blockIdx.x * NWAVES + F.wave, NGW = F.G * NWAVES;
    for (int it = gwv; it < NB * 128 * 8; it += NGW) {
        int id = it; if (F.G == 256) id = blockIdx.x * 32 + (it / NGW) * 8 + F.wave;
        const int h = id & 7, bc = id >> 3, b = bc >> 7, c = bc & 127; const size_t chd = (size_t)id;
        const bf16* gQ = (const bf16*)(ws + WS_QE) + chd * 4096; const bf16* gY = (const bf16*)(ws + WS_Y0) + chd * 4096; const bf16* gS = (const bf16*)(ws + WS_S0) + chd * 4096;
        const long rowbase = (long)b * T + c * 64;
        v4u vp[9], gp[9];
#pragma unroll
        for (int k = 0; k < 9; ++k) { const int idx = lane + 64 * k; vp[k] = (v4u){0u, 0u, 0u, 0u}; gp[k] = (v4u){0u, 0u, 0u, 0u};
            if (idx < 520) { const int row = idx >> 3, p8 = idx & 7; if (row > 0 || c > 0) { const bf16* src = P + (rowbase - 1 + row) * P0LD + h * 64 + 8 * p8; vp[k] = *(const v4u*)(src + C_V); gp[k] = *(const v4u*)(src + C_GA); } } }
        bf16x8 sf[4][2];
#pragma unroll
        for (int mt = 0; mt < 4; ++mt)
#pragma unroll
            for (int s = 0; s < 2; ++s) sf[mt][s] = *(const bf16x8*)(gS + (16 * mt + r) * 64 + 32 * s + 8 * q);
        f32x4v lnw[4], lnb[4], muv[4], mug[4];
#pragma unroll
        for (int mt = 0; mt < 4; ++mt) { const int cg = h * 64 + 16 * mt + 4 * q; lnw[mt] = *(const f32x4v*)(F.a_ln_w + cg); lnb[mt] = *(const f32x4v*)(F.a_ln_b + cg);
            muv[mt] = *(const f32x4v*)(F.a_mu + C_V + cg); mug[mt] = *(const f32x4v*)(F.a_mu + C_GA + cg); }
#pragma unroll
        for (int k = 0; k < 9; ++k) { const int idx = lane + 64 * k; if (idx < 520) { const int row = idx >> 3, p8 = idx & 7; *(LAS v4u*)(VG + row * RC_LD + 8 * p8) = vp[k]; *(LAS v4u*)(VG + row * RC_LD + 64 + 8 * p8) = gp[k]; } }
#pragma unroll 1
        for (int nt = 0; nt < 4; ++nt) {
            const int i = 16 * nt + r; const long t = rowbase + i;
            bf16x8 qf[2];
#pragma unroll
            for (int s = 0; s < 2; ++s) qf[s] = *(const bf16x8*)(gQ + i * 64 + 32 * s + 8 * q);
            v2u y0w[4];
#pragma unroll
            for (int mt = 0; mt < 4; ++mt) y0w[mt] = *(const v2u*)(gY + i * 64 + 16 * mt + 4 * q);
            const float ct = ((const float*)(ws + WS_CT))[t * 8 + h];
            f32x4v y[4]; float sum = 0.f;
#pragma unroll
            for (int mt = 0; mt < 4; ++mt) { const v2u y0 = y0w[mt];
                f32x4v d = {bflo(y0.x), bfhi(y0.x), bflo(y0.y), bfhi(y0.y)};
#pragma unroll
                for (int s = 0; s < 2; ++s) d = __builtin_amdgcn_mfma_f32_16x16x32_bf16(sf[mt][s], qf[s], d, 0, 0, 0);
                y[mt] = d; sum += (d[0] + d[1]) + (d[2] + d[3]); }
            sum += __shfl_xor(sum, 16); sum += __shfl_xor(sum, 32);
            const float mean = sum * (1.f / 64.f); float sq = 0.f;
#pragma unroll
            for (int mt = 0; mt < 4; ++mt)
#pragma unroll
                for (int e = 0; e < 4; ++e) { const float dd = y[mt][e] - mean; y[mt][e] = dd; sq += dd * dd; }
            sq += __shfl_xor(sq, 16); sq += __shfl_xor(sq, 32);
            const float rstd = __builtin_amdgcn_rsqf(sq * (1.f / 64.f) + 64e-5f);
#pragma unroll
            for (int mt = 0; mt < 4; ++mt) { const int col = h * 64 + 16 * mt + 4 * q;
                const LAS bf16* lp = VG + i * RC_LD + 16 * mt + 4 * q;
                const v2u pv = *(const LAS v2u*)lp, pg = *(const LAS v2u*)(lp + 64), cv = *(const LAS v2u*)(lp + RC_LD), cgt = *(const LAS v2u*)(lp + RC_LD + 64);
                const float cvf[4] = {bflo(cv.x), bfhi(cv.x), bflo(cv.y), bfhi(cv.y)}, pvf[4] = {bflo(pv.x), bfhi(pv.x), bflo(pv.y), bfhi(pv.y)};
                const float cgf[4] = {bflo(cgt.x), bfhi(cgt.x), bflo(cgt.y), bfhi(cgt.y)}, pgf[4] = {bflo(pg.x), bfhi(pg.x), bflo(pg.y), bfhi(pg.y)};
                float o[4];
#pragma unroll
                for (int e = 0; e < 4; ++e) { const float vs = cvf[e] + muv[mt][e] * (pvf[e] - cvf[e]), gs = cgf[e] + mug[mt][e] * (pgf[e] - cgf[e]);
                    o[e] = (y[mt][e] * rstd * lnw[mt][e] + lnb[mt][e] + ct * vs) * siluf_(gs); }
                v2u ow; ow.x = pk2(o[0], o[1]); ow.y = pk2(o[2], o[3]);
                *(v2u*)(F.HB + (size_t)t * D + col) = ow; }
        }
    }
}
constexpr size_t WS_OB = 32 * MiB  , WS_GAM = 928 * MiB, WS_SSQ = 936 * MiB;
__device__ __forceinline__ void ph_hgrn_prep(Frame& F, unsigned char* ws) {
    const int gw = F.vcu * NWAVES + F.wave, NGW = F.G * NWAVES, lane = F.lane;
    bf16* P = F.PROJ; float* gam = (float*)(ws + WS_GAM);
    for (int task = gw; task < (M / 64) * 2; task += NGW) {
        const int bc = task >> 1, c0 = (task & 1) * 512 + 8 * lane;
        const f32x4 l0 = *(const f32x4*)(F.lb_tab + c0), l1 = *(const f32x4*)(F.lb_tab + c0 + 4); const float lb[8] = {l0[0], l0[1], l0[2], l0[3], l1[0], l1[1], l1[2], l1[3]};
        float run[8];
#pragma unroll
        for (int e = 0; e < 8; ++e) run[e] = 1.f;
        bf16* p = P + (size_t)bc * 64 * P1LD + c0;
#pragma unroll 4
        for (int j = 0; j < 64; ++j) { const v4u qw = *(const v4u*)(p + (size_t)j * P1LD), fw = *(const v4u*)(p + (size_t)j * P1LD + 1024);
            float qd[8], ki[8];
#pragma unroll
            for (int e = 0; e < 8; ++e) { const float qv = (e & 1) ? bfhi(qw[e >> 1]) : bflo(qw[e >> 1]), fv = (e & 1) ? bfhi(fw[e >> 1]) : bflo(fw[e >> 1]);
                const float a = __expf(fminf(-fv, 40.f)), bq_ = __expf(fminf(-qv, 40.f)); const float rab = frcp((1.0f + a) * (1.0f + bq_));
                const float sg = rab * (1.0f + bq_), sq = rab * (1.0f + a); run[e] *= (1.0f + lb[e] * a) * sg;
                qd[e] = qv * sq * run[e]; ki[e] = (1.0f - lb[e]) * a * sg * frcp(run[e]); }
            v4u qo, ko;
#pragma unroll
            for (int e = 0; e < 4; ++e) { qo[e] = pk2(qd[2 * e], qd[2 * e + 1]); ko[e] = pk2(ki[2 * e], ki[2 * e + 1]); }
            *(v4u*)(p + (size_t)j * P1LD) = qo; *(v4u*)(p + (size_t)j * P1LD + 1024) = ko; }
        f32x4 g0, g1;
#pragma unroll
        for (int e = 0; e < 4; ++e) { g0[e] = run[e]; g1[e] = run[4 + e]; }
        *(f32x4*)(gam + (size_t)bc * 1024 + c0) = g0; *(f32x4*)(gam + (size_t)bc * 1024 + c0 + 4) = g1;
    }
}
typedef short v4s __attribute__((ext_vector_type(4)));
__device__ __forceinline__ bf16x8 tr_frag(const LAS bf16* Mx, int ld, int j0, int c0, int lane) {
    const int q = lane >> 4, i = lane & 15; const LAS bf16* a = Mx + (j0 + 8 * q + (i >> 2)) * ld + c0 + 4 * (i & 3);
    const v4s lo = __builtin_amdgcn_ds_read_tr16_b64_v4i16((LAS v4s*)a), hi = __builtin_amdgcn_ds_read_tr16_b64_v4i16((LAS v4s*)(a + 4 * ld));
    return (bf16x8){lo[0], lo[1], lo[2], lo[3], hi[0], hi[1], hi[2], hi[3]};
}
__device__ __forceinline__ bf16x8 tr_frag_perm(const LAS bf16* Mx, int ld, int s2, int c0, int lane) {
    const int q = lane >> 4, i = lane & 15; const LAS bf16* a = Mx + (32 * s2 + 4 * q + (i >> 2)) * ld + c0 + 4 * (i & 3);
    const v4s lo = __builtin_amdgcn_ds_read_tr16_b64_v4i16((LAS v4s*)a), hi = __builtin_amdgcn_ds_read_tr16_b64_v4i16((LAS v4s*)(a + 16 * ld));
    return (bf16x8){lo[0], lo[1], lo[2], lo[3], hi[0], hi[1], hi[2], hi[3]};
}
constexpr int HG_QD = 0, HG_KI = 34816, HG_VS = 69632, HG_ST = 79872, HG_GAM = 97280;
__device__ __forceinline__ void ph_hgrn_chunk(Frame& F, unsigned char* ws) {
    LAS unsigned char* L = F.lds; const int tid = F.tid, lane = F.lane, wave = F.wave, r = lane & 15, q = lane >> 4;
    const bf16* P = F.PROJ; const float* gam = (const float*)(ws + WS_GAM); bf16* OB = (bf16*)(ws + WS_OB); float* SSQ = (float*)(ws + WS_SSQ);
    for (int task0 = blockIdx.x; task0 < NB * 8 * 4; task0 += F.G) {
        int task = task0; if (F.G == 256) { const int xcd = task0 & 7, sl = task0 >> 3; task = (xcd * 8 + (sl >> 2)) * 4 + (sl & 3); }
        const int vq = task & 3, h = (task >> 2) & 7, b = task >> 5, ib = wave >> 1, vt = wave & 1;
        f32x4v S[2]; S[0] = (f32x4v){0.f, 0.f, 0.f, 0.f}; S[1] = S[0];
        for (int u = tid; u < 8704 / 4; u += NTHR) ((LAS unsigned*)(L + HG_ST))[u] = 0u;
        const int prow0 = tid >> 4, pc = tid & 15, vrow = tid >> 2, vpc = tid & 3;
        v4u rqA[2], rkA[2], rvA = {0u, 0u, 0u, 0u}, rqB[2], rkB[2], rvB = {0u, 0u, 0u, 0u}; float rgA = 0.f, rgB = 0.f;
#define HG_LOAD(c_, rq, rk, rv, rg) do { const size_t rb_ = (size_t)b * T + (size_t)(c_) * 64; \
            _Pragma("unroll") for (int i_ = 0; i_ < 2; ++i_) { const bf16* s_ = P + (rb_ + prow0 + 32 * i_) * P1LD + h * 128 + 8 * pc; rq[i_] = *(const v4u*)s_; rk[i_] = *(const v4u*)(s_ + 1024); } \
            if (wave < 4) rv = *(const v4u*)(P + (rb_ + vrow) * P1LD + 2048 + h * 128 + vq * 32 + 8 * vpc); \
            if (wave < 2) rg = gam[((size_t)b * 128 + (c_)) * 1024 + h * 128 + tid]; } while (0)
#define HG_STAGE(bufi, rq, rk, rv, rg) do { LAS bf16* QDs_ = (LAS bf16*)(L + HG_QD + (bufi) * 17408); LAS bf16* KIs_ = (LAS bf16*)(L + HG_KI + (bufi) * 17408); \
            _Pragma("unroll") for (int i_ = 0; i_ < 2; ++i_) { *(LAS v4u*)(QDs_ + (prow0 + 32 * i_) * 136 + 8 * pc) = rq[i_]; *(LAS v4u*)(KIs_ + (prow0 + 32 * i_) * 136 + 8 * pc) = rk[i_]; } \
            if (wave < 4) *(LAS v4u*)((LAS bf16*)(L + HG_VS + (bufi) * 5120) + vrow * 40 + 8 * vpc) = rv; \
            if (wave < 2) ((LAS float*)(L + HG_GAM + (bufi) * 512))[tid] = rg; } while (0)
        HG_LOAD(0, rqA, rkA, rvA, rgA); HG_LOAD(1, rqB, rkB, rvB, rgB);
        HG_STAGE(0, rqA, rkA, rvA, rgA); HG_LOAD(2, rqA, rkA, rvA, rgA);
        LBAR();
#pragma unroll 1
        for (int c2 = 0; c2 < 128; c2 += 2) {
#pragma unroll
          for (int par = 0; par < 2; ++par) { const int c = c2 + par;
            if (c + 1 < 128) {
                if (par == 0) { HG_STAGE(1, rqB, rkB, rvB, rgB); if (c + 3 < 128) HG_LOAD(c + 3, rqB, rkB, rvB, rgB); }
                else { HG_STAGE(0, rqA, rkA, rvA, rgA); if (c + 3 < 128) HG_LOAD(c + 3, rqA, rkA, rvA, rgA); } }
            const LAS bf16* QD = (const LAS bf16*)(L + HG_QD + par * 17408); const LAS bf16* KI = (const LAS bf16*)(L + HG_KI + par * 17408); const LAS bf16* VS = (const LAS bf16*)(L + HG_VS + par * 5120);
            const LAS float* GAM = (const LAS float*)(L + HG_GAM + par * 512);
            const LAS bf16* STc = (const LAS bf16*)(L + HG_ST + par * 8704); LAS bf16* STn = (LAS bf16*)(L + HG_ST + (par ^ 1) * 8704);
            bf16x8 bq[4], kf[4][4], stf[4], vtf[2], ktf[2][2];
#pragma unroll
            for (int s = 0; s < 4; ++s) bq[s] = *(const LAS bf16x8*)(QD + (16 * ib + r) * 136 + 32 * s + 8 * q);
            vtf[0] = tr_frag_perm(VS, 40, 0, 16 * vt, lane); vtf[1] = tr_frag_perm(VS, 40, 1, 16 * vt, lane);
#pragma unroll
            for (int jt = 0; jt < 4; ++jt) if (jt <= ib) {
#pragma unroll
                for (int s = 0; s < 4; ++s) kf[jt][s] = *(const LAS bf16x8*)(KI + (16 * jt + r) * 136 + 32 * s + 8 * q); }
#pragma unroll
            for (int s = 0; s < 4; ++s) stf[s] = *(const LAS bf16x8*)(STc + (16 * vt + r) * 136 + 32 * s + 8 * q);
#pragma unroll
            for (int k2 = 0; k2 < 2; ++k2) { ktf[k2][0] = tr_frag_perm(KI, 136, 0, (2 * ib + k2) * 16, lane); ktf[k2][1] = tr_frag_perm(KI, 136, 1, (2 * ib + k2) * 16, lane); }
            const f32x4v g0 = *(const LAS f32x4v*)(GAM + (2 * ib) * 16 + 4 * q), g1 = *(const LAS f32x4v*)(GAM + (2 * ib + 1) * 16 + 4 * q);
            __builtin_amdgcn_sched_barrier(0);
            f32x4v sc[4];
#pragma unroll
            for (int jt = 0; jt < 4; ++jt) { f32x4v d = {0.f, 0.f, 0.f, 0.f};
                if (jt <= ib) {
#pragma unroll
                    for (int s = 0; s < 4; ++s) d = __builtin_amdgcn_mfma_f32_16x16x32_bf16(kf[jt][s], bq[s], d, 0, 0, 0);
                    if (jt == ib) {
#pragma unroll
                        for (int e = 0; e < 4; ++e) if (4 * q + e > r) d[e] = 0.f; } }
                sc[jt] = d; }
            f32x4v o = {0.f, 0.f, 0.f, 0.f};
#pragma unroll
            for (int s = 0; s < 4; ++s) o = __builtin_amdgcn_mfma_f32_16x16x32_bf16(stf[s], bq[s], o, 0, 0, 0);
#pragma unroll
            for (int k2 = 0; k2 < 2; ++k2) { f32x4v d = S[k2];
                d = __builtin_amdgcn_mfma_f32_16x16x32_bf16(ktf[k2][0], vtf[0], d, 0, 0, 0);
                d = __builtin_amdgcn_mfma_f32_16x16x32_bf16(ktf[k2][1], vtf[1], d, 0, 0, 0);
                d = d * (k2 ? g1 : g0); S[k2] = d;
                v2u w; w.x = pk2(d[0], d[1]); w.y = pk2(d[2], d[3]); *(LAS v2u*)(STn + (16 * vt + r) * 136 + (2 * ib + k2) * 16 + 4 * q) = w; }
#pragma unroll
            for (int s2 = 0; s2 < 2; ++s2) { v4u w; w.x = pk2(sc[2 * s2][0], sc[2 * s2][1]); w.y = pk2(sc[2 * s2][2], sc[2 * s2][3]); w.z = pk2(sc[2 * s2 + 1][0], sc[2 * s2 + 1][1]); w.w = pk2(sc[2 * s2 + 1][2], sc[2 * s2 + 1][3]);
                o = __builtin_amdgcn_mfma_f32_16x16x32_bf16(vtf[s2], __builtin_bit_cast(bf16x8, w), o, 0, 0, 0); }
            { const size_t t = (size_t)b * T + (size_t)c * 64 + 16 * ib + r;
              v2u w; w.x = pk2(o[0], o[1]); w.y = pk2(o[2], o[3]); *(v2u*)(OB + t * D + h * 128 + vq * 32 + 16 * vt + 4 * q) = w;
              float ss = (o[0] * o[0] + o[1] * o[1]) + (o[2] * o[2] + o[3] * o[3]); ss += __shfl_xor(ss, 16); ss += __shfl_xor(ss, 32);
              if (q == 0) SSQ[(t * 8 + h) * 8 + vq * 2 + vt] = ss; }
            LBAR();
          }
        }
#undef HG_LOAD
#undef HG_STAGE
    }
}
__device__ __forceinline__ void hgrn_prep_local(Frame& F, unsigned char* ws, int b, int h, int cbeg, int ncks) {
    const int lane = F.lane; bf16* P = F.PROJ; float* gam = (float*)(ws + WS_GAM);
    for (int ck = 4 * F.wave + (lane >> 4); ck < ncks; ck += 4 * NWAVES) {
        const int bc = b * 128 + cbeg + ck, c0 = h * 128 + 8 * (lane & 15);
        const f32x4 l0 = *(const f32x4*)(F.lb_tab + c0), l1 = *(const f32x4*)(F.lb_tab + c0 + 4); const float lb[8] = {l0[0], l0[1], l0[2], l0[3], l1[0], l1[1], l1[2], l1[3]};
        float run[8];
#pragma unroll
        for (int e = 0; e < 8; ++e) run[e] = 1.f;
        bf16* p = P + (size_t)bc * 64 * P1LD + c0;
#pragma unroll 4
        for (int j = 0; j < 64; ++j) { const v4u qw = *(const v4u*)(p + (size_t)j * P1LD), fw = *(const v4u*)(p + (size_t)j * P1LD + 1024);
            float qd[8], ki[8];
#pragma unroll
            for (int e = 0; e < 8; ++e) { const float qv = (e & 1) ? bfhi(qw[e >> 1]) : bflo(qw[e >> 1]), fv = (e & 1) ? bfhi(fw[e >> 1]) : bflo(fw[e >> 1]);
                const float a = __expf(fminf(-fv, 40.f)), bq_ = __expf(fminf(-qv, 40.f)); const float rab = frcp((1.0f + a) * (1.0f + bq_));
                const float sg = rab * (1.0f + bq_), sq = rab * (1.0f + a); run[e] *= (1.0f + lb[e] * a) * sg;
                qd[e] = qv * sq * run[e]; ki[e] = (1.0f - lb[e]) * a * sg * frcp(run[e]); }
            v4u qo, ko;
#pragma unroll
            for (int e = 0; e < 4; ++e) { qo[e] = pk2(qd[2 * e], qd[2 * e + 1]); ko[e] = pk2(ki[2 * e], ki[2 * e + 1]); }
            *(v4u*)(p + (size_t)j * P1LD) = qo; *(v4u*)(p + (size_t)j * P1LD + 1024) = ko; }
        f32x4 g0, g1;
#pragma unroll
        for (int e = 0; e < 4; ++e) { g0[e] = run[e]; g1[e] = run[4 + e]; }
        *(f32x4*)(gam + (size_t)bc * 1024 + c0) = g0; *(f32x4*)(gam + (size_t)bc * 1024 + c0 + 4) = g1;
    }
}
constexpr int FQ_QD = 0, FQ_KI = 34816, FQ_VS = 69632, FQ_ST = 104448, FQ_GAM = 139264, FQ_G = 140288;
constexpr int HG_NSEG = 4, HG_CPS = 128 / HG_NSEG;
constexpr size_t WS_SEND = 960 * MiB, WS_GSEG = 980 * MiB, WS_GV = 982 * MiB;
__device__ __forceinline__ void ph_hgrn_fat(Frame& F, unsigned char* ws) {
    LAS unsigned char* L = F.lds; const int tid = F.tid, lane = F.lane, wave = F.wave, r = lane & 15, q = lane >> 4;
    const bf16* P = F.PROJ; const float* gam = (const float*)(ws + WS_GAM); bf16* OB = (bf16*)(ws + WS_OB);
    for (int task = blockIdx.x; task < NB * 8 * HG_NSEG; task += F.G) {
        const int seg = task % HG_NSEG, bh = task / HG_NSEG, h = bh & 7, b = bh >> 3, ib = wave >> 1, vh = wave & 1, cbeg = seg * HG_CPS;
        hgrn_prep_local(F, ws, b, h, cbeg, HG_CPS);
        __syncthreads();
        f32x4v S[2][4];
#pragma unroll
        for (int k2 = 0; k2 < 2; ++k2)
#pragma unroll
            for (int vt = 0; vt < 4; ++vt) S[k2][vt] = (f32x4v){0.f, 0.f, 0.f, 0.f};
        float gprod = 1.f;
        for (int u = tid; u < 34816 / 4; u += NTHR) ((LAS unsigned*)(L + FQ_ST))[u] = 0u;
        const int prow0 = tid >> 4, pc = tid & 15;
        v4u rqA[2], rkA[2], rvA[2]; float rgA = 0.f;
#define HF_LOAD(c_, rq, rk, rv, rg) do { const size_t rb_ = (size_t)b * T + (size_t)(cbeg + (c_)) * 64; \
            _Pragma("unroll") for (int i_ = 0; i_ < 2; ++i_) { const bf16* s_ = P + (rb_ + prow0 + 32 * i_) * P1LD + h * 128 + 8 * pc; rq[i_] = *(const v4u*)s_; rk[i_] = *(const v4u*)(s_ + 1024); rv[i_] = *(const v4u*)(s_ + 2048); } \
            if (wave < 2) rg = gam[((size_t)b * 128 + cbeg + (c_)) * 1024 + h * 128 + tid]; } while (0)
#define HF_STAGE(bufi, rq, rk, rv, rg) do { LAS bf16* QDs_ = (LAS bf16*)(L + FQ_QD + (bufi) * 17408); LAS bf16* KIs_ = (LAS bf16*)(L + FQ_KI + (bufi) * 17408); LAS bf16* VSs_ = (LAS bf16*)(L + FQ_VS + (bufi) * 17408); \
            _Pragma("unroll") for (int i_ = 0; i_ < 2; ++i_) { const int o_ = (prow0 + 32 * i_) * 136 + 8 * pc; *(LAS v4u*)(QDs_ + o_) = rq[i_]; *(LAS v4u*)(KIs_ + o_) = rk[i_]; *(LAS v4u*)(VSs_ + o_) = rv[i_]; } \
            if (wave < 2) { ((LAS float*)(L + FQ_GAM + (bufi) * 512))[tid] = rg; gprod *= rg; } } while (0)
        HF_LOAD(0, rqA, rkA, rvA, rgA);
        HF_STAGE(0, rqA, rkA, rvA, rgA); HF_LOAD(1, rqA, rkA, rvA, rgA);
        LBAR();
        LAS bf16* ST = (LAS bf16*)(L + FQ_ST);
#pragma unroll 1
        for (int c2 = 0; c2 < HG_CPS; c2 += 2) {
#pragma unroll
          for (int par = 0; par < 2; ++par) { const int c = c2 + par;
            if (c + 1 < HG_CPS) {
                HF_STAGE(par ^ 1, rqA, rkA, rvA, rgA); if (c + 2 < HG_CPS) HF_LOAD(c + 2, rqA, rkA, rvA, rgA); }
            const LAS bf16* QD = (const LAS bf16*)(L + FQ_QD + par * 17408); const LAS bf16* KI = (const LAS bf16*)(L + FQ_KI + par * 17408); const LAS bf16* VS = (const LAS bf16*)(L + FQ_VS + par * 17408);
            const LAS float* GAM = (const LAS float*)(L + FQ_GAM + par * 512);
            bf16x8 bq[4], kf[2][4], stf[4][4], vtf[4][2];
#pragma unroll
            for (int s = 0; s < 4; ++s) bq[s] = *(const LAS bf16x8*)(QD + (16 * ib + r) * 136 + 32 * s + 8 * q);
            f32x4v sc[4];
#pragma unroll
            for (int jh = 0; jh < 2; ++jh) {
#pragma unroll
                for (int j2 = 0; j2 < 2; ++j2) if (2 * jh + j2 <= ib) {
#pragma unroll
                    for (int s = 0; s < 4; ++s) kf[j2][s] = *(const LAS bf16x8*)(KI + (16 * (2 * jh + j2) + r) * 136 + 32 * s + 8 * q); }
                __builtin_amdgcn_sched_barrier(0);
#pragma unroll
                for (int j2 = 0; j2 < 2; ++j2) { const int jt = 2 * jh + j2; f32x4v d = {0.f, 0.f, 0.f, 0.f};
                    if (jt <= ib) {
#pragma unroll
                        for (int s = 0; s < 4; ++s) d = __builtin_amdgcn_mfma_f32_16x16x32_bf16(kf[j2][s], bq[s], d, 0, 0, 0);
                        if (jt == ib) {
#pragma unroll
                            for (int e = 0; e < 4; ++e) if (4 * q + e > r) d[e] = 0.f; } }
                    sc[jt] = d; }
                __builtin_amdgcn_sched_barrier(0); }
            bf16x8 pw[2];
#pragma unroll
            for (int s2 = 0; s2 < 2; ++s2) { v4u w; w.x = pk2(sc[2 * s2][0], sc[2 * s2][1]); w.y = pk2(sc[2 * s2][2], sc[2 * s2][3]); w.z = pk2(sc[2 * s2 + 1][0], sc[2 * s2 + 1][1]); w.w = pk2(sc[2 * s2 + 1][2], sc[2 * s2 + 1][3]);
                pw[s2] = __builtin_bit_cast(bf16x8, w); }
            __builtin_amdgcn_sched_barrier(0);
#pragma unroll
            for (int vt = 0; vt < 4; ++vt)
#pragma unroll
                for (int s = 0; s < 4; ++s) stf[vt][s] = *(const LAS bf16x8*)(ST + (64 * vh + 16 * vt + r) * 136 + 32 * s + 8 * q);
            __builtin_amdgcn_sched_barrier(0);
            f32x4v o[4];
#pragma unroll
            for (int vt = 0; vt < 4; ++vt) { f32x4v d = {0.f, 0.f, 0.f, 0.f};
#pragma unroll
                for (int s = 0; s < 4; ++s) d = __builtin_amdgcn_mfma_f32_16x16x32_bf16(stf[vt][s], bq[s], d, 0, 0, 0);
                o[vt] = d; }
            __builtin_amdgcn_sched_barrier(0);
#pragma unroll
            for (int vt = 0; vt < 4; ++vt) { vtf[vt][0] = tr_frag_perm(VS, 136, 0, 64 * vh + 16 * vt, lane); vtf[vt][1] = tr_frag_perm(VS, 136, 1, 64 * vh + 16 * vt, lane); }
            __builtin_amdgcn_sched_barrier(0);
#pragma unroll
            for (int vt = 0; vt < 4; ++vt)
#pragma unroll
                for (int s2 = 0; s2 < 2; ++s2) o[vt] = __builtin_amdgcn_mfma_f32_16x16x32_bf16(vtf[vt][s2], pw[s2], o[vt], 0, 0, 0);
            LBAR();
            { bf16x8 ktf[2][2];
#pragma unroll
              for (int k2 = 0; k2 < 2; ++k2) { ktf[k2][0] = tr_frag_perm(KI, 136, 0, (2 * ib + k2) * 16, lane); ktf[k2][1] = tr_frag_perm(KI, 136, 1, (2 * ib + k2) * 16, lane); }
              const f32x4v g0 = *(const LAS f32x4v*)(GAM + (2 * ib) * 16 + 4 * q), g1 = *(const LAS f32x4v*)(GAM + (2 * ib + 1) * 16 + 4 * q);
#pragma unroll
              for (int vt = 0; vt < 4; ++vt) { const int v0 = 64 * vh + 16 * vt; const bf16x8 vf0 = tr_frag_perm(VS, 136, 0, v0, lane), vf1 = tr_frag_perm(VS, 136, 1, v0, lane);
#pragma unroll
                for (int k2 = 0; k2 < 2; ++k2) { f32x4v d = S[k2][vt];
                    d = __builtin_amdgcn_mfma_f32_16x16x32_bf16(ktf[k2][0], vf0, d, 0, 0, 0);
                    d = __builtin_amdgcn_mfma_f32_16x16x32_bf16(ktf[k2][1], vf1, d, 0, 0, 0);
                    d = d * (k2 ? g1 : g0); S[k2][vt] = d;
                    v2u w; w.x = pk2(d[0], d[1]); w.y = pk2(d[2], d[3]); *(LAS v2u*)(ST + (v0 + r) * 136 + (2 * ib + k2) * 16 + 4 * q) = w; } } }
            { LAS bf16* OT = (LAS bf16*)(L + FQ_QD + par * 17408);
#pragma unroll
              for (int vt = 0; vt < 4; ++vt) { const f32x4v d = o[vt]; v2u w; w.x = pk2(d[0], d[1]); w.y = pk2(d[2], d[3]); *(LAS v2u*)(OT + (16 * ib + r) * 136 + 64 * vh + 16 * vt + 4 * q) = w; }
              LBAR();
              const size_t rb = (size_t)b * T + (size_t)(cbeg + c) * 64;
#pragma unroll
              for (int i_ = 0; i_ < 2; ++i_) *(v4u*)(OB + (rb + prow0 + 32 * i_) * D + h * 128 + 8 * pc) = *(const LAS v4u*)(OT + (prow0 + 32 * i_) * 136 + 8 * pc); }
          }
        }
#undef HF_LOAD
#undef HF_STAGE
        { float* se = (float*)(ws + WS_SEND) + (size_t)task * 16384;
#pragma unroll
          for (int k2 = 0; k2 < 2; ++k2)
#pragma unroll
              for (int vt = 0; vt < 4; ++vt) *(f32x4v*)(se + (64 * vh + 16 * vt + r) * 128 + (2 * ib + k2) * 16 + 4 * q) = S[k2][vt];
          if (wave < 2) ((float*)(ws + WS_GSEG))[(size_t)task * 128 + tid] = gprod; }
    }
}
__device__ __forceinline__ void ph_hgrn_post2(Frame& F, unsigned char* ws) {
    LAS unsigned char* L = F.lds; const int tid = F.tid, lane = F.lane, wave = F.wave, r = lane & 15, q = lane >> 4, ib = wave >> 1, vh = wave & 1;
    const bf16* P = F.PROJ; const bf16* OB = (const bf16*)(ws + WS_OB); const float* gam = (const float*)(ws + WS_GAM);
    LAS bf16* SI = (LAS bf16*)L; LAS float* XS = (LAS float*)(L + 140288);
    f32x4v cw[4];
#pragma unroll
    for (int vt = 0; vt < 4; ++vt) cw[vt] = *(const f32x4v*)(F.c_norm_w + 64 * vh + 16 * vt + 4 * q);
    const int prow0 = tid >> 4, pc = tid & 15;
    for (int task = blockIdx.x; task < NB * 8 * HG_NSEG; task += F.G) {
        const int seg = task % HG_NSEG, bh = task / HG_NSEG, h = bh & 7, b = bh >> 3, cbeg = seg * HG_CPS;
        LBAR();
        for (int u = tid; u < 128 * 32; u += NTHR) { const int v = u >> 5, k4 = (u & 31) * 4; f32x4v acc = {0.f, 0.f, 0.f, 0.f};
            for (int s1 = 0; s1 < seg; ++s1) { const size_t tk = (size_t)(bh * HG_NSEG + s1);
                const f32x4v gm = *(const f32x4v*)((const float*)(ws + WS_GSEG) + tk * 128 + k4), se = *(const f32x4v*)((const float*)(ws + WS_SEND) + tk * 16384 + v * 128 + k4); acc = acc * gm + se; }
            v2u w; w.x = pk2(acc[0], acc[1]); w.y = pk2(acc[2], acc[3]); *(LAS v2u*)(SI + v * 136 + k4) = w; }
        v4u rqA[2], roA[2], rtA[2]; f32x4v ggA[2], gr0 = {1.f, 1.f, 1.f, 1.f}, gr1 = gr0;
#pragma unroll
        for (int i = 0; i < 2; ++i) rqA[i] = (v4u){0u, 0u, 0u, 0u};
#define P2_LOAD(c_, rq, ro, rt, gg) do { const size_t rb_ = (size_t)b * T + (size_t)(cbeg + (c_)) * 64; \
            _Pragma("unroll") for (int i_ = 0; i_ < 2; ++i_) { const size_t row_ = rb_ + prow0 + 32 * i_; if (seg > 0) rq[i_] = *(const v4u*)(P + row_ * P1LD + h * 128 + 8 * pc); \
                ro[i_] = *(const v4u*)(OB + row_ * D + h * 128 + 8 * pc); rt[i_] = *(const v4u*)(P + row_ * P1LD + 3072 + h * 128 + 8 * pc); } \
            if (seg > 0) { const float* g_ = gam + ((size_t)b * 128 + cbeg + (c_)) * 1024 + h * 128 + 8 * pc; gg[0] = *(const f32x4v*)g_; gg[1] = *(const f32x4v*)(g_ + 4); } } while (0)
#define P2_STAGE(bufi, rq, ro, rt, gg) do { \
            _Pragma("unroll") for (int i_ = 0; i_ < 2; ++i_) { const int o_ = (prow0 + 32 * i_) * 136 + 8 * pc; v4u w_ = rq[i_]; \
                if (seg > 0) { w_.x = pk2(bflo(w_.x) * gr0[0], bfhi(w_.x) * gr0[1]); w_.y = pk2(bflo(w_.y) * gr0[2], bfhi(w_.y) * gr0[3]); w_.z = pk2(bflo(w_.z) * gr1[0], bfhi(w_.z) * gr1[1]); w_.w = pk2(bflo(w_.w) * gr1[2], bfhi(w_.w) * gr1[3]); } \
                *(LAS v4u*)((LAS bf16*)(L + 34816 + (bufi) * 17408) + o_) = w_; \
                *(LAS v4u*)((LAS bf16*)(L + 69632 + (bufi) * 17408) + o_) = ro[i_]; *(LAS v4u*)((LAS bf16*)(L + 104448 + (bufi) * 17408) + o_) = rt[i_]; } \
            if (seg > 0) { gr0 = gr0 * gg[0]; gr1 = gr1 * gg[1]; } } while (0)
        P2_LOAD(0, rqA, roA, rtA, ggA);
        P2_STAGE(0, rqA, roA, rtA, ggA); P2_LOAD(1, rqA, roA, rtA, ggA);
        LBAR();
#pragma unroll 1
        for (int c2 = 0; c2 < HG_CPS; c2 += 2) {
#pragma unroll
          for (int par = 0; par < 2; ++par) { const int c = c2 + par;
            if (c + 1 < HG_CPS) { P2_STAGE(par ^ 1, rqA, roA, rtA, ggA); if (c + 2 < HG_CPS) P2_LOAD(c + 2, rqA, roA, rtA, ggA); }
            const LAS bf16* TQ = (const LAS bf16*)(L + 34816 + par * 17408); LAS bf16* TO = (LAS bf16*)(L + 69632 + par * 17408); const LAS bf16* TG = (const LAS bf16*)(L + 104448 + par * 17408);
            v2u ovr[4]; bf16x8 bq_[4], sif[4][4];
#pragma unroll
            for (int vt = 0; vt < 4; ++vt) ovr[vt] = *(const LAS v2u*)(TO + (16 * ib + r) * 136 + 64 * vh + 16 * vt + 4 * q);
            if (seg > 0) {
#pragma unroll
                for (int s = 0; s < 4; ++s) bq_[s] = *(const LAS bf16x8*)(TQ + (16 * ib + r) * 136 + 32 * s + 8 * q);
#pragma unroll
                for (int vt = 0; vt < 4; ++vt)
#pragma unroll
                    for (int s = 0; s < 4; ++s) sif[vt][s] = *(const LAS bf16x8*)(SI + (64 * vh + 16 * vt + r) * 136 + 32 * s + 8 * q); }
            __builtin_amdgcn_sched_barrier(0);
            f32x4v o_[4];
#pragma unroll
            for (int vt = 0; vt < 4; ++vt) o_[vt] = (f32x4v){bflo(ovr[vt].x), bfhi(ovr[vt].x), bflo(ovr[vt].y), bfhi(ovr[vt].y)};
            if (seg > 0) {
#pragma unroll
                for (int vt = 0; vt < 4; ++vt) { f32x4v d_ = o_[vt];
#pragma unroll
                    for (int s = 0; s < 4; ++s) d_ = __builtin_amdgcn_mfma_f32_16x16x32_bf16(sif[vt][s], bq_[s], d_, 0, 0, 0);
                    o_[vt] = d_; } }
            float ss_ = 0.f;
#pragma unroll
            for (int vt = 0; vt < 4; ++vt) ss_ += (o_[vt][0] * o_[vt][0] + o_[vt][1] * o_[vt][1]) + (o_[vt][2] * o_[vt][2] + o_[vt][3] * o_[vt][3]);
            ss_ += __shfl_xor(ss_, 16); ss_ += __shfl_xor(ss_, 32);
            if (q == 0) XS[par * 128 + ib * 32 + vh * 16 + r] = ss_;
            LBAR();
            const float rs_ = __builtin_amdgcn_rsqf((XS[par * 128 + ib * 32 + r] + XS[par * 128 + ib * 32 + 16 + r]) * (1.f / 128.f) + 1e-6f);
#pragma unroll
            for (int vt = 0; vt < 4; ++vt) { const int off_ = (16 * ib + r) * 136 + 64 * vh + 16 * vt + 4 * q; const v2u tv = *(const LAS v2u*)(TG + off_);
                const float g0_ = bflo(tv.x), g1_ = bfhi(tv.x), g2_ = bflo(tv.y), g3_ = bfhi(tv.y); v2u w_;
                w_.x = pk2(o_[vt][0] * rs_ * cw[vt][0] * siluf_(g0_), o_[vt][1] * rs_ * cw[vt][1] * siluf_(g1_)); w_.y = pk2(o_[vt][2] * rs_ * cw[vt][2] * siluf_(g2_), o_[vt][3] * rs_ * cw[vt][3] * siluf_(g3_));
                *(LAS v2u*)(TO + off_) = w_; }
            LBAR();
            { const size_t rb_ = (size_t)b * T + (size_t)(cbeg + c) * 64;
#pragma unroll
              for (int i_ = 0; i_ < 2; ++i_) *(v4u*)(F.HB + (rb_ + prow0 + 32 * i_) * D + h * 128 + 8 * pc) = *(const LAS v4u*)(TO + (prow0 + 32 * i_) * 136 + 8 * pc); }
          }
        }
#undef P2_LOAD
#undef P2_STAGE
    }
}
__device__ __forceinline__ void ph_hgrn_post(Frame& F, unsigned char* ws) {
    const int gw = F.vcu * NWAVES + F.wave, NGW = F.G * NWAVES, lane = F.lane;
    const bf16* OB = (const bf16*)(ws + WS_OB); const float* SSQ = (const float*)(ws + WS_SSQ); const bf16* P = F.PROJ;
    const int hd = lane >> 3, c0 = 16 * lane;
    f32x4v cw[4];
#pragma unroll
    for (int i = 0; i < 4; ++i) cw[i] = *(const f32x4v*)(F.c_norm_w + (c0 & 127) + 4 * i);
    v4u a0[6], a1[6], b0[6], b1[6];
#define POST_LD(v, mm) do { if ((mm) < M) { const v4u* s_ = (const v4u*)(SSQ + ((size_t)(mm) * 8 + hd) * 8); v[0] = s_[0]; v[1] = s_[1]; \
        const v4u* o_ = (const v4u*)(OB + (size_t)(mm) * D + c0); v[2] = o_[0]; v[3] = o_[1]; const v4u* g_ = (const v4u*)(P + (size_t)(mm) * P1LD + 3072 + c0); v[4] = g_[0]; v[5] = g_[1]; } } while (0)
#define POST_PR(v, mm) do { if ((mm) < M) { const f32x4v s0_ = __builtin_bit_cast(f32x4v, v[0]), s1_ = __builtin_bit_cast(f32x4v, v[1]); \
        const float rs_ = __builtin_amdgcn_rsqf(((s0_[0] + s0_[1]) + (s0_[2] + s0_[3]) + (s1_[0] + s1_[1]) + (s1_[2] + s1_[3])) * (1.f / 128.f) + 1e-6f); \
        _Pragma("unroll") for (int i = 0; i < 2; ++i) { const v4u ow_ = v[2 + i], gw_ = v[4 + i]; v4u res_; \
            _Pragma("unroll") for (int e = 0; e < 4; ++e) { const float w0_ = cw[2 * i + (e >> 1)][2 * (e & 1)], w1_ = cw[2 * i + (e >> 1)][2 * (e & 1) + 1]; \
                res_[e] = pk2(bflo(ow_[e]) * rs_ * w0_ * siluf_(bflo(gw_[e])), bfhi(ow_[e]) * rs_ * w1_ * siluf_(bfhi(gw_[e]))); } \
            *(v4u*)(F.HB + (size_t)(mm) * D + c0 + 8 * i) = res_; } } } while (0)
    int m = gw; POST_LD(a0, m); POST_LD(a1, m + NGW);
#pragma unroll 1
    for (; m < M; m += 4 * NGW) {
        POST_LD(b0, m + 2 * NGW); POST_LD(b1, m + 3 * NGW);
        POST_PR(a0, m); POST_PR(a1, m + NGW);
        POST_LD(a0, m + 4 * NGW); POST_LD(a1, m + 5 * NGW);
        POST_PR(b0, m + 2 * NGW); POST_PR(b1, m + 3 * NGW);
    }
#undef POST_LD
#undef POST_PR
}
#ifndef MK_PER_PHASE
#define MK_PER_PHASE 0
#endif
#ifndef RWKV_NAIVE
#define RWKV_NAIVE 0
#endif
#ifndef HGRN_NAIVE
#define HGRN_NAIVE 0
#endif
constexpr int N_PHASES = 13;
struct Args { const float* in[23]; float* out; unsigned char* ws; int ph_lo, ph_hi; };
__global__ void __launch_bounds__(NTHR, 2) fwd_kernel(Args args) {
    extern __shared__ __attribute__((aligned(16))) unsigned char lds[];
    Frame F;
    F.lds = (LAS unsigned char*)lds;
    F.tid = threadIdx.x; F.lane = F.tid & 63; F.wave = __builtin_amdgcn_readfirstlane(F.tid >> 6);
    F.G = gridDim.x; { const int bx = blockIdx.x; F.vcu = (F.G % 8 == 0) ? (bx % 8) * (F.G / 8) + bx / 8 : bx; }
    unsigned char* ws = args.ws;
    F.x = args.in[0]; F.rel_bias = args.in[1]; F.lower_bounds = args.in[2]; F.pre0 = args.in[3]; F.post0 = args.in[4]; F.w_in0 = args.in[5]; F.w_out0 = args.in[6];
    F.a_mu = args.in[7]; F.a_w0 = args.in[8]; F.a_w2 = args.in[9]; F.a_a0 = args.in[10]; F.a_a2 = args.in[11]; F.a_k_k = args.in[12]; F.a_k_a = args.in[13]; F.a_r_k = args.in[14];
    F.a_ln_w = args.in[15]; F.a_ln_b = args.in[16]; F.sinks = args.in[17]; F.pre1 = args.in[18]; F.post1 = args.in[19]; F.w_in1 = args.in[20]; F.w_out1 = args.in[21]; F.c_norm_w = args.in[22];
    F.out = args.out;
    F.W0T = (bf16*)(ws + WS_W0T); F.WO0T = (bf16*)(ws + WS_WO0T); F.W1T = (bf16*)(ws + WS_W1T); F.WO1T = (bf16*)(ws + WS_WO1T);
    F.HA = (bf16*)(ws + WS_HA); F.HB = (bf16*)(ws + WS_HB); F.PROJ = (bf16*)(ws + WS_PROJ); F.Y = (bf16*)(ws + WS_Y);
    F.bias_tab = (float*)(ws + WS_TAB); F.lb_tab = (float*)(ws + WS_TAB + 4096);
    for (int u = F.tid; u < (LDS_BYTES - LDSCTL_OFF) / 4; u += NTHR) ((LAS unsigned*)(F.lds + LDSCTL_OFF))[u] = 0u;
    __syncthreads();
    const int lo = args.ph_lo, hi = args.ph_hi;
    XcdBarrier bar; bar.bar = (unsigned*)(ws + WS_CTL) + CW_BAR; bar.x = 0; bar.st = nullptr;
    if (hi - lo > 1) bar = xcd_barrier_post((unsigned*)(ws + WS_CTL) + CW_BAR, (volatile LAS unsigned*)(F.lds + MISC_OFF) + 8);
#define IN(k) (lo <= (k) && (k) < hi)
#define SEAM(k) do { if (IN(k) && IN((k) + 1)) xcd_barrier(bar); } while (0)
    if (IN(0)) { ph_prologue(F, ws); } SEAM(0);
    if (IN(1)) { pg8::Gemm g{F.HA, F.W0T, M, N0P, D}; pg8::StaticOrder S; S.init(M, N0P, F.G, (int)blockIdx.x); pg8::EpiBf16 E{F.PROJ, P0LD};
        pg8::gemm_phase<pg8::EpiBf16, pg8::StaticOrder, true, true>(F.lds, g, S, E); } SEAM(1);
#if RWKV_NAIVE
    if (IN(2)) { ph_attention(F); __syncthreads(); ph_rwkv_naive(F); } SEAM(2);
    SEAM(3);
    SEAM(4);
#else
    if (IN(2)) { ph_attention(F); __syncthreads(); ph_rwkv_passA(F, ws); } SEAM(2);
    if (IN(3)) { ph_rwkv_passB(F, ws); } SEAM(3);
    if (IN(4)) { ph_rwkv_passC(F, ws); } SEAM(4);
#endif
    if (IN(5)) { pg8::Gemm g{F.HB, F.WO0T, M, D, D}; pg8::StaticOrder S; S.init(M, D, F.G, (int)blockIdx.x); pg8::EpiBf16 E{F.Y, D};
        pg8::gemm_phase<pg8::EpiBf16, pg8::StaticOrder, true, true>(F.lds, g, S, E); } SEAM(5);
    if (IN(6)) { ph_resnorm0(F, F.x, F.Y, F.post0, F.pre1, F.HA); } SEAM(6);
    if (IN(7)) { pg8::Gemm g{F.HA, F.W1T, M, N1, D}; pg8::StaticOrder S; S.init(M, N1, F.G, (int)blockIdx.x); pg8::EpiBf16 E{F.PROJ, P1LD};
        pg8::gemm_phase<pg8::EpiBf16, pg8::StaticOrder, true, true>(F.lds, g, S, E); } SEAM(7);
#if HGRN_NAIVE
    if (IN(8)) { ph_hgrn_naive(F); } SEAM(8);
    SEAM(9);
    SEAM(10);
#else
    if (IN(9)) { ph_hgrn_fat(F, ws); } SEAM(9);
    if (IN(10)) { ph_hgrn_post2(F, ws); } SEAM(10);
#endif
    if (IN(11)) { pg8::Gemm g{F.HB, F.WO1T, M, D, D}; pg8::StaticOrder S; S.init(M, D, F.G, (int)blockIdx.x); pg8::EpiBf16 E{F.HA, D};
        pg8::gemm_phase<pg8::EpiBf16, pg8::StaticOrder, true, true>(F.lds, g, S, E); } SEAM(11);
    if (IN(12)) { ph_resnorm1(F, F.Y, F.HA, F.post1, F.out); }
#undef IN
#undef SEAM
}

extern "C" void kernel_launch(void* const* d_in, const int* in_sizes, int n_in, void* d_out, int out_size, void* d_ws, size_t ws_size, hipStream_t stream) {
    static int grid = 0;
    if (grid == 0) {
        if (n_in != 23 || in_sizes[0] != M * D || out_size != M * D || ws_size < WS_END) { fprintf(stderr, "kernel_launch: unexpected shapes (n_in %d, in0 %d, out %d, ws %zu); nothing launched\n", n_in, n_in > 0 ? in_sizes[0] : -1, out_size, ws_size); grid = -1; return; }
        int dev = 0, cus = 0, per_cu = 0;
        if (hipGetDevice(&dev) != hipSuccess || hipDeviceGetAttribute(&cus, hipDeviceAttributeMultiprocessorCount, dev) != hipSuccess) { grid = -1; return; }
        if (hipFuncSetAttribute((const void*)fwd_kernel, hipFuncAttributeMaxDynamicSharedMemorySize, LDS_BYTES) != hipSuccess) { fprintf(stderr, "kernel_launch: hipFuncSetAttribute failed\n"); grid = -1; return; }
        if (hipOccupancyMaxActiveBlocksPerMultiprocessor(&per_cu, (const void*)fwd_kernel, NTHR, LDS_BYTES) != hipSuccess || per_cu < 1) { fprintf(stderr, "kernel_launch: occupancy query says %d blocks per CU\n", per_cu); (void)hipGetLastError(); grid = -1; return; }
        grid = cus;
    }
    if (grid < 0) return;
    (void)hipMemsetAsync((char*)d_ws + WS_CTL, 0, CTL_ZERO_BYTES, stream);
    Args a{};
    for (int i = 0; i < 23; ++i) a.in[i] = (const float*)d_in[i];
    a.out = (float*)d_out; a.ws = (unsigned char*)d_ws;
#if MK_PER_PHASE
    for (int p = 0; p < N_PHASES; ++p) { a.ph_lo = p; a.ph_hi = p + 1; hipLaunchKernelGGL(fwd_kernel, dim3(grid), dim3(NTHR), LDS_BYTES, stream, a); }
#else
    a.ph_lo = 0; a.ph_hi = N_PHASES; hipLaunchKernelGGL(fwd_kernel, dim3(grid), dim3(NTHR), LDS_BYTES, stream, a);
#endif
}
```
